# Optimizing an MI355X kernel written in HIP

```python
import math
import jax, jax.numpy as jnp
from jax import lax
import numpy as np

D_MODEL = 1024
BATCH = 8
SEQ = 8192
DEPTH = 4

N_MEM = 256
N_MIXERS = 2
N_S5 = (DEPTH + 1) // 2
N_RET = DEPTH // 2

S5_GROUP = 16
S5_GROUPS = D_MODEL // S5_GROUP
S5_STATE = 64
DT_MIN = 1e-3
DT_MAX = 1e-1

RET_HEADS = 4
RET_QK_DIM = D_MODEL // RET_HEADS
RET_V_DIM = 2 * RET_QK_DIM
RET_VALUE_WIDTH = RET_HEADS * RET_V_DIM
RET_IN_WIDTH = 2 * D_MODEL + 2 * RET_VALUE_WIDTH
RET_CHUNK = 128
ROPE_BASE = 10000.0

XATTN_HEADS = 4
XATTN_DIM = D_MODEL // XATTN_HEADS

D_FF = 2816
MACARON_WEIGHT = 0.5
EPS = 1e-6

kernel_name = "hybrid_s5_retention_macaron_memxattn"


def _rmsnorm(x, g):
    xf = x.astype(jnp.float32)
    y = xf * lax.rsqrt(jnp.mean(xf * xf, axis=-1, keepdims=True) + EPS) * g.astype(jnp.float32)
    return y.astype(x.dtype)


def _swiglu(x, w_in, w_out):
    a, b = jnp.split(x @ w_in, 2, axis=-1)
    return (jax.nn.silu(a) * b) @ w_out


def _complex_linear_combine(e1, e2):
    a1r, a1i, b1r, b1i = e1
    a2r, a2i, b2r, b2i = e2
    ar = a2r * a1r - a2i * a1i
    ai = a2r * a1i + a2i * a1r
    br = a2r * b1r - a2i * b1i + b2r
    bi = a2r * b1i + a2i * b1r + b2i
    return ar, ai, br, bi


def _s5_mixer(u, lam_re, lam_im, log_dt, b_re, b_im, c_re, c_im, d_skip, w_glu):
    bsz, seq, _ = u.shape
    f32 = jnp.float32
    uf = u.astype(f32)
    lr = lam_re.astype(f32)
    li = lam_im.astype(f32)
    dt = jnp.exp(log_dt.astype(f32))[:, None]
    mag = jnp.exp(lr * dt)
    ar = mag * jnp.cos(li * dt)
    ai = mag * jnp.sin(li * dt)
    den = lr * lr + li * li
    nr = ar - 1.0
    zr = (nr * lr + ai * li) / den
    zi = (ai * lr - nr * li) / den
    br = b_re.astype(f32)
    bi = b_im.astype(f32)
    bbar_re = zr[..., None] * br - zi[..., None] * bi
    bbar_im = zr[..., None] * bi + zi[..., None] * br
    ug = uf.reshape(bsz, seq, S5_GROUPS, S5_GROUP)
    bu_re = jnp.einsum('bsgh,gph->sbgp', ug, bbar_re)
    bu_im = jnp.einsum('bsgh,gph->sbgp', ug, bbar_im)
    a_re = jnp.broadcast_to(ar, (seq, 1) + ar.shape)
    a_im = jnp.broadcast_to(ai, (seq, 1) + ai.shape)
    _, _, xr, xi = lax.associative_scan(_complex_linear_combine, (a_re, a_im, bu_re, bu_im), axis=0)
    y = (jnp.einsum('sbgp,ghp->bsgh', xr, c_re.astype(f32))
         - jnp.einsum('sbgp,ghp->bsgh', xi, c_im.astype(f32)))
    y = y.reshape(bsz, seq, D_MODEL) + d_skip.astype(f32) * uf
    y = jax.nn.gelu(y).astype(u.dtype)
    a, gate = jnp.split(y @ w_glu, 2, axis=-1)
    return a * jax.nn.sigmoid(gate)


def _rotary(t, cos, sin):
    t1, t2 = jnp.split(t, 2, axis=-1)
    return jnp.concatenate([t1 * cos - t2 * sin, t1 * sin + t2 * cos], axis=-1)


def _retention_mixer(u, positions, w_in, w_out):
    bsz, seq, _ = u.shape
    f32 = jnp.float32
    h = u @ w_in
    q, k, v, g = jnp.split(h, [D_MODEL, 2 * D_MODEL, 2 * D_MODEL + RET_VALUE_WIDTH], axis=-1)
    q = q.astype(f32).reshape(bsz, seq, RET_HEADS, RET_QK_DIM)
    k = k.astype(f32).reshape(bsz, seq, RET_HEADS, RET_QK_DIM) * (RET_QK_DIM ** -0.5)
    v = v.astype(f32).reshape(bsz, seq, RET_HEADS, RET_V_DIM)
    half = RET_QK_DIM // 2
    inv_freq = 1.0 / (ROPE_BASE ** jnp.linspace(0.0, 1.0, half, dtype=f32))
    ang = positions.astype(f32)[..., None] * inv_freq
    cos = jnp.cos(ang)[:, :, None, :]
    sin = jnp.sin(ang)[:, :, None, :]
    q = _rotary(q, cos, sin)
    k = _rotary(k, cos, sin)
    gamma = 1.0 - jnp.exp2(-5.0 - jnp.arange(RET_HEADS, dtype=f32))
    lg = jnp.log(gamma)
    idx = jnp.arange(RET_CHUNK)
    diff = idx[:, None] - idx[None, :]
    d_mat = jnp.where(diff >= 0, jnp.exp(lg[:, None, None] * jnp.maximum(diff, 0).astype(f32)), 0.0)
    xi = jnp.exp(lg[:, None] * (idx + 1).astype(f32))
    zeta = jnp.exp(lg[:, None] * (RET_CHUNK - 1 - idx).astype(f32))
    gamma_chunk = jnp.exp(lg * RET_CHUNK)
    n_chunks = seq // RET_CHUNK

    def to_chunks(t):
        d = t.shape[-1]
        return t.reshape(bsz, n_chunks, RET_CHUNK, RET_HEADS, d).transpose(1, 0, 3, 2, 4)

    def step(state, inp):
        qc, kc, vc = inp
        inner = jnp.einsum('bhid,bhjd->bhij', qc, kc) * d_mat
        out = (jnp.einsum('bhij,bhjv->bhiv', inner, vc)
               + jnp.einsum('bhid,bhdv->bhiv', qc, state) * xi[None, :, :, None])
        state = (state * gamma_chunk[None, :, None, None]
                 + jnp.einsum('bhjd,bhjv->bhdv', kc * zeta[None, :, :, None], vc))
        return state, out

    state0 = jnp.zeros((bsz, RET_HEADS, RET_QK_DIM, RET_V_DIM), f32)
    _, outs = lax.scan(step, state0, (to_chunks(q), to_chunks(k), to_chunks(v)))
    o = outs.transpose(1, 0, 3, 2, 4).reshape(bsz, seq, RET_HEADS, RET_V_DIM)
    mu = jnp.mean(o, axis=-1, keepdims=True)
    var = jnp.mean(jnp.square(o - mu), axis=-1, keepdims=True)
    o = ((o - mu) * lax.rsqrt(var + EPS)).reshape(bsz, seq, RET_VALUE_WIDTH)
    y = (jax.nn.silu(g.astype(f32)) * o).astype(u.dtype)
    return y @ w_out


def _memory_cross_attention(xn, mem_n, w_q, w_kv, w_o):
    bsz, seq, _ = xn.shape
    q = (xn @ w_q).reshape(bsz, seq, XATTN_HEADS, XATTN_DIM)
    k, v = jnp.split(mem_n @ w_kv, 2, axis=-1)
    k = k.reshape(bsz, N_MEM, XATTN_HEADS, XATTN_DIM)
    v = v.reshape(bsz, N_MEM, XATTN_HEADS, XATTN_DIM)
    s = jnp.einsum('bshd,bmhd->bhsm', q.astype(jnp.float32), k.astype(jnp.float32)) * (XATTN_DIM ** -0.5)
    p = jax.nn.softmax(s, axis=-1).astype(xn.dtype)
    o = jnp.einsum('bhsm,bmhd->bshd', p, v).reshape(bsz, seq, D_MODEL)
    return o @ w_o


def setup_inputs(seed: int = 0) -> dict:
    key = jax.random.key(seed)
    ks = jax.random.split(key, 32)
    f32 = jnp.float32
    nrm = lambda k, shape, scale: jax.random.normal(k, shape, f32) * scale
    x = nrm(ks[0], (BATCH, SEQ, D_MODEL), 1.0)
    mem = nrm(ks[1], (BATCH, N_MEM, D_MODEL), 1.0)
    offset = jax.random.randint(ks[2], (BATCH, 1), 0, 4096, dtype=jnp.int32)
    positions = offset + jnp.arange(SEQ, dtype=jnp.int32)[None, :]
    norm_gains = 1.0 + nrm(ks[3], (DEPTH, 4, D_MODEL), 0.02)
    mem_norm = 1.0 + nrm(ks[4], (D_MODEL,), 0.02)
    final_norm = 1.0 + nrm(ks[5], (D_MODEL,), 0.02)
    ffn1_w_in = nrm(ks[6], (DEPTH, D_MODEL, 2 * D_FF), D_MODEL ** -0.5)
    ffn1_w_out = nrm(ks[7], (DEPTH, D_FF, D_MODEL), D_FF ** -0.5)
    ffn2_w_in = nrm(ks[8], (DEPTH, D_MODEL, 2 * D_FF), D_MODEL ** -0.5)
    ffn2_w_out = nrm(ks[9], (DEPTH, D_FF, D_MODEL), D_FF ** -0.5)
    n_idx = jnp.arange(S5_STATE, dtype=f32)
    s5_lam_re = -0.5 + nrm(ks[10], (N_S5, S5_GROUPS, S5_STATE), 0.01)
    s5_lam_im = math.pi * n_idx[None, None, :] + nrm(ks[11], (N_S5, S5_GROUPS, S5_STATE), 0.01)
    s5_log_dt = jax.random.uniform(ks[12], (N_S5, S5_GROUPS), f32, math.log(DT_MIN), math.log(DT_MAX))
    s5_b_re = nrm(ks[13], (N_S5, S5_GROUPS, S5_STATE, S5_GROUP), (2 * S5_GROUP) ** -0.5)
    s5_b_im = nrm(ks[14], (N_S5, S5_GROUPS, S5_STATE, S5_GROUP), (2 * S5_GROUP) ** -0.5)
    s5_c_re = nrm(ks[15], (N_S5, S5_GROUPS, S5_GROUP, S5_STATE), S5_STATE ** -0.5)
    s5_c_im = nrm(ks[16], (N_S5, S5_GROUPS, S5_GROUP, S5_STATE), S5_STATE ** -0.5)
    s5_d = nrm(ks[17], (N_S5, D_MODEL), 1.0)
    s5_w_glu = nrm(ks[18], (N_S5, D_MODEL, 2 * D_MODEL), D_MODEL ** -0.5)
    ret_w_in = nrm(ks[19], (N_RET, D_MODEL, RET_IN_WIDTH), D_MODEL ** -0.5)
    ret_w_out = nrm(ks[20], (N_RET, RET_VALUE_WIDTH, D_MODEL), RET_VALUE_WIDTH ** -0.5)
    xattn_w_q = nrm(ks[21], (DEPTH, D_MODEL, D_MODEL), D_MODEL ** -0.5)
    xattn_w_kv = nrm(ks[22], (DEPTH, D_MODEL, 2 * D_MODEL), D_MODEL ** -0.5)
    xattn_w_o = nrm(ks[23], (DEPTH, D_MODEL, D_MODEL), D_MODEL ** -0.5)
    return {
        "x": x, "mem": mem, "positions": positions,
        "norm_gains": norm_gains, "mem_norm": mem_norm, "final_norm": final_norm,
        "ffn1_w_in": ffn1_w_in, "ffn1_w_out": ffn1_w_out,
        "ffn2_w_in": ffn2_w_in, "ffn2_w_out": ffn2_w_out,
        "s5_lam_re": s5_lam_re, "s5_lam_im": s5_lam_im, "s5_log_dt": s5_log_dt,
        "s5_b_re": s5_b_re, "s5_b_im": s5_b_im, "s5_c_re": s5_c_re, "s5_c_im": s5_c_im,
        "s5_d": s5_d, "s5_w_glu": s5_w_glu,
        "ret_w_in": ret_w_in, "ret_w_out": ret_w_out,
        "xattn_w_q": xattn_w_q, "xattn_w_kv": xattn_w_kv, "xattn_w_o": xattn_w_o,
    }


def reference(x, mem, positions, norm_gains, mem_norm, final_norm,
              ffn1_w_in, ffn1_w_out, ffn2_w_in, ffn2_w_out,
              s5_lam_re, s5_lam_im, s5_log_dt, s5_b_re, s5_b_im, s5_c_re, s5_c_im, s5_d, s5_w_glu,
              ret_w_in, ret_w_out, xattn_w_q, xattn_w_kv, xattn_w_o):
    mem_n = _rmsnorm(mem, mem_norm)
    for i in range(DEPTH):
        g = norm_gains[i]
        x = x + MACARON_WEIGHT * _swiglu(_rmsnorm(x, g[0]), ffn1_w_in[i], ffn1_w_out[i])
        h = _rmsnorm(x, g[1])
        j = i // N_MIXERS
        if i % N_MIXERS == 0:
            mix = _s5_mixer(h, s5_lam_re[j], s5_lam_im[j], s5_log_dt[j], s5_b_re[j], s5_b_im[j],
                            s5_c_re[j], s5_c_im[j], s5_d[j], s5_w_glu[j])
        else:
            mix = _retention_mixer(h, positions, ret_w_in[j], ret_w_out[j])
        x = x + mix
        x = x + _memory_cross_attention(_rmsnorm(x, g[2]), mem_n, xattn_w_q[i], xattn_w_kv[i], xattn_w_o[i])
        x = x + MACARON_WEIGHT * _swiglu(_rmsnorm(x, g[3]), ffn2_w_in[i], ffn2_w_out[i])
    return _rmsnorm(x, final_norm)
```

```cpp
#ifndef HOST_EMU
#include <hip/hip_runtime.h>
#include <cstdio>
#include <cstdint>
#define LAS __attribute__((address_space(3)))
#define GAS __attribute__((address_space(1)))
#define DEV __device__ __forceinline__
#else
#include "emu.h"
#define LAS
#define GAS
#define DEV inline
#endif

#ifndef KB_BATCH
#define KB_BATCH 8
#endif
#ifndef KB_SEQ
#define KB_SEQ 8192
#endif
constexpr int BATCH = KB_BATCH, SEQ = KB_SEQ, DM = 1024, DEPTH = 4, NMEM = 256, DFF = 2816;
constexpr int M = BATCH * SEQ;
constexpr int MMEM = BATCH * NMEM;
constexpr int S5G = 64, S5P = 64, S5H = 16;
constexpr int S5_NCH = 64;
constexpr int S5_LC = SEQ / S5_NCH;
constexpr int RH = 4, RDK = 256, RDV = 512, RVW = RH * RDV, RIN = 2 * DM + 2 * RVW;
constexpr int RMC = 256;
constexpr int XH = 4, XD = 256;
constexpr int ROT_NPOS = 12288;
constexpr float EPS = 1e-6f;
constexpr int SSQW = 32;

typedef unsigned short bf16;
typedef short bf16x8 __attribute__((ext_vector_type(8)));
typedef short s16x4 __attribute__((ext_vector_type(4)));
typedef float f32x4 __attribute__((ext_vector_type(4)));
typedef float f32x2 __attribute__((ext_vector_type(2)));
typedef float f32x16 __attribute__((ext_vector_type(16)));
typedef unsigned u32x4 __attribute__((ext_vector_type(4)));
typedef unsigned u32x2 __attribute__((ext_vector_type(2)));

DEV unsigned f2bf(float f) { unsigned u = __builtin_bit_cast(unsigned, f); return (u + 0x7fffu + ((u >> 16) & 1u)) >> 16; }
DEV float bf2f(unsigned h) { return __builtin_bit_cast(float, (h & 0xffffu) << 16); }
DEV float bflo(unsigned w) { return __builtin_bit_cast(float, w << 16); }
DEV float bfhi(unsigned w) { return __builtin_bit_cast(float, w & 0xffff0000u); }
#ifndef HOST_EMU
typedef __bf16 bf16v2_t __attribute__((ext_vector_type(2)));
DEV unsigned pk2(float lo, float hi) { const f32x2 v = {lo, hi}; const bf16v2_t b = __builtin_convertvector(v, bf16v2_t); return __builtin_bit_cast(unsigned, b); }
DEV float fexp2(float x) { return __builtin_amdgcn_exp2f(x); }
DEV float frcp(float x) { return __builtin_amdgcn_rcpf(x); }
DEV float frsq(float x) { return __builtin_amdgcn_rsqf(x); }
#define MFMA32(a, b, c) __builtin_amdgcn_mfma_f32_32x32x16_bf16(a, b, c, 0, 0, 0)
#define MFMA16K16(a, b, c) __builtin_amdgcn_mfma_f32_16x16x16bf16_1k(a, b, c, 0, 0, 0)
#else
DEV unsigned pk2(float lo, float hi) { return f2bf(lo) | (f2bf(hi) << 16); }
DEV float fexp2(float x) { return exp2f(x); }
DEV float frcp(float x) { return 1.0f / x; }
DEV float frsq(float x) { return 1.0f / sqrtf(x); }
#define MFMA32(a, b, c) emu_mfma32(a, b, c)
#define MFMA16K16(a, b, c) emu_mfma16k16(a, b, c)
#endif
DEV float sigmoidf_(float x) { return frcp(1.0f + fexp2(-1.4426950408889634f * x)); }
DEV float siluf_(float x) { return x * sigmoidf_(x); }
DEV float gelu_tanh(float x) { const float u = 0.7978845608028654f * (x + 0.044715f * x * x * x); return x * sigmoidf_(2.0f * u); }
DEV int pos16(int n) { return (n & 3) | ((n & 4) << 1) | ((n & 8) >> 1); }
DEV int rowmap32(int reg, int hh) { return (reg & 3) + 8 * (reg >> 2) + 4 * hh; }
DEV bf16x8 pack8(float a0, float a1, float a2, float a3, float a4, float a5, float a6, float a7) {
    u32x4 w; w.x = pk2(a0, a1); w.y = pk2(a2, a3); w.z = pk2(a4, a5); w.w = pk2(a6, a7); return __builtin_bit_cast(bf16x8, w); }
DEV s16x4 pack4(float a0, float a1, float a2, float a3) { u32x2 w; w.x = pk2(a0, a1); w.y = pk2(a2, a3); return __builtin_bit_cast(s16x4, w); }
DEV float wave_sum(float v) {
#pragma unroll
    for (int o = 1; o < 64; o <<= 1) v += __shfl_xor(v, o);
    return v;
}

constexpr size_t MiB = 1u << 20;
constexpr size_t WS_CTL = 0, CTL_ZERO_BYTES = 1 * MiB;
constexpr size_t WS_W = 1 * MiB;
constexpr size_t W_F1IN = WS_W, W_F1OUT = W_F1IN + (size_t)2 * DFF * DM * 2, W_F2IN = W_F1OUT + (size_t)DM * DFF * 2, W_F2OUT = W_F2IN + (size_t)2 * DFF * DM * 2;
constexpr size_t W_MIX = W_F2OUT + (size_t)DM * DFF * 2;
constexpr size_t W_ROUT = W_MIX + (size_t)RIN * DM * 2;
constexpr size_t W_XQ = W_ROUT + (size_t)DM * RVW * 2, W_XO = W_XQ + (size_t)DM * DM * 2, W_XK = W_XO + (size_t)DM * DM * 2, W_XV = W_XK + (size_t)DM * DM * 2;
constexpr size_t W_XKV_SET = (size_t)2 * DM * DM * 2;
constexpr size_t W_END = W_XV + (size_t)DM * DM * 2 + W_XKV_SET;
static_assert(W_END <= 65 * MiB, "weight region");
constexpr size_t WS_S5T = 65 * MiB, S5T_STRIDE = 1 * MiB;
constexpr size_t S5T_BBAR = WS_S5T, S5T_CT = S5T_BBAR + (size_t)S5G * 2 * S5P * S5H * 2, S5T_A = S5T_CT + (size_t)S5G * 2 * S5H * S5P * 2, S5T_AL = S5T_A + (size_t)S5G * S5P * 2 * 4;
static_assert(S5T_AL + (size_t)S5G * S5P * 2 * 4 <= WS_S5T + S5T_STRIDE, "s5 tables");
constexpr size_t WS_ROT = 67 * MiB;
static_assert((size_t)ROT_NPOS * 128 * 8 <= 13 * MiB, "rot table");
constexpr size_t WS_MEMN = 80 * MiB, WS_MEMNP = 84 * MiB;
constexpr size_t WS_XK = 88 * MiB, WS_XVT = 96 * MiB, XKV_SET = 4 * MiB;
constexpr size_t WS_SSQ = 104 * MiB;
constexpr size_t WS_XHAT = 105 * MiB;
constexpr size_t WS_BIG = 233 * MiB;
constexpr size_t BIG_H = WS_BIG;
constexpr size_t BIG_YB = WS_BIG, BIG_ES = WS_BIG + 128 * MiB;
constexpr size_t BIG_RQ = WS_BIG, BIG_RK = WS_BIG + 128 * MiB, BIG_RVT = WS_BIG + 256 * MiB, BIG_RO = WS_BIG + 512 * MiB, BIG_RST = WS_BIG + 768 * MiB;
constexpr size_t BIG_XQ = WS_BIG, BIG_XO = WS_BIG + 128 * MiB;
constexpr size_t WS_END = WS_BIG + 784 * MiB;
static_assert(WS_END <= (size_t)1024 * MiB, "workspace map");
#ifndef HOST_EMU
namespace pg8 {
#define PG8_LAS __attribute__((address_space(3)))
typedef unsigned short bf16_t;
typedef short bf16x8 __attribute__((ext_vector_type(8)));
typedef float f32x4 __attribute__((ext_vector_type(4)));
typedef unsigned u32x4 __attribute__((ext_vector_type(4)));
constexpr int BM = 256, BK = 64, HALF = 128, HTB = HALF * BK * 2  , STAGE_BYTES = 8 * HTB, NXCD = 8, WGM = 8;

__host__ __device__ __forceinline__ int lds_byte(int r, int c) { const int st = (r >> 4) * 2 + (c >> 5), rr = r & 15, cc = c & 31, ob = rr * 64 + cc * 2; return st * 1024 + (ob ^ (((ob >> 9) & 1) << 5)); }
__host__ __device__ __forceinline__ void stage_rc(int b, int& R, int& C) { const int st = b / 1024, sb = b % 1024, swz = sb ^ (((sb >> 9) & 1) << 5); R = (st >> 1) * 16 + swz / 64; C = (st & 1) * 32 + (swz % 64) / 2; }
__host__ __device__ __forceinline__ int perm32(int rho) { const int n = rho >> 4, i = rho & 15; return 8 * (i >> 2) + 4 * n + (i & 3); }

struct Unit { int pm, pn; };
struct Gemm { const bf16_t* A; const bf16_t* Bt; int M, N, K; int ld = 0; };

struct StaticOrder {
    int nM, nN, nwg, G, c;
    __host__ __device__ void init(int M, int N, int G_, int c_) { nM = M / BM; nN = N / BM; nwg = nM * nN; G = G_; c = c_; }
    __host__ __device__ bool next(int i, Unit& u) const {
        const long L = (long)i * G + c; if (L >= nwg) return false;
        int wgid = (int)L; { const int q = nwg / NXCD, r = nwg % NXCD, xcd = wgid % NXCD, off = wgid / NXCD; wgid = (xcd < r ? xcd * (q + 1) : r * (q + 1) + (xcd - r) * q) + off; }
        const int nig = WGM * nN, gid = wgid / nig, fm = gid * WGM, gsz = (nM - fm) < WGM ? (nM - fm) : WGM;
        u.pm = fm + ((wgid % nig) % gsz); u.pn = (wgid % nig) / gsz; return true;
    }
    __device__ __forceinline__ void a_ready(const Unit&) const {}
    __device__ __forceinline__ void done(const Unit&) const {}
};
}
#endif
#ifdef HOST_EMU
namespace pg8 { struct Unit { int pm, pn; }; constexpr int BM = 256, HALF = 128; }
#endif
typedef f32x4 AccT[2][2][4][2];
#if !defined(HOST_EMU) && defined(KB_NT_H)
#define NT_STORE16(p, v) __builtin_nontemporal_store((v), (p))
#else
#define NT_STORE16(p, v) (*(p) = (v))
#endif
#ifndef HOST_EMU
#define EPI_OPAQUE(a, b) asm volatile("" : "+v"(a), "+v"(b))
#else
#define EPI_OPAQUE(a, b) do {} while (0)
#endif

typedef unsigned long long ssq_t;
constexpr float SSQ_SCALE = 1048576.0f, SSQ_INV = 1.0f / 1048576.0f;
DEV ssq_t ss_fix(float v) { return (ssq_t)(v * SSQ_SCALE + 0.5f); }
DEV float ss_val(ssq_t v) { return (float)v * SSQ_INV; }
#ifndef HOST_EMU
DEV ssq_t zero64() { unsigned lo = 0u, hi = 0u; asm volatile("" : "+v"(lo), "+v"(hi)); return ((ssq_t)hi << 32) | lo; }
#else
DEV ssq_t zero64() { return 0ull; }
#endif
DEV void row_rstd(const ssq_t* ss, int row0, float (&rs)[2][4]) {
#pragma unroll
    for (int ai = 0; ai < 2; ++ai)
#pragma unroll
        for (int m = 0; m < 4; ++m) rs[ai][m] = frsq(ss_val(ss[row0 + 128 * ai + 16 * m]) * (1.0f / DM) + EPS);
}
#ifndef HOST_EMU
DEV void ss_add(ssq_t* p, float v) { atomicAdd(p, ss_fix(v)); }
#else
#include <mutex>
static std::mutex e_atomic_mtx;
DEV void ss_add(ssq_t* p, float v) { std::lock_guard<std::mutex> g(e_atomic_mtx); *p += ss_fix(v); }
#endif

struct EpiResid {
    static constexpr bool PERM = true, AFTER_DRAIN = false;
    bf16* xh; ssq_t* ss_acc; ssq_t* ss_zero; float scale;
    DEV void operator()(const AccT& acc, const pg8::Unit& u, int wr, int wc, int fr, int fq) const {
        EPI_OPAQUE(fr, fq);
        const int row0 = u.pm * 256 + wr * 64 + fr, col0 = u.pn * 256 + wc * 32 + 8 * fq;
#pragma unroll
        for (int ai = 0; ai < 2; ++ai)
#pragma unroll
            for (int m = 0; m < 4; ++m) { const int row = row0 + 128 * ai + 16 * m; bf16* rowp = xh + (size_t)row * DM + col0; float ss = 0.f;
#pragma unroll
                for (int bj = 0; bj < 2; ++bj) { const u32x4 b = *(const u32x4*)(rowp + 128 * bj); const f32x4 a0 = acc[ai][bj][m][0] * scale, a1 = acc[ai][bj][m][1] * scale;
                    u32x4 w; w.x = pk2(bflo(b.x) + a0[0], bfhi(b.x) + a0[1]); w.y = pk2(bflo(b.y) + a0[2], bfhi(b.y) + a0[3]); w.z = pk2(bflo(b.z) + a1[0], bfhi(b.z) + a1[1]); w.w = pk2(bflo(b.w) + a1[2], bfhi(b.w) + a1[3]);
                    *(u32x4*)(rowp + 128 * bj) = w;
                    const float o0 = bflo(w.x), o1 = bfhi(w.x), o2 = bflo(w.y), o3 = bfhi(w.y), o4 = bflo(w.z), o5 = bfhi(w.z), o6 = bflo(w.w), o7 = bfhi(w.w);
                    ss += ((o0 * o0 + o1 * o1) + (o2 * o2 + o3 * o3)) + ((o4 * o4 + o5 * o5) + (o6 * o6 + o7 * o7)); }
                ss += __shfl_xor(ss, 16); ss += __shfl_xor(ss, 32);
                if (fq == 0) { ss_add(ss_acc + row, ss); ss_zero[row] = zero64(); }
            }
    }
};
struct EpiS5Glu {
    static constexpr bool PERM = true, AFTER_DRAIN = false;
    bf16* xh; ssq_t* ss_acc; ssq_t* ss_zero;
    DEV void operator()(const AccT& acc, const pg8::Unit& u, int wr, int wc, int fr, int fq) const {
        EPI_OPAQUE(fr, fq);
        const int row0 = u.pm * 256 + wr * 64 + fr, col0 = u.pn * 128 + wc * 32 + 8 * fq;
#pragma unroll
        for (int ai = 0; ai < 2; ++ai)
#pragma unroll
            for (int m = 0; m < 4; ++m) { const int row = row0 + 128 * ai + 16 * m; bf16* rowp = xh + (size_t)row * DM + col0;
                const u32x4 b = *(const u32x4*)rowp; const float bb[8] = {bflo(b.x), bfhi(b.x), bflo(b.y), bfhi(b.y), bflo(b.z), bfhi(b.z), bflo(b.w), bfhi(b.w)}; float o[8];
#pragma unroll
                for (int n = 0; n < 2; ++n)
#pragma unroll
                    for (int e = 0; e < 4; ++e) o[4 * n + e] = bb[4 * n + e] + acc[ai][0][m][n][e] * sigmoidf_(acc[ai][1][m][n][e]);
                u32x4 w; w.x = pk2(o[0], o[1]); w.y = pk2(o[2], o[3]); w.z = pk2(o[4], o[5]); w.w = pk2(o[6], o[7]);
                *(u32x4*)rowp = w;
                const float o0 = bflo(w.x), o1 = bfhi(w.x), o2 = bflo(w.y), o3 = bfhi(w.y), o4 = bflo(w.z), o5 = bfhi(w.z), o6 = bflo(w.w), o7 = bfhi(w.w);
                float ss = ((o0 * o0 + o1 * o1) + (o2 * o2 + o3 * o3)) + ((o4 * o4 + o5 * o5) + (o6 * o6 + o7 * o7));
                ss += __shfl_xor(ss, 16); ss += __shfl_xor(ss, 32);
                if (fq == 0) { ss_add(ss_acc + row, ss); ss_zero[row] = zero64(); }
            }
    }
};
struct EpiSwiGLU {
    static constexpr bool PERM = true, AFTER_DRAIN = false;
    bf16* H; const ssq_t* ssq;
    DEV void operator()(const AccT& acc, const pg8::Unit& u, int wr, int wc, int fr, int fq) const {
        EPI_OPAQUE(fr, fq);
        const int row0 = u.pm * 256 + wr * 64 + fr, col0 = u.pn * 128 + wc * 32 + 8 * fq;
        float rs[2][4]; row_rstd(ssq, row0, rs);
#pragma unroll
        for (int ai = 0; ai < 2; ++ai)
#pragma unroll
            for (int m = 0; m < 4; ++m) { const float r = rs[ai][m]; float h[8];
#pragma unroll
                for (int n = 0; n < 2; ++n)
#pragma unroll
                    for (int e = 0; e < 4; ++e) { const float a = acc[ai][0][m][n][e] * r, b = acc[ai][1][m][n][e] * r; h[4 * n + e] = siluf_(a) * b; }
                u32x4 w; w.x = pk2(h[0], h[1]); w.y = pk2(h[2], h[3]); w.z = pk2(h[4], h[5]); w.w = pk2(h[6], h[7]);
                NT_STORE16((u32x4*)(H + (size_t)(row0 + 128 * ai + 16 * m) * DFF + col0), w); }
    }
};
template <int NSLOT> struct EpiBf16 {
    static constexpr bool PERM = true, AFTER_DRAIN = false;
    bf16* O; int ldc; const ssq_t* ssq;
    DEV void operator()(const AccT& acc, const pg8::Unit& u, int wr, int wc, int fr, int fq) const {
        EPI_OPAQUE(fr, fq);
        const int row0 = u.pm * 256 + wr * 64 + fr, col0 = u.pn * 256 + wc * 32 + 8 * fq;
        float rs[2][4];
        if constexpr (NSLOT > 0) row_rstd(ssq, row0, rs);
#pragma unroll
        for (int ai = 0; ai < 2; ++ai)
#pragma unroll
            for (int m = 0; m < 4; ++m) { const float r = NSLOT > 0 ? rs[ai][m] : 1.0f; bf16* rowp = O + (size_t)(row0 + 128 * ai + 16 * m) * ldc + col0;
#pragma unroll
                for (int bj = 0; bj < 2; ++bj) { const f32x4 v0 = acc[ai][bj][m][0] * r, v1 = acc[ai][bj][m][1] * r;
                    u32x4 w; w.x = pk2(v0[0], v0[1]); w.y = pk2(v0[2], v0[3]); w.z = pk2(v1[0], v1[1]); w.w = pk2(v1[2], v1[3]);
                    *(u32x4*)(rowp + 128 * bj) = w; } }
    }
};
struct EpiRetIn {
    static constexpr bool PERM = true, AFTER_DRAIN = false;
    bf16 *Q, *K; const ssq_t* ssq; const float* rot; const int* positions;
    DEV void operator()(const AccT& acc, const pg8::Unit& u, int wr, int wc, int fr, int fq) const {
        EPI_OPAQUE(fr, fq);
        const int row0 = u.pm * 256 + wr * 64 + fr, pn = u.pn;
        float rs[2][4]; row_rstd(ssq, row0, rs);
        {
            const int h = pn & 3; const bool isk = pn >= 4; bf16* dst = isk ? K : Q;
            const float lg = log2f(1.0f - exp2f(-5.0f - (float)h)); const int d0 = wc * 32 + 8 * fq;
#pragma unroll
            for (int ai = 0; ai < 2; ++ai)
#pragma unroll
                for (int m = 0; m < 4; ++m) { const int row = row0 + 128 * ai + 16 * m; const int i256 = row & (RMC - 1);
                    const float sc = rs[ai][m] * (isk ? fexp2(-lg * (float)i256) * 0.0625f : fexp2(lg * (float)i256));
                    const float* rp = rot + ((size_t)positions[row] * 128 + d0) * 2;
                    const f32x4 r0 = *(const f32x4*)rp, r1 = *(const f32x4*)(rp + 4), r2 = *(const f32x4*)(rp + 8), r3 = *(const f32x4*)(rp + 12);
                    const float cs[8] = {r0[0], r0[2], r1[0], r1[2], r2[0], r2[2], r3[0], r3[2]}, sn[8] = {r0[1], r0[3], r1[1], r1[3], r2[1], r2[3], r3[1], r3[3]};
                    float o1[8], o2[8];
#pragma unroll
                    for (int n = 0; n < 2; ++n)
#pragma unroll
                        for (int e = 0; e < 4; ++e) { const float t1 = acc[ai][0][m][n][e] * sc, t2 = acc[ai][1][m][n][e] * sc; const int j = 4 * n + e;
                            o1[j] = t1 * cs[j] - t2 * sn[j]; o2[j] = t1 * sn[j] + t2 * cs[j]; }
                    u32x4 w1, w2; w1.x = pk2(o1[0], o1[1]); w1.y = pk2(o1[2], o1[3]); w1.z = pk2(o1[4], o1[5]); w1.w = pk2(o1[6], o1[7]);
                    w2.x = pk2(o2[0], o2[1]); w2.y = pk2(o2[2], o2[3]); w2.z = pk2(o2[4], o2[5]); w2.w = pk2(o2[6], o2[7]);
                    bf16* p = dst + (size_t)row * DM + 256 * h + d0; *(u32x4*)p = w1; *(u32x4*)(p + 128) = w2; }
        }
    }
};
struct EpiRetGate {
    static constexpr bool PERM = true, AFTER_DRAIN = false;
    bf16* O; const ssq_t* ssq; const float* stat;
    DEV void operator()(const AccT& acc, const pg8::Unit& u, int wr, int wc, int fr, int fq) const {
        EPI_OPAQUE(fr, fq);
        const int row0 = u.pm * 256 + wr * 64 + fr, h = u.pn >> 1, col0 = u.pn * 256 + wc * 32 + 8 * fq;
        float rs[2][4]; row_rstd(ssq, row0, rs);
#pragma unroll
        for (int ai = 0; ai < 2; ++ai)
#pragma unroll
            for (int m = 0; m < 4; ++m) { const int row = row0 + 128 * ai + 16 * m; const float r = rs[ai][m];
                const f32x4 st = *(const f32x4*)(stat + ((size_t)row * RH + h) * 16 + 4 * fq);
                float s1 = st[0] + st[2], s2 = st[1] + st[3];
                s1 += __shfl_xor(s1, 16); s1 += __shfl_xor(s1, 32); s2 += __shfl_xor(s2, 16); s2 += __shfl_xor(s2, 32);
                const float mu = s1 * (1.0f / RDV), var = fmaxf(s2 * (1.0f / RDV) - mu * mu, 0.0f), rg = frsq(var + EPS);
                bf16* rowp = O + (size_t)row * RVW + col0;
#pragma unroll
                for (int bj = 0; bj < 2; ++bj) { const u32x4 ow = *(const u32x4*)(rowp + 128 * bj);
                    const float o[8] = {bflo(ow.x), bfhi(ow.x), bflo(ow.y), bfhi(ow.y), bflo(ow.z), bfhi(ow.z), bflo(ow.w), bfhi(ow.w)}; float y[8];
#pragma unroll
                    for (int n = 0; n < 2; ++n)
#pragma unroll
                        for (int e = 0; e < 4; ++e) { const int j = 4 * n + e; y[j] = siluf_(acc[ai][bj][m][n][e] * r) * ((o[j] - mu) * rg); }
                    u32x4 w; w.x = pk2(y[0], y[1]); w.y = pk2(y[2], y[3]); w.z = pk2(y[4], y[5]); w.w = pk2(y[6], y[7]);
                    *(u32x4*)(rowp + 128 * bj) = w; } }
    }
};

struct EpiNull {
    static constexpr bool PERM = false, AFTER_DRAIN = false;
    DEV void operator()(const AccT& acc, const pg8::Unit& u, int wr, int wc, int fr, int fq) const {
#ifndef HOST_EMU
#pragma unroll
        for (int ai = 0; ai < 2; ++ai)
#pragma unroll
            for (int bj = 0; bj < 2; ++bj)
#pragma unroll
                for (int m = 0; m < 4; ++m)
#pragma unroll
                    for (int n = 0; n < 2; ++n) asm volatile("" :: "v"(acc[ai][bj][m][n]));
#endif
    }
};

struct EpiRetP {
    static constexpr bool PERM = true, AFTER_DRAIN = false;
    bf16* P;
    DEV void operator()(const AccT& acc, const pg8::Unit& u, int wr, int wc, int fr, int fq) const {
        EPI_OPAQUE(fr, fq);
        bf16* blk = P + (size_t)u.pm * 65536;
        const int i0 = wr * 64 + fr, j0 = wc * 32 + 8 * fq;
#pragma unroll
        for (int ai = 0; ai < 2; ++ai)
#pragma unroll
            for (int m = 0; m < 4; ++m) { const int i = i0 + 128 * ai + 16 * m;
#pragma unroll
                for (int bj = 0; bj < 2; ++bj) { const int jb = j0 + 128 * bj;
                    const int g16 = jb & ~15, f = (jb >> 3) & 1;
#pragma unroll
                    for (int n = 0; n < 2; ++n) { float v[4];
#pragma unroll
                        for (int e_ = 0; e_ < 4; ++e_) v[e_] = (jb + 4 * n + e_ <= i) ? acc[ai][bj][m][n][e_] : 0.f;
                        u32x2 w; w.x = pk2(v[0], v[1]); w.y = pk2(v[2], v[3]);
                        *(u32x2*)(blk + (size_t)i * 256 + g16 + 8 * n + 4 * f) = w; } } }
    }
};

struct EpiRetVT {
    static constexpr bool PERM = true, AFTER_DRAIN = false;
    bf16* VT; const ssq_t* ssq;
    DEV void operator()(const AccT& acc, const pg8::Unit& u, int wr, int wc, int fr, int fq) const {
        EPI_OPAQUE(fr, fq);
        const int row0 = u.pm * 256 + wr * 64 + fr, t0 = u.pn * 256 + wc * 32 + 8 * fq;
        float rs[2][8];
#pragma unroll
        for (int bj = 0; bj < 2; ++bj)
#pragma unroll
            for (int j = 0; j < 8; ++j) rs[bj][j] = frsq(ss_val(ssq[t0 + 128 * bj + j]) * (1.0f / DM) + EPS);
        const int f = fq & 1;
#pragma unroll
        for (int ai = 0; ai < 2; ++ai)
#pragma unroll
            for (int m = 0; m < 4; ++m) { bf16* rowp = VT + (size_t)(row0 + 128 * ai + 16 * m) * M;
#pragma unroll
                for (int bj = 0; bj < 2; ++bj) { const int g16 = (t0 + 128 * bj) & ~15;
#pragma unroll
                    for (int n = 0; n < 2; ++n) { const f32x4 a = acc[ai][bj][m][n]; u32x2 w; w.x = pk2(a[0] * rs[bj][4 * n], a[1] * rs[bj][4 * n + 1]); w.y = pk2(a[2] * rs[bj][4 * n + 2], a[3] * rs[bj][4 * n + 3]);
                        *(u32x2*)(rowp + g16 + 8 * n + 4 * f) = w; } } }
    }
};
#ifndef HOST_EMU
namespace pg8 {
__device__ __forceinline__ int pg8_lane_id_fresh() { unsigned m = ~0u; asm volatile("" : "+s"(m)); return (int)__builtin_amdgcn_mbcnt_hi(m, __builtin_amdgcn_mbcnt_lo(m, 0u)); }
template <class Epi, class Sched, bool ALIGN_EPI = false, bool SP2 = false>
__device__ __forceinline__ void gemm_phase(PG8_LAS unsigned char* lds, const Gemm g, const Sched& S, const Epi& E, int wave_id) {
    int tid_l = wave_id * 64 + pg8_lane_id_fresh(); asm volatile("" : "+v"(tid_l));
    const int tid = tid_l, wid = __builtin_amdgcn_readfirstlane(tid >> 6), lane = tid & 63, wr = wid >> 2, wc = wid & 3, fr = lane & 15, fq = lane >> 4;
    const int K = g.K, nt = K / BK, ldk = g.ld ? g.ld : g.K;
    unsigned voffA[2], voffB[2];
#pragma unroll
    for (int i = 0; i < 2; ++i) { int R, C; stage_rc(tid * 16 + i * 8192, R, C); const int Rb = Epi::PERM ? ((R & ~31) + perm32(R & 31)) : R;
        voffA[i] = (unsigned)(R * ldk + C) * 2u; voffB[i] = (unsigned)(Rb * ldk + C) * 2u; }
    const size_t kstep = (size_t)(BK * 2);
    const size_t hstep = (size_t)HALF * ldk * 2;
    const size_t tstep = 2 * hstep;
    const unsigned ldsw = (unsigned)wid * 1024u;
    const int aoff = lds_byte(wr * 64 + fr, fq * 8), boff = lds_byte(wc * 32 + fr, fq * 8);
#define PG8_SA(b, h) (((b) * 2 + (h)) * HTB)
#define PG8_SB(b, h) ((4 + (b) * 2 + (h)) * HTB)
#define PG8_STAGE(bufoff, gbase, voff) do { _Pragma("unroll") for (int _i = 0; _i < 2; ++_i) \
        __builtin_amdgcn_global_load_lds((const unsigned*)((const char*)(gbase) + (voff)[_i]), (PG8_LAS unsigned*)(lds + (bufoff) + ldsw + _i * 8192), 16, 0, 0); } while (0)
#define PG8_LDA(dst, b, h) do { _Pragma("unroll") for (int m = 0; m < 4; ++m) _Pragma("unroll") for (int k = 0; k < 2; ++k) dst[m][k] = *(const PG8_LAS bf16x8*)(lds + PG8_SA(b, h) + aoff + m * 2048 + k * 1024); } while (0)
#define PG8_LDB(dst, b, h) do { _Pragma("unroll") for (int n = 0; n < 2; ++n) _Pragma("unroll") for (int k = 0; k < 2; ++k) dst[n][k] = *(const PG8_LAS bf16x8*)(lds + PG8_SB(b, h) + boff + n * 2048 + k * 1024); } while (0)
#define PG8_MMA(ai, bj, At, Bt) do { __builtin_amdgcn_s_setprio(1); _Pragma("unroll") for (int m = 0; m < 4; ++m) _Pragma("unroll") for (int n = 0; n < 2; ++n) _Pragma("unroll") for (int k = 0; k < 2; ++k) \
        acc[ai][bj][m][n] = __builtin_amdgcn_mfma_f32_16x16x32_bf16(Bt[n][k], At[m][k], acc[ai][bj][m][n], 0, 0, 0); __builtin_amdgcn_s_setprio(0); } while (0)
#define PG8_WAIT_V(n) asm volatile("s_waitcnt vmcnt(" #n ")" ::: "memory")
#define PG8_WAIT_L(n) asm volatile("s_waitcnt lgkmcnt(" #n ")" ::: "memory")
#define PG8_BAR __builtin_amdgcn_s_barrier()
#define PG8_SCHED __builtin_amdgcn_sched_barrier(0)
    Unit cur, nxt; int ui = 0;
    if (!S.next(0, cur)) return;
    f32x4 acc[2][2][4][2];
#pragma unroll
    for (int a = 0; a < 2; ++a)
#pragma unroll
        for (int b = 0; b < 2; ++b)
#pragma unroll
            for (int m = 0; m < 4; ++m)
#pragma unroll
                for (int n = 0; n < 2; ++n) acc[a][b][m][n] = (f32x4){0.f, 0.f, 0.f, 0.f};
    bf16x8 At[4][2], B0[2][2], B1[2][2];
    const char* cA = (const char*)g.A + (size_t)cur.pm * tstep; const char* cB = (const char*)g.Bt + (size_t)cur.pn * tstep;
    S.a_ready(cur);
    if constexpr (SP2) {
        PG8_STAGE(PG8_SB(0, 0), cB, voffB); PG8_STAGE(PG8_SB(0, 1), cB + hstep, voffB); PG8_STAGE(PG8_SA(0, 0), cA, voffA); PG8_STAGE(PG8_SA(0, 1), cA + hstep, voffA);
        if (wr == 1) PG8_BAR;
        PG8_WAIT_V(2); PG8_BAR;
        PG8_STAGE(PG8_SB(1, 0), cB + kstep, voffB); PG8_STAGE(PG8_SA(1, 0), cA + kstep, voffA); PG8_STAGE(PG8_SB(1, 1), cB + hstep + kstep, voffB);
        PG8_WAIT_V(6); PG8_BAR;
    } else {
        PG8_STAGE(PG8_SB(0, 0), cB, voffB); PG8_STAGE(PG8_SA(0, 0), cA, voffA); PG8_STAGE(PG8_SB(0, 1), cB + hstep, voffB); PG8_STAGE(PG8_SA(0, 1), cA + hstep, voffA);
        if (wr == 1) PG8_BAR;
        PG8_WAIT_V(4); PG8_BAR;
        PG8_STAGE(PG8_SB(1, 0), cB + kstep, voffB); PG8_STAGE(PG8_SA(1, 0), cA + kstep, voffA); PG8_STAGE(PG8_SB(1, 1), cB + hstep + kstep, voffB);
        PG8_WAIT_V(6); PG8_BAR;
    }
    for (;;) {
        const bool has_next = S.next(ui + 1, nxt);
        const char* nA = has_next ? (const char*)g.A + (size_t)nxt.pm * tstep : cA; const char* nB = has_next ? (const char*)g.Bt + (size_t)nxt.pn * tstep : cB;
        for (int t = 0; t < nt; t += 2) {
            const bool last = (t == nt - 2);
            const char* a1 = cA + (size_t)(t + 1) * kstep;
            const char* a2 = last ? nA : cA + (size_t)(t + 2) * kstep; const char* b2 = last ? nB : cB + (size_t)(t + 2) * kstep;
            const char* a3 = a2 + kstep; const char* b3 = b2 + kstep;
            if (last && has_next) S.a_ready(nxt);
            if constexpr (SP2) {
            PG8_LDB(B0, 0, 0); PG8_LDB(B1, 0, 1); PG8_SCHED; PG8_LDA(At, 0, 0); PG8_STAGE(PG8_SA(1, 1), a1 + hstep, voffA);
            PG8_WAIT_V(8); PG8_WAIT_L(0); PG8_BAR; PG8_MMA(0, 0, At, B0); PG8_MMA(0, 1, At, B1); PG8_BAR; PG8_SCHED;
            PG8_LDA(At, 0, 1); PG8_STAGE(PG8_SB(0, 0), b2, voffB); PG8_STAGE(PG8_SB(0, 1), b2 + hstep, voffB); PG8_STAGE(PG8_SA(0, 0), a2, voffA);
            PG8_WAIT_V(8); PG8_WAIT_L(0); PG8_BAR; PG8_MMA(1, 0, At, B0); PG8_MMA(1, 1, At, B1); PG8_BAR; PG8_SCHED;
            PG8_LDB(B0, 1, 0); PG8_LDB(B1, 1, 1); PG8_SCHED; PG8_LDA(At, 1, 0); PG8_STAGE(PG8_SA(0, 1), a2 + hstep, voffA);
            PG8_WAIT_V(8); PG8_WAIT_L(0); PG8_BAR; PG8_MMA(0, 0, At, B0); PG8_MMA(0, 1, At, B1); PG8_BAR; PG8_SCHED;
            PG8_LDA(At, 1, 1); PG8_STAGE(PG8_SB(1, 0), b3, voffB); PG8_STAGE(PG8_SB(1, 1), b3 + hstep, voffB); PG8_STAGE(PG8_SA(1, 0), a3, voffA);
            PG8_WAIT_V(8); PG8_WAIT_L(0); PG8_BAR; PG8_MMA(1, 0, At, B0); PG8_MMA(1, 1, At, B1); PG8_BAR; PG8_SCHED;
            } else {
            PG8_LDB(B0, 0, 0); PG8_SCHED; PG8_LDA(At, 0, 0); PG8_STAGE(PG8_SA(1, 1), a1 + hstep, voffA);
            PG8_WAIT_L(8); PG8_BAR; PG8_WAIT_L(0); PG8_MMA(0, 0, At, B0); PG8_BAR; PG8_SCHED;
            PG8_LDB(B1, 0, 1); PG8_STAGE(PG8_SB(0, 0), b2, voffB);
            PG8_BAR; PG8_WAIT_L(0); PG8_MMA(0, 1, At, B1); PG8_BAR;
            PG8_LDA(At, 0, 1); PG8_STAGE(PG8_SA(0, 0), a2, voffA);
            PG8_BAR; PG8_WAIT_L(0); PG8_MMA(1, 0, At, B0); PG8_BAR; PG8_SCHED;
            PG8_STAGE(PG8_SB(0, 1), b2 + hstep, voffB);
            PG8_WAIT_V(6); PG8_BAR; PG8_MMA(1, 1, At, B1); PG8_BAR;
            PG8_LDB(B0, 1, 0); PG8_SCHED; PG8_LDA(At, 1, 0); PG8_STAGE(PG8_SA(0, 1), a2 + hstep, voffA);
            PG8_WAIT_L(8); PG8_BAR; PG8_WAIT_L(0); PG8_MMA(0, 0, At, B0); PG8_BAR; PG8_SCHED;
            PG8_LDB(B1, 1, 1); PG8_STAGE(PG8_SB(1, 0), b3, voffB);
            PG8_BAR; PG8_WAIT_L(0); PG8_MMA(0, 1, At, B1); PG8_BAR;
            PG8_LDA(At, 1, 1); PG8_STAGE(PG8_SA(1, 0), a3, voffA);
            PG8_BAR; PG8_WAIT_L(0); PG8_MMA(1, 0, At, B0); PG8_BAR; PG8_SCHED;
            PG8_STAGE(PG8_SB(1, 1), b3 + hstep, voffB);
            PG8_WAIT_V(6); PG8_BAR; PG8_MMA(1, 1, At, B1); PG8_BAR;
            }
        }
        if constexpr (ALIGN_EPI) { if (wr == 0) PG8_BAR; }
        if constexpr (!Epi::AFTER_DRAIN) { E(acc, cur, wr, wc, fr, fq); S.done(cur); }
        if (!has_next) break;
#pragma unroll
        for (int a = 0; a < 2; ++a)
#pragma unroll
            for (int b = 0; b < 2; ++b)
#pragma unroll
                for (int m = 0; m < 4; ++m)
#pragma unroll
                    for (int n = 0; n < 2; ++n) acc[a][b][m][n] = (f32x4){0.f, 0.f, 0.f, 0.f};
        cur = nxt; cA = nA; cB = nB; ++ui;
        if constexpr (ALIGN_EPI) { if (wr == 1) PG8_BAR; }
    }
    PG8_WAIT_V(0);
    if constexpr (!ALIGN_EPI) { if (wr == 0) PG8_BAR; }
    PG8_BAR;
    if constexpr (Epi::AFTER_DRAIN) { E.fused(acc, cur, wr, wc, fr, fq, lds, wid, lane); S.done(cur); }
#undef PG8_SA
#undef PG8_SB
#undef PG8_STAGE
#undef PG8_LDA
#undef PG8_LDB
#undef PG8_MMA
#undef PG8_WAIT_V
#undef PG8_WAIT_L
#undef PG8_BAR
#undef PG8_SCHED
}
}
#endif
#ifndef HOST_EMU
#define WAVE_LDS_SYNC() do { asm volatile("s_waitcnt lgkmcnt(0)" ::: "memory"); } while (0)
#else
#define WAVE_LDS_SYNC() do { e_wave->bar.arrive_and_wait(); } while (0)
#endif
DEV void conv_tile(const float* W, int ldw, int k0, int n0, const float* gain, bf16* dst, int Kd, LAS float* scr, int lane) {
#pragma unroll 8
    for (int i = 0; i < 32; ++i) { const int kk = 2 * i + (lane >> 5); float v = W[(size_t)(k0 + kk) * ldw + n0 + (lane & 31)]; if (gain) v *= gain[k0 + kk]; scr[kk * 33 + (lane & 31)] = v; }
    WAVE_LDS_SYNC();
    const int c = lane & 7;
#pragma unroll
    for (int j = 0; j < 4; ++j) { const int n = (lane >> 3) + 8 * j; const LAS float* s = scr + (8 * c) * 33 + n;
        u32x4 o; o.x = pk2(s[0 * 33], s[1 * 33]); o.y = pk2(s[2 * 33], s[3 * 33]); o.z = pk2(s[4 * 33], s[5 * 33]); o.w = pk2(s[6 * 33], s[7 * 33]);
        *(u32x4*)(dst + (size_t)n * Kd + k0 + 8 * c) = o; }
    WAVE_LDS_SYNC();
}
DEV int glu_row(int n, int NH) { const int j = n < NH ? n : n - NH; return (j >> 7) * 256 + (n < NH ? 0 : 128) + (j & 127); }

struct LayerW {
    const float *g;
    const float *f1in, *f1out, *f2in, *f2out;
    const float *mixin, *mixout;
    const float *xq, *xkv, *xkv2, *xo;
    int is_ret;
};
DEV void convert_layer(const LayerW& L, unsigned char* ws, LAS float* scr, int gw, int NGW, int lane) {
    constexpr int I_FIN = (DM / 64) * (2 * DFF / 32), I_FOUT = (DFF / 64) * (DM / 32), I_GLU = (DM / 64) * (2 * DM / 32), I_RIN = (DM / 64) * (RIN / 32), I_ROUT = (RVW / 64) * (DM / 32),
                  I_SQ = (DM / 64) * (DM / 32), I_KV = (DM / 64) * (2 * DM / 32);
    const int i_mix = L.is_ret ? I_RIN + I_ROUT : I_GLU;
    const int n_kv = L.is_ret ? 0 : 2 * I_KV;
    const int total = 2 * (I_FIN + I_FOUT) + i_mix + 2 * I_SQ + n_kv;
    for (int it = gw; it < total; it += NGW) {
        int r = it;
        if (r < 2 * I_FIN) { const int f = r >= I_FIN; r -= f * I_FIN; const int nb = r % (2 * DFF / 32), kb = r / (2 * DFF / 32);
            conv_tile(f ? L.f2in : L.f1in, 2 * DFF, 64 * kb, 32 * nb, L.g + (f ? 3 : 0) * DM, (bf16*)(ws + (f ? W_F2IN : W_F1IN)) + (size_t)glu_row(32 * nb, DFF) * DM, DM, scr, lane); continue; }
        r -= 2 * I_FIN;
        if (r < 2 * I_FOUT) { const int f = r >= I_FOUT; r -= f * I_FOUT; const int nb = r % (DM / 32), kb = r / (DM / 32);
            conv_tile(f ? L.f2out : L.f1out, DM, 64 * kb, 32 * nb, nullptr, (bf16*)(ws + (f ? W_F2OUT : W_F1OUT)) + (size_t)(32 * nb) * DFF, DFF, scr, lane); continue; }
        r -= 2 * I_FOUT;
        if (r < i_mix) {
            if (!L.is_ret) { const int nb = r % (2 * DM / 32), kb = r / (2 * DM / 32);
                conv_tile(L.mixin, 2 * DM, 64 * kb, 32 * nb, nullptr, (bf16*)(ws + W_MIX) + (size_t)glu_row(32 * nb, DM) * DM, DM, scr, lane); }
            else if (r < I_RIN) { const int nb = r % (RIN / 32), kb = r / (RIN / 32);
                conv_tile(L.mixin, RIN, 64 * kb, 32 * nb, L.g + 1 * DM, (bf16*)(ws + W_MIX) + (size_t)(32 * nb) * DM, DM, scr, lane); }
            else { r -= I_RIN; const int nb = r % (DM / 32), kb = r / (DM / 32);
                conv_tile(L.mixout, DM, 64 * kb, 32 * nb, nullptr, (bf16*)(ws + W_ROUT) + (size_t)(32 * nb) * RVW, RVW, scr, lane); }
            continue; }
        r -= i_mix;
        if (r < 2 * I_SQ) { const int f = r >= I_SQ; r -= f * I_SQ; const int nb = r % (DM / 32), kb = r / (DM / 32);
            conv_tile(f ? L.xo : L.xq, DM, 64 * kb, 32 * nb, f ? nullptr : L.g + 2 * DM, (bf16*)(ws + (f ? W_XO : W_XQ)) + (size_t)(32 * nb) * DM, DM, scr, lane); continue; }
        r -= 2 * I_SQ;
        { const int set = r >= I_KV; r -= set * I_KV; const int nb = r % (2 * DM / 32), kb = r / (2 * DM / 32); const int n0 = 32 * nb;
          conv_tile(set ? L.xkv2 : L.xkv, 2 * DM, 64 * kb, n0, nullptr, (bf16*)(ws + (n0 < DM ? W_XK : W_XV) + set * W_XKV_SET) + (size_t)(n0 < DM ? n0 : n0 - DM) * DM, DM, scr, lane); }
    }
}
DEV void s5_tables(const float* lam_re, const float* lam_im, const float* log_dt, const float* b_re, const float* b_im, const float* c_re, const float* c_im, unsigned char* ws, int gt, int NGT) {
    bf16* BBAR = (bf16*)(ws + S5T_BBAR); bf16* CT = (bf16*)(ws + S5T_CT); float* A = (float*)(ws + S5T_A); float* AL = (float*)(ws + S5T_AL);
    for (int idx = gt; idx < S5G * S5P; idx += NGT) {
        const int g = idx / S5P, p = idx % S5P;
        const double dt = exp((double)log_dt[g]), lr = (double)lam_re[idx], li = (double)lam_im[idx];
        const double mag = exp(lr * dt), ang = li * dt, ar = mag * cos(ang), ai = mag * sin(ang);
        const double den = lr * lr + li * li, nr = ar - 1.0, zr = (nr * lr + ai * li) / den, zi = (ai * lr - nr * li) / den;
        for (int hi = 0; hi < S5H; ++hi) { const double br = (double)b_re[(size_t)idx * S5H + hi], bi = (double)b_im[(size_t)idx * S5H + hi];
            BBAR[((size_t)(g * 2 + 0) * S5P + p) * S5H + hi] = (bf16)f2bf((float)(zr * br - zi * bi));
            BBAR[((size_t)(g * 2 + 1) * S5P + p) * S5H + hi] = (bf16)f2bf((float)(zr * bi + zi * br)); }
        for (int ho = 0; ho < S5H; ++ho) { const size_t ci = ((size_t)g * S5H + ho) * S5P + p;
            CT[((size_t)(g * 2 + 0) * S5H + ho) * S5P + p] = (bf16)f2bf(c_re[ci]);
            CT[((size_t)(g * 2 + 1) * S5H + ho) * S5P + p] = (bf16)f2bf(-c_im[ci]); }
        A[(size_t)idx * 2] = (float)ar; A[(size_t)idx * 2 + 1] = (float)ai;
        double pr = 1.0, pi = 0.0, qr = ar, qi = ai;
        for (int e = S5_LC; e > 0; e >>= 1) { if (e & 1) { const double t = pr * qr - pi * qi; pi = pr * qi + pi * qr; pr = t; } const double t = qr * qr - qi * qi; qi = 2.0 * qr * qi; qr = t; }
        AL[(size_t)idx * 2] = (float)pr; AL[(size_t)idx * 2 + 1] = (float)pi;
    }
}
DEV void rot_table(float* rot, int gt, int NGT) {
    for (int idx = gt; idx < ROT_NPOS * 128; idx += NGT) { const int pos = idx >> 7, k = idx & 127;
        const double invf = exp(-9.210340371976184 * ((double)k / 127.0)), ang = (double)pos * invf;
        rot[(size_t)idx * 2] = (float)cos(ang); rot[(size_t)idx * 2 + 1] = (float)sin(ang); }
}
DEV void memn_rows(const float* mem, const float* gain, bf16* MEMN, bf16* MEMNP, int gw, int NGW, int lane) {
    for (int row = gw; row < MMEM; row += NGW) {
        const f32x4* xr = (const f32x4*)(mem + (size_t)row * DM) + lane; const f32x4* gr = (const f32x4*)gain + lane;
        f32x4 v[4]; float s = 0.f;
#pragma unroll
        for (int j = 0; j < 4; ++j) { v[j] = xr[64 * j]; s += (v[j][0] * v[j][0] + v[j][1] * v[j][1]) + (v[j][2] * v[j][2] + v[j][3] * v[j][3]); }
        const float r = 1.0f / sqrtf(wave_sum(s) * (1.0f / DM) + EPS);
        const int rowp = (row & ~15) | pos16(row & 15);
#pragma unroll
        for (int j = 0; j < 4; ++j) { const f32x4 g = gr[64 * j]; u32x2 w; w.x = pk2(v[j][0] * r * g[0], v[j][1] * r * g[1]); w.y = pk2(v[j][2] * r * g[2], v[j][3] * r * g[3]);
            *((u32x2*)(MEMN + (size_t)row * DM) + lane + 64 * j) = w; *((u32x2*)(MEMNP + (size_t)rowp * DM) + lane + 64 * j) = w; }
    }
}
DEV void x0_rows(const float* x, bf16* xh, ssq_t* ss0, ssq_t* ss1, int gw, int NGW, int lane) {
    for (int row = gw; row < M; row += NGW) {
        const f32x4* xr = (const f32x4*)(x + (size_t)row * DM) + lane; float s = 0.f;
#pragma unroll
        for (int j = 0; j < 4; ++j) { const f32x4 v = xr[64 * j]; u32x2 w; w.x = pk2(v[0], v[1]); w.y = pk2(v[2], v[3]); *((u32x2*)(xh + (size_t)row * DM) + lane + 64 * j) = w;
            const float q0 = bflo(w.x), q1 = bfhi(w.x), q2 = bflo(w.y), q3 = bfhi(w.y); s += (q0 * q0 + q1 * q1) + (q2 * q2 + q3 * q3); }
        s = wave_sum(s);
        if (lane == 0) { ss0[row] = ss_fix(s); ss1[row] = 0ull; }
    }
}
DEV void final_rows(const bf16* xh, const ssq_t* ssq, const float* gain, float* out, int gw, int NGW, int lane) {
    const f32x4* gr = (const f32x4*)gain + lane; f32x4 g[4];
#pragma unroll
    for (int j = 0; j < 4; ++j) g[j] = gr[64 * j];
    for (int row0 = gw * 4; row0 < M; row0 += NGW * 4) {
        u32x2 v[4][4]; float r[4];
#pragma unroll
        for (int i = 0; i < 4; ++i) { r[i] = 1.0f / sqrtf(ss_val(ssq[row0 + i]) * (1.0f / DM) + EPS); const u32x2* xr = (const u32x2*)(xh + (size_t)(row0 + i) * DM) + lane;
#pragma unroll
            for (int j = 0; j < 4; ++j) v[i][j] = xr[64 * j]; }
#pragma unroll
        for (int i = 0; i < 4; ++i) { f32x4* orow = (f32x4*)(out + (size_t)(row0 + i) * DM) + lane;
#pragma unroll
            for (int j = 0; j < 4; ++j) { f32x4 o; o[0] = bflo(v[i][j].x) * r[i] * g[j][0]; o[1] = bfhi(v[i][j].x) * r[i] * g[j][1]; o[2] = bflo(v[i][j].y) * r[i] * g[j][2]; o[3] = bfhi(v[i][j].y) * r[i] * g[j][3]; orow[64 * j] = o; } }
    }
}
template <int PASS> DEV void s5_pass(const bf16* xh, const ssq_t* ssq, const float* gain, const float* dskip, const unsigned char* ws, float* ES, bf16* YB, LAS unsigned char* lds, int vcu, int G, int tid) {
    const int wave = tid >> 6, lane = tid & 63, fr = lane & 15, fq = lane >> 4;
    const bf16* BBAR = (const bf16*)(ws + S5T_BBAR); const bf16* CT = (const bf16*)(ws + S5T_CT); const float* A = (const float*)(ws + S5T_A);
    LAS float* rtab = (LAS float*)lds;
    constexpr int NT = BATCH * 4 * 8, QLEN = SEQ / 4;
    for (int wt = vcu; wt < NT; wt += G) {
        const int gb = wt & 7, bq = wt >> 3, q4 = bq & 3, b = bq >> 2, g = 8 * gb + wave;
        const int tok0 = b * SEQ + q4 * QLEN;
        __syncthreads();
        for (int t = tid; t < QLEN; t += 512) rtab[t] = frsq(ss_val(ssq[tok0 + t]) * (1.0f / DM) + EPS);
        __syncthreads();
        s16x4 bb[4][2], cc[4][2]; float ar[4][4], ai[4][4];
#pragma unroll
        for (int ct = 0; ct < 4; ++ct) {
#pragma unroll
            for (int part = 0; part < 2; ++part) {
                bb[ct][part] = *(const s16x4*)(BBAR + ((size_t)(g * 2 + part) * S5P + 16 * ct + fr) * S5H + 4 * fq);
                cc[ct][part] = *(const s16x4*)(CT + ((size_t)(g * 2 + part) * S5H + fr) * S5P + 16 * ct + 4 * fq); }
            const f32x4 a0 = *(const f32x4*)(A + ((size_t)g * S5P + 16 * ct + 4 * fq) * 2), a1 = *(const f32x4*)(A + ((size_t)g * S5P + 16 * ct + 4 * fq) * 2 + 4);
            ar[ct][0] = a0[0]; ai[ct][0] = a0[1]; ar[ct][1] = a0[2]; ai[ct][1] = a0[3]; ar[ct][2] = a1[0]; ai[ct][2] = a1[1]; ar[ct][3] = a1[2]; ai[ct][3] = a1[3]; }
        const f32x4 gn = *(const f32x4*)(gain + 16 * g + 4 * fq), dk = *(const f32x4*)(dskip + 16 * g + 4 * fq);
        float xr[4][4], xi[4][4];
        const int bg = b * S5G + g, ch = 16 * q4 + fr;
        float* es = ES + ((size_t)bg * S5_NCH + ch) * 128 + 4 * fq;
#pragma unroll
        for (int ct = 0; ct < 4; ++ct) {
            if (PASS == 3) { const f32x4 r_ = *(const f32x4*)(es + 16 * ct), i_ = *(const f32x4*)(es + 64 + 16 * ct);
#pragma unroll
                for (int i = 0; i < 4; ++i) { xr[ct][i] = r_[i]; xi[ct][i] = i_[i]; } }
            else {
#pragma unroll
                for (int i = 0; i < 4; ++i) { xr[ct][i] = 0.f; xi[ct][i] = 0.f; } } }
        const size_t rowbase = (size_t)(tok0 + S5_LC * fr) * DM + 16 * g + 4 * fq;
        u32x2 nxt = *(const u32x2*)(xh + rowbase);
#pragma unroll 1
        for (int j = 0; j < S5_LC; ++j) {
            const u32x2 cur = nxt; if (j + 1 < S5_LC) nxt = *(const u32x2*)(xh + rowbase + (size_t)(j + 1) * DM);
            const float r = rtab[S5_LC * fr + j];
            const float u0 = bflo(cur.x) * r * gn[0], u1 = bfhi(cur.x) * r * gn[1], u2 = bflo(cur.y) * r * gn[2], u3 = bfhi(cur.y) * r * gn[3];
            const s16x4 ub = pack4(u0, u1, u2, u3);
#pragma unroll
            for (int ct = 0; ct < 4; ++ct) {
                const f32x4 z = {0.f, 0.f, 0.f, 0.f};
                const f32x4 br = MFMA16K16(bb[ct][0], ub, z), bi = MFMA16K16(bb[ct][1], ub, z);
#pragma unroll
                for (int i = 0; i < 4; ++i) { const float nr = br[i] + ar[ct][i] * xr[ct][i] - ai[ct][i] * xi[ct][i], ni = bi[i] + ar[ct][i] * xi[ct][i] + ai[ct][i] * xr[ct][i]; xr[ct][i] = nr; xi[ct][i] = ni; } }
            if (PASS == 3) {
                f32x4 y = {0.f, 0.f, 0.f, 0.f};
#pragma unroll
                for (int ct = 0; ct < 4; ++ct) { y = MFMA16K16(cc[ct][0], pack4(xr[ct][0], xr[ct][1], xr[ct][2], xr[ct][3]), y); y = MFMA16K16(cc[ct][1], pack4(xi[ct][0], xi[ct][1], xi[ct][2], xi[ct][3]), y); }
                u32x2 w; w.x = pk2(gelu_tanh(y[0] + dk[0] * u0), gelu_tanh(y[1] + dk[1] * u1)); w.y = pk2(gelu_tanh(y[2] + dk[2] * u2), gelu_tanh(y[3] + dk[3] * u3));
                *(u32x2*)(YB + rowbase + (size_t)j * DM) = w; }
        }
        if (PASS == 1) {
#pragma unroll
            for (int ct = 0; ct < 4; ++ct) { const f32x4 r_ = {xr[ct][0], xr[ct][1], xr[ct][2], xr[ct][3]}, i_ = {xi[ct][0], xi[ct][1], xi[ct][2], xi[ct][3]};
                *(f32x4*)(es + 16 * ct) = r_; *(f32x4*)(es + 64 + 16 * ct) = i_; } }
    }
}
DEV void s5_carry(float* ES, const unsigned char* ws, int gt, int NGT) {
    const float* AL = (const float*)(ws + S5T_AL);
    for (int idx = gt; idx < BATCH * S5G * S5P; idx += NGT) { const int bg = idx / S5P, k = idx % S5P, g = bg % S5G;
        const float alr = AL[((size_t)g * S5P + k) * 2], ali = AL[((size_t)g * S5P + k) * 2 + 1]; float sr = 0.f, si = 0.f;
        float* p = ES + (size_t)bg * S5_NCH * 128 + k;
        for (int c = 0; c < S5_NCH; ++c) { const float er = p[(size_t)c * 128], ei = p[(size_t)c * 128 + 64]; p[(size_t)c * 128] = sr; p[(size_t)c * 128 + 64] = si;
            const float nr = alr * sr - ali * si + er, ni = alr * si + ali * sr + ei; sr = nr; si = ni; } }
}

#ifndef HOST_EMU
#define LDS_BARRIER() do { asm volatile("s_waitcnt lgkmcnt(0)" ::: "memory"); __builtin_amdgcn_s_barrier(); asm volatile("" ::: "memory"); } while (0)
#else
#define LDS_BARRIER() __syncthreads()
#endif
constexpr int KTS = 264;
#ifndef HOST_EMU
#define FRAG_PIN() __builtin_amdgcn_sched_barrier(0)
#else
#define FRAG_PIN() do {} while (0)
#endif
#define TILE_MFMA16(acc, rowp, bfrag) do { _Pragma("unroll") for (int s4_ = 0; s4_ < 4; ++s4_) { bf16x8 fr_[4]; \
    _Pragma("unroll") for (int q_ = 0; q_ < 4; ++q_) fr_[q_] = *(const LAS bf16x8*)((rowp) + 16 * (4 * s4_ + q_)); FRAG_PIN(); \
    _Pragma("unroll") for (int q_ = 0; q_ < 4; ++q_) acc = MFMA32(fr_[q_], bfrag[4 * s4_ + q_], acc); FRAG_PIN(); } } while (0)
constexpr int RET_LDS = (2 * 32 + 64) * KTS * 2;
DEV void stage_tile_ld(const bf16* src, size_t ld, int tid, u32x4 (&rg)[2]) {
#pragma unroll
    for (int i = 0; i < 2; ++i) { const int q = tid + 512 * i, row = q >> 5, chk = q & 31; rg[i] = *(const u32x4*)(src + (size_t)row * ld + 8 * chk); }
}
DEV void stage_tile_st(LAS bf16* dst, int tid, const u32x4 (&rg)[2]) {
#pragma unroll
    for (int i = 0; i < 2; ++i) { const int q = tid + 512 * i, row = q >> 5, chk = q & 31; *(LAS u32x4*)(dst + row * KTS + 8 * chk) = rg[i]; }
}
#define RET_STAGE_LD(...) do { if (!(SKIP & 16)) stage_tile_ld(__VA_ARGS__); } while (0)
template <int SKIP = 0>
DEV void ret_core(const bf16* Q, const bf16* K, const bf16* VT, bf16* O, float* STAT, LAS unsigned char* lds, int vcu, int G, int tid) {
    const int w = tid >> 6, lane = tid & 63, c = lane & 31, hh = lane >> 5;
    LAS bf16* KT0 = (LAS bf16*)lds; LAS bf16* KT1 = KT0 + 32 * KTS; LAS bf16* SB = KT1 + 32 * KTS;
    constexpr int NT = BATCH * RH * 8, NMC = SEQ / RMC;
    bf16x8 idf[2];
#pragma unroll
    for (int sg = 0; sg < 2; ++sg)
#pragma unroll
        for (int e = 0; e < 8; ++e) idf[sg][e] = (16 * sg + 8 * hh + e == c) ? (short)0x3F80 : (short)0;
    for (int tsk = vcu; tsk < NT; tsk += G) {
        const int b = tsk >> 5, h = (tsk >> 3) & 3, vs = tsk & 7;
        const float lg = log2f(1.0f - exp2f(-5.0f - (float)h)), g256 = exp2f(lg * (float)RMC);
        f32x16 sacc[2];
#pragma unroll
        for (int vt = 0; vt < 2; ++vt)
#pragma unroll
            for (int r = 0; r < 16; ++r) sacc[vt][r] = 0.f;
        LDS_BARRIER();
        for (int i = tid; i < 64 * KTS / 2; i += 512) ((LAS unsigned*)SB)[i] = 0u;
        LDS_BARRIER();
        const bf16* vtrow = VT + (size_t)(RDV * h + 64 * vs + c) * M + 8 * hh;
        bf16x8 qf[16];
        { const bf16* qrow = Q + (size_t)(b * SEQ + 32 * w + c) * DM + 256 * h + 8 * hh;
#pragma unroll
          for (int s = 0; s < 16; ++s) qf[s] = (SKIP & 32) ? idf[s & 1] : *(const bf16x8*)(qrow + 16 * s); }
        for (int mc = 0; mc < NMC; ++mc) {
            const int T0 = b * SEQ + RMC * mc;
            const bf16* ksrc = K + (size_t)T0 * DM + 256 * h;
            u32x4 rg0[2], rg1[2];
            RET_STAGE_LD(ksrc, DM, tid, rg0);
            f32x16 oacc[2];
#pragma unroll
            for (int vt = 0; vt < 2; ++vt) {
#pragma unroll
                for (int r = 0; r < 16; ++r) oacc[vt][r] = 0.f;
#pragma unroll
                for (int s = 0; s < 16; ++s) if (!(SKIP & 4)) oacc[vt] = MFMA32(*(const LAS bf16x8*)(SB + (32 * vt + c) * KTS + 16 * s + 8 * hh), qf[s], oacc[vt]);
#pragma unroll
                for (int r = 0; r < 16; ++r) { oacc[vt][r] *= g256; sacc[vt][r] *= g256; } }
            stage_tile_st(KT0, tid, rg0);
            RET_STAGE_LD(ksrc + (size_t)32 * DM, DM, tid, rg1);
            LDS_BARRIER();
#pragma unroll
            for (int jt = 0; jt < 8; ++jt) {
                LAS bf16* cur = (jt & 1) ? KT1 : KT0; LAS bf16* nx = (jt & 1) ? KT0 : KT1;
                bf16x8 vf[2][2];
#pragma unroll
                for (int vt = 0; vt < 2; ++vt)
#pragma unroll
                    for (int s2 = 0; s2 < 2; ++s2) vf[vt][s2] = (SKIP & 8) ? idf[s2] : *(const bf16x8*)(vtrow + (size_t)(32 * vt) * M + T0 + 32 * jt + 16 * s2);
                FRAG_PIN();
                if (jt < 6) { if (jt & 1) RET_STAGE_LD(ksrc + (size_t)(32 * (jt + 2)) * DM, DM, tid, rg1); else RET_STAGE_LD(ksrc + (size_t)(32 * (jt + 2)) * DM, DM, tid, rg0); }
                FRAG_PIN();
                if (!(SKIP & 1) && w >= jt) {
                    f32x16 X;
#pragma unroll
                    for (int r = 0; r < 16; ++r) X[r] = 0.f;
                    TILE_MFMA16(X, cur + c * KTS + 8 * hh, qf);
                    if (w == jt) {
#pragma unroll
                        for (int r = 0; r < 16; ++r) if (rowmap32(r, hh) > c) X[r] = 0.f; }
#pragma unroll
                    for (int s2 = 0; s2 < 2; ++s2) { const bf16x8 pf = pack8(X[8 * s2], X[8 * s2 + 1], X[8 * s2 + 2], X[8 * s2 + 3], X[8 * s2 + 4], X[8 * s2 + 5], X[8 * s2 + 6], X[8 * s2 + 7]);
#pragma unroll
                        for (int vt = 0; vt < 2; ++vt) oacc[vt] = MFMA32(vf[vt][s2], pf, oacc[vt]); }
                }
                if (jt == 7 && mc + 1 < NMC) { const bf16* qrow = Q + (size_t)(T0 + RMC + 32 * w + c) * DM + 256 * h + 8 * hh;
#pragma unroll
                    for (int s = 0; s < 16; ++s) qf[s] = (SKIP & 32) ? idf[s & 1] : *(const bf16x8*)(qrow + 16 * s); }
                if (!(SKIP & 2)) {
                    f32x16 Xk;
#pragma unroll
                    for (int r = 0; r < 16; ++r) Xk[r] = 0.f;
                    Xk = MFMA32(*(const LAS bf16x8*)(cur + c * KTS + 32 * w + 8 * hh), idf[0], Xk);
                    Xk = MFMA32(*(const LAS bf16x8*)(cur + c * KTS + 32 * w + 16 + 8 * hh), idf[1], Xk);
#pragma unroll
                    for (int s2 = 0; s2 < 2; ++s2) { const bf16x8 kf = pack8(Xk[8 * s2], Xk[8 * s2 + 1], Xk[8 * s2 + 2], Xk[8 * s2 + 3], Xk[8 * s2 + 4], Xk[8 * s2 + 5], Xk[8 * s2 + 6], Xk[8 * s2 + 7]);
#pragma unroll
                        for (int vt = 0; vt < 2; ++vt) sacc[vt] = MFMA32(kf, vf[vt][s2], sacc[vt]); }
                }
                if (jt < 7) { if (jt & 1) stage_tile_st(nx, tid, rg0); else stage_tile_st(nx, tid, rg1); }
                LDS_BARRIER();
            }
            float s1 = 0.f, s2_ = 0.f;
            bf16* orow = O + (size_t)(T0 + 32 * w + c) * RVW + RDV * h + 64 * vs + 4 * hh;
#pragma unroll
            for (int vt = 0; vt < 2; ++vt)
#pragma unroll
                for (int q = 0; q < 4; ++q) { const float a0 = oacc[vt][4 * q], a1 = oacc[vt][4 * q + 1], a2 = oacc[vt][4 * q + 2], a3 = oacc[vt][4 * q + 3];
                    s1 += (a0 + a1) + (a2 + a3); s2_ += (a0 * a0 + a1 * a1) + (a2 * a2 + a3 * a3);
                    u32x2 wv; wv.x = pk2(a0, a1); wv.y = pk2(a2, a3); *(u32x2*)(orow + 32 * vt + 8 * q) = wv; }
            s1 += __shfl_xor(s1, 32); s2_ += __shfl_xor(s2_, 32);
            if (hh == 0) { f32x2 sv; sv[0] = s1; sv[1] = s2_; *(f32x2*)(STAT + ((size_t)(T0 + 32 * w + c) * RH + h) * 16 + 2 * vs) = sv; }
#pragma unroll
            for (int vt = 0; vt < 2; ++vt)
#pragma unroll
                for (int q = 0; q < 4; ++q) { u32x2 wv; wv.x = pk2(sacc[vt][4 * q], sacc[vt][4 * q + 1]); wv.y = pk2(sacc[vt][4 * q + 2], sacc[vt][4 * q + 3]);
                    *(LAS u32x2*)(SB + (32 * vt + c) * KTS + 32 * w + 8 * q + 4 * hh) = wv; }
            LDS_BARRIER();
        }
    }
}

#undef RET_STAGE_LD
struct DiagOrder {
    int nblk, G, c;
    DEV bool next(int i, pg8::Unit& u) const { const int k = i * G + c; if (k >= nblk) return false; u.pm = k; u.pn = k; return true; }
    DEV void a_ready(const pg8::Unit&) const {}
    DEV void done(const pg8::Unit&) const {}
};

DEV void xattn_core(const bf16* QX, const bf16* XK, const bf16* XVT, bf16* OX, LAS unsigned char* lds, int vcu, int G, int tid) {
    const int w = tid >> 6, lane = tid & 63, c = lane & 31, hh = lane >> 5;
    LAS bf16* T0_ = (LAS bf16*)lds; LAS bf16* T1_ = T0_ + 32 * KTS;
    constexpr int NQB = SEQ / 256, NU = BATCH * XH * NQB;
    for (int un = vcu; un < NU; un += G) {
        const int qb = un % NQB, bh = un / NQB, h = bh & 3, b = bh >> 2;
        const size_t R0 = (size_t)b * SEQ + 256 * qb + 32 * w + c;
        bf16x8 qf[16];
#pragma unroll
        for (int s = 0; s < 16; ++s) qf[s] = *(const bf16x8*)(QX + R0 * DM + 256 * h + 16 * s + 8 * hh);
        const bf16* ksrc = XK + (size_t)(b * NMEM) * DM + 256 * h;
        const bf16* vsrc = XVT + (size_t)(256 * h) * MMEM + b * NMEM;
        u32x4 rg[2];
        f32x16 st[8];
        LDS_BARRIER();
        stage_tile_ld(ksrc, DM, tid, rg); stage_tile_st(T0_, tid, rg);
        LDS_BARRIER();
#pragma unroll
        for (int kt = 0; kt < 8; ++kt) {
            LAS bf16* cur = (kt & 1) ? T1_ : T0_; LAS bf16* nx = (kt & 1) ? T0_ : T1_;
            if (kt < 7) stage_tile_ld(ksrc + (size_t)(32 * (kt + 1)) * DM, DM, tid, rg); else stage_tile_ld(vsrc, MMEM, tid, rg);
#pragma unroll
            for (int r = 0; r < 16; ++r) st[kt][r] = 0.f;
            TILE_MFMA16(st[kt], cur + c * KTS + 8 * hh, qf);
            stage_tile_st(nx, tid, rg);
            LDS_BARRIER();
        }
        float mx = st[0][0];
#pragma unroll
        for (int kt = 0; kt < 8; ++kt)
#pragma unroll
            for (int r = 0; r < 16; ++r) mx = fmaxf(mx, st[kt][r]);
        mx = fmaxf(mx, __shfl_xor(mx, 32));
        const float c2 = 1.4426950408889634f * 0.0625f, mc2 = -mx * c2; float l = 0.f;
        bf16x8 pf[16];
#pragma unroll
        for (int kt = 0; kt < 8; ++kt) {
#pragma unroll
            for (int r = 0; r < 16; ++r) { const float p = fexp2(st[kt][r] * c2 + mc2); st[kt][r] = p; l += p; }
#pragma unroll
            for (int s2 = 0; s2 < 2; ++s2) pf[2 * kt + s2] = pack8(st[kt][8 * s2], st[kt][8 * s2 + 1], st[kt][8 * s2 + 2], st[kt][8 * s2 + 3], st[kt][8 * s2 + 4], st[kt][8 * s2 + 5], st[kt][8 * s2 + 6], st[kt][8 * s2 + 7]); }
        l += __shfl_xor(l, 32);
        const float il = 1.0f / l;
        bf16* orow = OX + R0 * DM + 256 * h + 4 * hh;
#pragma unroll
        for (int dt = 0; dt < 8; ++dt) {
            LAS bf16* cur = (dt & 1) ? T1_ : T0_; LAS bf16* nx = (dt & 1) ? T0_ : T1_;
            if (dt < 7) stage_tile_ld(vsrc + (size_t)(32 * (dt + 1)) * MMEM, MMEM, tid, rg);
            f32x16 ot;
#pragma unroll
            for (int r = 0; r < 16; ++r) ot[r] = 0.f;
            TILE_MFMA16(ot, cur + c * KTS + 8 * hh, pf);
#pragma unroll
            for (int q = 0; q < 4; ++q) { u32x2 wv; wv.x = pk2(ot[4 * q] * il, ot[4 * q + 1] * il); wv.y = pk2(ot[4 * q + 2] * il, ot[4 * q + 3] * il); *(u32x2*)(orow + 32 * dt + 8 * q) = wv; }
            if (dt < 7) stage_tile_st(nx, tid, rg);
            LDS_BARRIER();
        }
    }
}
#ifndef HOST_EMU
#define RLX_AGENT __ATOMIC_RELAXED, __HIP_MEMORY_SCOPE_AGENT
#define XB_TMO      128
#define XB_XCNT(j)  (256  + 64 * (j))
#define XB_XSUB(j)  (1280 + 64 * (j))
#define XB_XGEN(j)  (2304 + 64 * (j))
#define XB_TOP      3328
#define XB_TOPGEN   3392
#define XCD_BAR_WORDS 3456
#define XB_SPIN_CAP (1u << 18)

__device__ __forceinline__ unsigned xb_ld(unsigned* p)              { return __hip_atomic_load(p, __ATOMIC_RELAXED, __HIP_MEMORY_SCOPE_AGENT); }
__device__ __forceinline__ unsigned xb_add(unsigned* p, unsigned v) { return __hip_atomic_fetch_add(p, v, __ATOMIC_RELAXED, __HIP_MEMORY_SCOPE_AGENT); }
__device__ __forceinline__ unsigned xb_xcc_id() { return (unsigned)__builtin_amdgcn_s_getreg((3 << 11) | 20) & 0xFu; }
#define XB_SPIN(cond, bar) do { unsigned _sp = 0; while (cond) { __builtin_amdgcn_s_sleep(1); \
    if ((++_sp & 255u) == 0u) { if (xb_ld(&(bar)[XB_TMO])) break; if (_sp > XB_SPIN_CAP) { atomicAdd(&(bar)[XB_TMO], 1u); break; } } } } while (0)

struct XcdBarrier {
    unsigned* bar; unsigned x;
    volatile LAS unsigned* st;
};

__device__ __forceinline__ XcdBarrier xcd_barrier_post(unsigned* bar, volatile LAS unsigned* st) {
    XcdBarrier b; b.bar = bar; b.x = xb_xcc_id(); b.st = st;
    if (threadIdx.x == 0) (void)xb_add(&bar[XB_XCNT(b.x)], 1u);
    return b;
}
__device__ __forceinline__ void xcd_barrier_complete(unsigned* bar, unsigned x, unsigned& nloc, unsigned& nx) {
    const unsigned G = gridDim.x * gridDim.y * gridDim.z;
    unsigned sum, cnt, mine, sp = 0u;
    for (;;) {
        sum = 0u; cnt = 0u; mine = 0u;
#pragma unroll
        for (unsigned j = 0; j < 16; ++j) { const unsigned c = xb_ld(&bar[XB_XCNT(j)]); sum += c; cnt += (c > 0u) ? 1u : 0u; mine = (j == x) ? c : mine; }
        if (sum == G) break;
        __builtin_amdgcn_s_sleep(1);
        if ((++sp & 255u) == 0u) { if (xb_ld(&bar[XB_TMO])) break; if (sp > XB_SPIN_CAP) { atomicAdd(&bar[XB_TMO], 1u); break; } }
    }
    nloc = mine > 0u ? mine : 1u; nx = cnt > 0u ? cnt : 1u;
}

__device__ __forceinline__ void xcd_barrier(const XcdBarrier& b) {
    asm volatile("s_waitcnt vmcnt(0)" ::: "memory");
    __syncthreads();
    if (threadIdx.x == 0) {
        unsigned* bar = b.bar;
        __builtin_amdgcn_s_waitcnt(0);
        unsigned nloc = b.st[0], nx = b.st[1];
        if (nloc == 0u) { xcd_barrier_complete(bar, b.x, nloc, nx); b.st[0] = nloc; b.st[1] = nx; }
        const unsigned old = xb_add(&bar[XB_XSUB(b.x)], 1u);
        const unsigned gen = old / nloc;
        if (old + 1u == (gen + 1u) * nloc) {
            __builtin_amdgcn_fence(__ATOMIC_RELEASE, "agent");
            asm volatile("s_waitcnt vmcnt(0)" ::: "memory");
            const unsigned og = xb_add(&bar[XB_TOP], 1u);
            const unsigned tg = og / nx;
            if (og + 1u == (tg + 1u) * nx) xb_add(&bar[XB_TOPGEN], 1u);
            else XB_SPIN(xb_ld(&bar[XB_TOPGEN]) == tg, bar);
            __builtin_amdgcn_fence(__ATOMIC_ACQUIRE, "agent");
            xb_add(&bar[XB_XGEN(b.x)], 1u);
            asm volatile("s_waitcnt vmcnt(0)" ::: "memory");
        } else {
            XB_SPIN(xb_ld(&bar[XB_XGEN(b.x)]) == gen, bar);
            __builtin_amdgcn_fence(__ATOMIC_ACQUIRE, "agent");
            asm volatile("s_waitcnt vmcnt(0)" ::: "memory");
        }
    }
    __syncthreads();
}
#endif
#ifndef HOST_EMU
constexpr int NWAVES = 8;
constexpr int RING_BYTES = 131072, LDSCTL_OFF = RING_BYTES, MISC_OFF = LDSCTL_OFF + 320, LDS_BYTES = 147456;
constexpr int PTAB_OFF = LDSCTL_OFF + 1024;
constexpr int CW_BAR = 4096;
#ifndef MK_PER_PHASE
#define MK_PER_PHASE 0
#endif
constexpr int PH_PER_LAYER = 12, PH_FINAL = 1 + PH_PER_LAYER * DEPTH, N_PHASES = PH_FINAL + 1;
static_assert(RET_LDS <= RING_BYTES, "lds");

DEV volatile LAS unsigned long long* ptab_base(LAS unsigned char* lds) { unsigned o = PTAB_OFF; asm volatile("" : "+v"(o)); return (volatile LAS unsigned long long*)(lds + o); }
DEV unsigned long long ldptr(volatile LAS unsigned long long* pt, int k) { const unsigned long long v = pt[k];
    const unsigned lo = __builtin_amdgcn_readfirstlane((unsigned)v), hi = __builtin_amdgcn_readfirstlane((unsigned)(v >> 32)); return ((unsigned long long)hi << 32) | lo; }
#ifndef KB_REP
#define KB_REP 0
#endif
#define REPS(k) (1 + ((KB_REP >> (k)) & 1))
#ifndef KB_FFN_SPLIT
#define KB_FFN_SPLIT 1
#endif
#ifndef KB_STAGGER
#define KB_STAGGER 0
#endif
#ifndef KB_PHMASK1
#define KB_PHMASK1 0xFFF
#endif
#ifndef KB_FINAL_SS
#define KB_FINAL_SS 0
#endif
#ifndef KB_LAYERS
#define KB_LAYERS 4
#endif
#ifndef KB_PHMASK
#define KB_PHMASK 0xFFF
#endif
DEV bool ph_enabled(int k) { if (k == 0 || k >= 1 + PH_PER_LAYER * DEPTH) return true; const int L = (k - 1) / PH_PER_LAYER, s = (k - 1) % PH_PER_LAYER; return L < KB_LAYERS && ((((L & 1) ? KB_PHMASK1 : KB_PHMASK) >> s) & 1); }
DEV int lane_id_fresh() { unsigned m = ~0u; asm volatile("" : "+s"(m)); return (int)__builtin_amdgcn_mbcnt_hi(m, __builtin_amdgcn_mbcnt_lo(m, 0u)); }
DEV XcdBarrier mk_bar(unsigned* p, volatile LAS unsigned* st) { XcdBarrier b; b.bar = p; b.x = xb_xcc_id(); b.st = st; return b; }
struct Args { const void* in[24]; float* out; unsigned char* ws; int ph_lo, ph_hi, li, pad; };

__global__ void __launch_bounds__(NWAVES * 64, 2) hybrid_fwd(Args args) {
    extern __shared__ __attribute__((aligned(16))) unsigned char lds_raw[];
    LAS unsigned char* lds = (LAS unsigned char*)lds_raw;
    volatile LAS unsigned* MISC = (volatile LAS unsigned*)(lds + MISC_OFF);
    const int tid0 = threadIdx.x; const int wave0 = __builtin_amdgcn_readfirstlane(tid0 >> 6);
    const int G = gridDim.x, bx = blockIdx.x, vcu = (G % 8 == 0) ? (bx % 8) * (G / 8) + bx / 8 : bx;
    const int NGW = G * NWAVES, NGT = G * NWAVES * 64;
#define LG(v) ({ int v_ = (v); asm volatile("" : "+s"(v_)); v_; })
#define PH_IDS int tid = LG(wave0) * 64 + lane_id_fresh(); asm volatile("" : "+v"(tid)); const int lane = tid & 63, wave = __builtin_amdgcn_readfirstlane(tid >> 6), gw = LG(vcu) * NWAVES + wave, gt = LG(vcu) * (NWAVES * 64) + tid; (void)lane; (void)gw; (void)gt;
    for (int u = tid0; u < (LDS_BYTES - LDSCTL_OFF) / 4; u += NWAVES * 64) ((LAS unsigned*)(lds + LDSCTL_OFF))[u] = 0u;
    __syncthreads();
    volatile LAS unsigned long long* PT = (volatile LAS unsigned long long*)(lds + PTAB_OFF);
    if (tid0 < 24) PT[tid0] = (unsigned long long)args.in[tid0];
    if (tid0 == 24) PT[24] = (unsigned long long)args.out;
    if (tid0 == 25) PT[25] = (unsigned long long)args.ws;
    __syncthreads();
#define PTR(k) ((const void*)(GAS const void*)ldptr(ptab_base(lds), (k)))
    (void)xcd_barrier_post((unsigned*)(args.ws + WS_CTL) + CW_BAR + args.li * XCD_BAR_WORDS, MISC + 8);
    const int li_ = args.li;
#define bar mk_bar((unsigned*)((unsigned char*)PTR(25) + WS_CTL) + CW_BAR + LG(li_) * XCD_BAR_WORDS, (volatile LAS unsigned*)(lds + MISC_OFF) + 8)
    const int lo = args.ph_lo, hi = args.ph_hi;
#if MK_PER_PHASE || defined(KB_DEBUG)
#define RUN(k) (lo <= (k) && (k) < hi && ph_enabled(k))
#define SEAM(k) do { if (RUN(k) && RUN((k) + 1)) xcd_barrier(bar); } while (0)
#else
#define RUN(k) true
#define SEAM(k) xcd_barrier(bar)
#endif
#define WSP ((unsigned char*)PTR(25))
#define OUTP ((float*)PTR(24))
#define INF(k) ((const float*)PTR(k))
    LAS unsigned char* ring = lds;

    for (int rep_ = 0; rep_ < REPS(11); ++rep_) { if (rep_) xcd_barrier(bar);
    if (RUN(0)) { PH_IDS unsigned char* ws = WSP; ssq_t* SS0 = (ssq_t*)(ws + WS_SSQ);
        rot_table((float*)(ws + WS_ROT), gt, NGT);
        for (int j = 0; j < DEPTH / 2; ++j) s5_tables(INF(10) + (size_t)j * S5G * S5P, INF(11) + (size_t)j * S5G * S5P, INF(12) + (size_t)j * S5G, INF(13) + (size_t)j * S5G * S5P * S5H, INF(14) + (size_t)j * S5G * S5P * S5H,
                                                      INF(15) + (size_t)j * S5G * S5H * S5P, INF(16) + (size_t)j * S5G * S5H * S5P, ws + (size_t)j * S5T_STRIDE, gt, NGT); memn_rows(INF(1), INF(4), (bf16*)(ws + WS_MEMN), (bf16*)(ws + WS_MEMNP), gw, NGW, lane); x0_rows(INF(0), (bf16*)(ws + WS_XHAT), SS0, SS0 + M, gw, NGW, lane); }
    }
    for (int L = 0; L < DEPTH; ++L) {
        const int pb = 1 + PH_PER_LAYER * L; const bool isret = (L & 1) != 0; const int j = L >> 1;
for (int rep_ = 0; rep_ < REPS(0); ++rep_) { if (rep_) xcd_barrier(bar);
        if (RUN(pb + 0)) { PH_IDS unsigned char* ws = WSP;
            LayerW lw;
            lw.g = INF(3) + (size_t)L * 4 * DM;
            lw.f1in = INF(6) + (size_t)L * DM * 2 * DFF; lw.f1out = INF(7) + (size_t)L * DFF * DM;
            lw.f2in = INF(8) + (size_t)L * DM * 2 * DFF; lw.f2out = INF(9) + (size_t)L * DFF * DM;
            lw.mixin = isret ? INF(19) + (size_t)j * DM * RIN : INF(18) + (size_t)j * DM * 2 * DM;
            lw.mixout = isret ? INF(20) + (size_t)j * RVW * DM : nullptr;
            lw.xq = INF(21) + (size_t)L * DM * DM; lw.xkv = INF(22) + (size_t)L * DM * 2 * DM; lw.xkv2 = INF(22) + (size_t)(L + 1 < DEPTH ? L + 1 : L) * DM * 2 * DM; lw.xo = INF(23) + (size_t)L * DM * DM;
            lw.is_ret = isret ? 1 : 0;
            convert_layer(lw, ws, (LAS float*)(ring + wave * 16384), gw, NGW, lane);
        }
}
        SEAM(pb + 0);
for (int rep_ = 0; rep_ < REPS(1); ++rep_) { if (rep_) xcd_barrier(bar);
        if (RUN(pb + 1)) { unsigned char* ws = WSP; ssq_t* SS0 = (ssq_t*)(ws + WS_SSQ);
            for (int hb = 0; hb < KB_FFN_SPLIT; ++hb) { const size_t r0 = (size_t)hb * (M / KB_FFN_SPLIT);
                { pg8::Gemm g{(const bf16*)(ws + WS_XHAT) + r0 * DM, (const bf16*)(ws + W_F1IN), M / KB_FFN_SPLIT, 2 * DFF, DM}; pg8::StaticOrder S; S.init(M / KB_FFN_SPLIT, 2 * DFF, LG(G), LG(bx)); EpiSwiGLU E{(bf16*)(ws + BIG_H) + r0 * DFF, SS0 + r0};
                  pg8::gemm_phase<EpiSwiGLU, pg8::StaticOrder, true, true>(ring, g, S, E, LG(wave0)); }
                if (hb + 1 < KB_FFN_SPLIT) { xcd_barrier(bar);
                    pg8::Gemm g{(const bf16*)(ws + BIG_H) + r0 * DFF, (const bf16*)(ws + W_F1OUT), M / KB_FFN_SPLIT, DM, DFF}; pg8::StaticOrder S; S.init(M / KB_FFN_SPLIT, DM, LG(G), LG(bx)); EpiResid E{(bf16*)(ws + WS_XHAT) + r0 * DM, (SS0 + M) + r0, SS0 + r0, 0.5f};
                    pg8::gemm_phase<EpiResid, pg8::StaticOrder, true, true>(ring, g, S, E, LG(wave0)); xcd_barrier(bar); } }
        }
}
        SEAM(pb + 1);
        if (RUN(pb + 2)) { unsigned char* ws = WSP; ssq_t* SS0 = (ssq_t*)(ws + WS_SSQ); const size_t r0 = (size_t)(KB_FFN_SPLIT - 1) * (M / KB_FFN_SPLIT);
            pg8::Gemm g{(const bf16*)(ws + BIG_H) + r0 * DFF, (const bf16*)(ws + W_F1OUT), M / KB_FFN_SPLIT, DM, DFF}; pg8::StaticOrder S; S.init(M / KB_FFN_SPLIT, DM, LG(G), LG(bx)); EpiResid E{(bf16*)(ws + WS_XHAT) + r0 * DM, (SS0 + M) + r0, SS0 + r0, 0.5f};
            pg8::gemm_phase<EpiResid, pg8::StaticOrder, true, true>(ring, g, S, E, LG(wave0)); }
        SEAM(pb + 2);
        if ((KB_REP >> 8) & 1) { unsigned char* ws = WSP; pg8::Gemm g{(const bf16*)(ws + WS_XHAT), (const bf16*)(ws + W_F1IN), M, 2 * DFF, DM}; pg8::StaticOrder S; S.init(M, 2 * DFF, LG(G), LG(bx)); EpiNull E{};
            pg8::gemm_phase<EpiNull, pg8::StaticOrder, true, true>(ring, g, S, E, LG(wave0)); xcd_barrier(bar); }
        if ((KB_REP >> 9) & 1) { unsigned char* ws = WSP; pg8::Gemm g{(const bf16*)(ws + BIG_H), (const bf16*)(ws + W_F1OUT), M, DM, DFF}; pg8::StaticOrder S; S.init(M, DM, LG(G), LG(bx)); EpiNull E{};
            pg8::gemm_phase<EpiNull, pg8::StaticOrder, true, true>(ring, g, S, E, LG(wave0)); xcd_barrier(bar); }
        if ((KB_REP >> 10) & 1) { unsigned char* ws = WSP; pg8::Gemm g{(const bf16*)(ws + BIG_H), (const bf16*)(ws + W_F1OUT), M, DM, DFF}; pg8::StaticOrder S; S.init(M, DM, LG(G), LG(bx));
            EpiResid E{(bf16*)(ws + WS_BIG + 384 * MiB), (ssq_t*)(ws + WS_BIG + 770 * MiB), (ssq_t*)(ws + WS_BIG + 771 * MiB), 0.5f};
            pg8::gemm_phase<EpiResid, pg8::StaticOrder, true, true>(ring, g, S, E, LG(wave0)); xcd_barrier(bar); }
        if (!isret) {
for (int rep_ = 0; rep_ < REPS(2); ++rep_) { if (rep_) xcd_barrier(bar);
            if (RUN(pb + 3)) { PH_IDS unsigned char* ws = WSP; s5_pass<1>((const bf16*)(ws + WS_XHAT), (const ssq_t*)(ws + WS_SSQ) + M, INF(3) + ((size_t)L * 4 + 1) * DM, INF(17) + (size_t)j * DM, ws + (size_t)j * S5T_STRIDE, (float*)(ws + BIG_ES), (bf16*)(ws + BIG_YB), ring, LG(vcu), LG(G), tid); }
            SEAM(pb + 3);
            if (RUN(pb + 4)) { PH_IDS unsigned char* ws = WSP; s5_carry((float*)(ws + BIG_ES), ws + (size_t)j * S5T_STRIDE, gt, NGT);
                for (int set = 0; set < 2; ++set) {
                    { pg8::Gemm g{(const bf16*)(ws + WS_MEMN), (const bf16*)(ws + W_XK + set * W_XKV_SET), MMEM, DM, DM}; pg8::StaticOrder S; S.init(MMEM, DM, LG(G), (LG(bx) + (2 * set) * (LG(G) / 4)) % LG(G)); EpiBf16<0> E{(bf16*)(ws + WS_XK + set * XKV_SET), DM, nullptr};
                      pg8::gemm_phase<EpiBf16<0>, pg8::StaticOrder, true, true>(ring, g, S, E, LG(wave0)); }
                    { pg8::Gemm g{(const bf16*)(ws + W_XV + set * W_XKV_SET), (const bf16*)(ws + WS_MEMNP), DM, MMEM, DM}; pg8::StaticOrder S; S.init(DM, MMEM, LG(G), (LG(bx) + (2 * set + 1) * (LG(G) / 4)) % LG(G)); EpiBf16<0> E{(bf16*)(ws + WS_XVT + set * XKV_SET), MMEM, nullptr};
                      pg8::gemm_phase<EpiBf16<0>, pg8::StaticOrder, true, true>(ring, g, S, E, LG(wave0)); } } }
            SEAM(pb + 4);
            if (RUN(pb + 5)) { PH_IDS unsigned char* ws = WSP; s5_pass<3>((const bf16*)(ws + WS_XHAT), (const ssq_t*)(ws + WS_SSQ) + M, INF(3) + ((size_t)L * 4 + 1) * DM, INF(17) + (size_t)j * DM, ws + (size_t)j * S5T_STRIDE, (float*)(ws + BIG_ES), (bf16*)(ws + BIG_YB), ring, LG(vcu), LG(G), tid); }
}
            SEAM(pb + 5);
            if (RUN(pb + 6)) { unsigned char* ws = WSP; ssq_t* SS0 = (ssq_t*)(ws + WS_SSQ);
                pg8::Gemm g{(const bf16*)(ws + BIG_YB), (const bf16*)(ws + W_MIX), M, 2 * DM, DM}; pg8::StaticOrder S; S.init(M, 2 * DM, LG(G), LG(bx)); EpiS5Glu E{(bf16*)(ws + WS_XHAT), SS0, SS0 + M};
                pg8::gemm_phase<EpiS5Glu, pg8::StaticOrder, true, true>(ring, g, S, E, LG(wave0)); }
            SEAM(pb + 6);
        } else {
for (int rep_ = 0; rep_ < REPS(3); ++rep_) { if (rep_) xcd_barrier(bar);
            if (RUN(pb + 3)) { unsigned char* ws = WSP;
                { pg8::Gemm g{(const bf16*)(ws + WS_XHAT), (const bf16*)(ws + W_MIX), M, 2 * DM, DM}; pg8::StaticOrder S; S.init(M, 2 * DM, LG(G), LG(bx));
                  EpiRetIn E{(bf16*)(ws + BIG_RQ), (bf16*)(ws + BIG_RK), (const ssq_t*)(ws + WS_SSQ) + M, (const float*)(ws + WS_ROT), (const int*)PTR(2)};
                  pg8::gemm_phase<EpiRetIn, pg8::StaticOrder, true, true>(ring, g, S, E, LG(wave0)); }
                { pg8::Gemm g{(const bf16*)(ws + W_MIX) + (size_t)(2 * DM) * DM, (const bf16*)(ws + WS_XHAT), RVW, M, DM}; pg8::StaticOrder S; S.init(RVW, M, LG(G), LG(bx));
                  EpiRetVT E{(bf16*)(ws + BIG_RVT), (const ssq_t*)(ws + WS_SSQ) + M};
                  pg8::gemm_phase<EpiRetVT, pg8::StaticOrder, true, true>(ring, g, S, E, LG(wave0)); } }
}
            SEAM(pb + 3);
            for (int rep_ = 0; rep_ < REPS(4); ++rep_) { if (rep_) xcd_barrier(bar);
#if defined(KB_RET_STUB)
            if (RUN(pb + 4)) { PH_IDS unsigned char* ws = WSP; bf16* ro = (bf16*)(ws + BIG_RO); const bf16* rq = (const bf16*)(ws + (KB_RET_STUB == 1 ? BIG_RQ : BIG_RK)); float* rst = (float*)(ws + BIG_RST);
                for (size_t i = gt; i < (size_t)M * RVW / 8; i += NGT) { const size_t row = i / (RVW / 8), c8 = i % (RVW / 8); u32x4 v;
                    if (KB_RET_STUB == 3) v = *(const u32x4*)((const bf16*)(ws + BIG_RVT) + (c8 * 8) * (size_t)M / 8 * 8 + row / 8 * 8 + 0) ; else v = *(const u32x4*)(rq + row * DM + (c8 & 127) * 8);
                    *(u32x4*)(ro + i * 8) = v; }
                for (size_t i = gt; i < (size_t)M * RH * 8; i += NGT) { rst[2 * i] = 0.f; rst[2 * i + 1] = 64.f; } }
#else
            if (RUN(pb + 4)) { PH_IDS unsigned char* ws = WSP;

                ret_core((const bf16*)(ws + BIG_RQ), (const bf16*)(ws + BIG_RK), (const bf16*)(ws + BIG_RVT), (bf16*)(ws + BIG_RO), (float*)(ws + BIG_RST), ring, LG(vcu), LG(G), tid); }
#endif
}
#ifdef KB_PROBE_SKIP
            { xcd_barrier(bar); PH_IDS unsigned char* ws = WSP; ret_core<KB_PROBE_SKIP>((const bf16*)(ws + BIG_RQ), (const bf16*)(ws + BIG_RK), (const bf16*)(ws + BIG_RVT), (bf16*)OUTP, (float*)((char*)OUTP + 0), ring, LG(vcu), LG(G), tid); }
#endif
            SEAM(pb + 4);
            if (RUN(pb + 5)) { unsigned char* ws = WSP;
                pg8::Gemm g{(const bf16*)(ws + WS_XHAT), (const bf16*)(ws + W_MIX) + (size_t)(2 * DM + RVW) * DM, M, RVW, DM}; pg8::StaticOrder S; S.init(M, RVW, LG(G), LG(bx));
                EpiRetGate E{(bf16*)(ws + BIG_RO), (const ssq_t*)(ws + WS_SSQ) + M, (const float*)(ws + BIG_RST)};
                pg8::gemm_phase<EpiRetGate, pg8::StaticOrder, true, true>(ring, g, S, E, LG(wave0)); }
            SEAM(pb + 5);
            if (RUN(pb + 6)) { unsigned char* ws = WSP; ssq_t* SS0 = (ssq_t*)(ws + WS_SSQ);
                pg8::Gemm g{(const bf16*)(ws + BIG_RO), (const bf16*)(ws + W_ROUT), M, DM, RVW}; pg8::StaticOrder S; S.init(M, DM, LG(G), LG(bx)); EpiResid E{(bf16*)(ws + WS_XHAT), SS0, SS0 + M, 1.0f};
                pg8::gemm_phase<EpiResid, pg8::StaticOrder, true, true>(ring, g, S, E, LG(wave0)); }
            SEAM(pb + 6);
        }
for (int rep_ = 0; rep_ < REPS(5); ++rep_) { if (rep_) xcd_barrier(bar);
        if (RUN(pb + 7)) { unsigned char* ws = WSP;
            pg8::Gemm g{(const bf16*)(ws + WS_XHAT), (const bf16*)(ws + W_XQ), M, DM, DM}; pg8::StaticOrder S; S.init(M, DM, LG(G), LG(bx));
            EpiBf16<1> E{(bf16*)(ws + BIG_XQ), DM, (const ssq_t*)(ws + WS_SSQ)}; pg8::gemm_phase<EpiBf16<1>, pg8::StaticOrder, true, true>(ring, g, S, E, LG(wave0)); }
}
        SEAM(pb + 7);
for (int rep_ = 0; rep_ < REPS(6); ++rep_) { if (rep_) xcd_barrier(bar);
        if (RUN(pb + 8)) { PH_IDS unsigned char* ws = WSP; xattn_core((const bf16*)(ws + BIG_XQ), (const bf16*)(ws + WS_XK + (L & 1) * XKV_SET), (const bf16*)(ws + WS_XVT + (L & 1) * XKV_SET), (bf16*)(ws + BIG_XO), ring, LG(vcu), LG(G), tid); }
}
        SEAM(pb + 8);
        if (RUN(pb + 9)) { unsigned char* ws = WSP; ssq_t* SS0 = (ssq_t*)(ws + WS_SSQ);
            pg8::Gemm g{(const bf16*)(ws + BIG_XO), (const bf16*)(ws + W_XO), M, DM, DM}; pg8::StaticOrder S; S.init(M, DM, LG(G), LG(bx)); EpiResid E{(bf16*)(ws + WS_XHAT), SS0 + M, SS0, 1.0f};
            pg8::gemm_phase<EpiResid, pg8::StaticOrder, true, true>(ring, g, S, E, LG(wave0)); }
        SEAM(pb + 9);
for (int rep_ = 0; rep_ < REPS(7); ++rep_) { if (rep_) xcd_barrier(bar);
        if (RUN(pb + 10)) { unsigned char* ws = WSP; ssq_t* SS0 = (ssq_t*)(ws + WS_SSQ);
            for (int hb = 0; hb < KB_FFN_SPLIT; ++hb) { const size_t r0 = (size_t)hb * (M / KB_FFN_SPLIT);
                { pg8::Gemm g{(const bf16*)(ws + WS_XHAT) + r0 * DM, (const bf16*)(ws + W_F2IN), M / KB_FFN_SPLIT, 2 * DFF, DM}; pg8::StaticOrder S; S.init(M / KB_FFN_SPLIT, 2 * DFF, LG(G), LG(bx)); EpiSwiGLU E{(bf16*)(ws + BIG_H) + r0 * DFF, (SS0 + M) + r0};
                  pg8::gemm_phase<EpiSwiGLU, pg8::StaticOrder, true, true>(ring, g, S, E, LG(wave0)); }
                if (hb + 1 < KB_FFN_SPLIT) { xcd_barrier(bar);
                    pg8::Gemm g{(const bf16*)(ws + BIG_H) + r0 * DFF, (const bf16*)(ws + W_F2OUT), M / KB_FFN_SPLIT, DM, DFF}; pg8::StaticOrder S; S.init(M / KB_FFN_SPLIT, DM, LG(G), LG(bx)); EpiResid E{(bf16*)(ws + WS_XHAT) + r0 * DM, SS0 + r0, (SS0 + M) + r0, 0.5f};
                    pg8::gemm_phase<EpiResid, pg8::StaticOrder, true, true>(ring, g, S, E, LG(wave0)); xcd_barrier(bar); } }
        }
}
        SEAM(pb + 10);
        if (RUN(pb + 11)) { unsigned char* ws = WSP; ssq_t* SS0 = (ssq_t*)(ws + WS_SSQ); const size_t r0 = (size_t)(KB_FFN_SPLIT - 1) * (M / KB_FFN_SPLIT);
            pg8::Gemm g{(const bf16*)(ws + BIG_H) + r0 * DFF, (const bf16*)(ws + W_F2OUT), M / KB_FFN_SPLIT, DM, DFF}; pg8::StaticOrder S; S.init(M / KB_FFN_SPLIT, DM, LG(G), LG(bx)); EpiResid E{(bf16*)(ws + WS_XHAT) + r0 * DM, SS0 + r0, (SS0 + M) + r0, 0.5f};
            pg8::gemm_phase<EpiResid, pg8::StaticOrder, true, true>(ring, g, S, E, LG(wave0)); }
        SEAM(pb + 11);
    }
    for (int rep_ = 0; rep_ < REPS(12); ++rep_) { if (rep_) xcd_barrier(bar);
    if (RUN(PH_FINAL)) { PH_IDS unsigned char* ws = WSP; float* out = OUTP; final_rows((const bf16*)(ws + WS_XHAT), (const ssq_t*)(ws + WS_SSQ) + KB_FINAL_SS * M, INF(5), out, gw, NGW, lane); }
    }
#undef RUN
#undef SEAM
#undef bar
}

extern "C" void kernel_launch(void* const* d_in, const int* in_sizes, int n_in, void* d_out, int out_size, void* d_ws, size_t ws_size, hipStream_t stream) {
    static int grid = 0;
    if (grid == 0) {
        if (n_in != 24 || in_sizes[0] != M * DM || out_size != M * DM || ws_size < WS_END) { fprintf(stderr, "kernel_launch: unexpected shapes / workspace (n_in %d, ws %zu, need %zu)\n", n_in, ws_size, (size_t)WS_END); grid = -1; return; }
        int dev = 0, cus = 0, per_cu = 0;
        if (hipGetDevice(&dev) != hipSuccess || hipDeviceGetAttribute(&cus, hipDeviceAttributeMultiprocessorCount, dev) != hipSuccess) { grid = -1; return; }
        if (hipFuncSetAttribute((const void*)hybrid_fwd, hipFuncAttributeMaxDynamicSharedMemorySize, LDS_BYTES) != hipSuccess) { fprintf(stderr, "kernel_launch: hipFuncSetAttribute failed\n"); grid = -1; return; }
        if (hipOccupancyMaxActiveBlocksPerMultiprocessor(&per_cu, (const void*)hybrid_fwd, NWAVES * 64, LDS_BYTES) != hipSuccess || per_cu < 1) { fprintf(stderr, "kernel_launch: occupancy query says %d blocks per CU\n", per_cu); }
        (void)hipGetLastError();
        grid = cus;
    }
    if (grid < 0) return;
    if (hipMemsetAsync((char*)d_ws + WS_CTL, 0, CTL_ZERO_BYTES, stream) != hipSuccess) return;
    Args a{};
    for (int i = 0; i < 24; ++i) a.in[i] = d_in[i];
    a.out = (float*)d_out; a.ws = (unsigned char*)d_ws; a.pad = 0;
#if MK_PER_PHASE
    for (int p = 0; p < N_PHASES; ++p) { a.ph_lo = p; a.ph_hi = p + 1; a.li = 0; hipLaunchKernelGGL(hybrid_fwd, dim3(grid), dim3(NWAVES * 64), LDS_BYTES, stream, a); }
#else
    a.ph_lo = 0; a.ph_hi = N_PHASES; a.li = 0;
    hipLaunchKernelGGL(hybrid_fwd, dim3(grid), dim3(NWAVES * 64), LDS_BYTES, stream, a);
#endif
}
#endif
```

```cpp
#ifndef HOST_EMU
#include <hip/hip_runtime.h>
#include <cstdio>
#include <cstdint>
#define LAS __attribute__((address_space(3)))
#define GAS __attribute__((address_space(1)))
#define DEV __device__ __forceinline__
#else
#include "emu.h"
#define LAS
#define GAS
#define DEV inline
#endif

#ifndef KB_BATCH
#define KB_BATCH 8
#endif
#ifndef KB_SEQ
#define KB_SEQ 8192
#endif
constexpr int BATCH = KB_BATCH, SEQ = KB_SEQ, DM = 1024, DEPTH = 4, NMEM = 256, DFF = 2816;
constexpr int M = BATCH * SEQ;
constexpr int MMEM = BATCH * NMEM;
constexpr int S5G = 64, S5P = 64, S5H = 16;
constexpr int S5_NCH = 64;
constexpr int S5_LC = SEQ / S5_NCH;
constexpr int RH = 4, RDK = 256, RDV = 512, RVW = RH * RDV, RIN = 2 * DM + 2 * RVW;
constexpr int RMC = 256;
constexpr int XH = 4, XD = 256;
constexpr int ROT_NPOS = 12288;
constexpr float EPS = 1e-6f;
constexpr int SSQW = 32;

typedef unsigned short bf16;
typedef short bf16x8 __attribute__((ext_vector_type(8)));
typedef short s16x4 __attribute__((ext_vector_type(4)));
typedef float f32x4 __attribute__((ext_vector_type(4)));
typedef float f32x2 __attribute__((ext_vector_type(2)));
typedef float f32x16 __attribute__((ext_vector_type(16)));
typedef unsigned u32x4 __attribute__((ext_vector_type(4)));
typedef unsigned u32x2 __attribute__((ext_vector_type(2)));

DEV unsigned f2bf(float f) { unsigned u = __builtin_bit_cast(unsigned, f); return (u + 0x7fffu + ((u >> 16) & 1u)) >> 16; }
DEV float bf2f(unsigned h) { return __builtin_bit_cast(float, (h & 0xffffu) << 16); }
DEV float bflo(unsigned w) { return __builtin_bit_cast(float, w << 16); }
DEV float bfhi(unsigned w) { return __builtin_bit_cast(float, w & 0xffff0000u); }
#ifndef HOST_EMU
typedef __bf16 bf16v2_t __attribute__((ext_vector_type(2)));
DEV unsigned pk2(float lo, float hi) { const f32x2 v = {lo, hi}; const bf16v2_t b = __builtin_convertvector(v, bf16v2_t); return __builtin_bit_cast(unsigned, b); }
DEV float fexp2(float x) { return __builtin_amdgcn_exp2f(x); }
DEV float frcp(float x) { return __builtin_amdgcn_rcpf(x); }
DEV float frsq(float x) { return __builtin_amdgcn_rsqf(x); }
#define MFMA32(a, b, c) __builtin_amdgcn_mfma_f32_32x32x16_bf16(a, b, c, 0, 0, 0)
#define MFMA16K16(a, b, c) __builtin_amdgcn_mfma_f32_16x16x16bf16_1k(a, b, c, 0, 0, 0)
#else
DEV unsigned pk2(float lo, float hi) { return f2bf(lo) | (f2bf(hi) << 16); }
DEV float fexp2(float x) { return exp2f(x); }
DEV float frcp(float x) { return 1.0f / x; }
DEV float frsq(float x) { return 1.0f / sqrtf(x); }
#define MFMA32(a, b, c) emu_mfma32(a, b, c)
#define MFMA16K16(a, b, c) emu_mfma16k16(a, b, c)
#endif
DEV float sigmoidf_(float x) { return frcp(1.0f + fexp2(-1.4426950408889634f * x)); }
DEV float siluf_(float x) { return x * sigmoidf_(x); }
DEV float gelu_tanh(float x) { const float u = 0.7978845608028654f * (x + 0.044715f * x * x * x); return x * sigmoidf_(2.0f * u); }
DEV int pos16(int n) { return (n & 3) | ((n & 4) << 1) | ((n & 8) >> 1); }
DEV int rowmap32(int reg, int hh) { return (reg & 3) + 8 * (reg >> 2) + 4 * hh; }
DEV bf16x8 pack8(float a0, float a1, float a2, float a3, float a4, float a5, float a6, float a7) {
    u32x4 w; w.x = pk2(a0, a1); w.y = pk2(a2, a3); w.z = pk2(a4, a5); w.w = pk2(a6, a7); return __builtin_bit_cast(bf16x8, w); }
DEV s16x4 pack4(float a0, float a1, float a2, float a3) { u32x2 w; w.x = pk2(a0, a1); w.y = pk2(a2, a3); return __builtin_bit_cast(s16x4, w); }
DEV float wave_sum(float v) {
#pragma unroll
    for (int o = 1; o < 64; o <<= 1) v += __shfl_xor(v, o);
    return v;
}

constexpr size_t MiB = 1u << 20;
constexpr size_t WS_CTL = 0, CTL_ZERO_BYTES = 1 * MiB;
constexpr size_t WS_W = 1 * MiB;
constexpr size_t W_F1IN = WS_W, W_F1OUT = W_F1IN + (size_t)2 * DFF * DM * 2, W_F2IN = W_F1OUT + (size_t)DM * DFF * 2, W_F2OUT = W_F2IN + (size_t)2 * DFF * DM * 2;
constexpr size_t W_MIX = W_F2OUT + (size_t)DM * DFF * 2;
constexpr size_t W_ROUT = W_MIX + (size_t)RIN * DM * 2;
constexpr size_t W_XQ = W_ROUT + (size_t)DM * RVW * 2, W_XO = W_XQ + (size_t)DM * DM * 2, W_XK = W_XO + (size_t)DM * DM * 2, W_XV = W_XK + (size_t)DM * DM * 2;
constexpr size_t W_XKV_SET = (size_t)2 * DM * DM * 2;
constexpr size_t W_END = W_XV + (size_t)DM * DM * 2 + W_XKV_SET;
static_assert(W_END <= 65 * MiB, "weight region");
constexpr size_t WS_S5T = 65 * MiB, S5T_STRIDE = 1 * MiB;
constexpr size_t S5T_BBAR = WS_S5T, S5T_CT = S5T_BBAR + (size_t)S5G * 2 * S5P * S5H * 2, S5T_A = S5T_CT + (size_t)S5G * 2 * S5H * S5P * 2, S5T_AL = S5T_A + (size_t)S5G * S5P * 2 * 4;
static_assert(S5T_AL + (size_t)S5G * S5P * 2 * 4 <= WS_S5T + S5T_STRIDE, "s5 tables");
constexpr size_t WS_ROT = 67 * MiB;
static_assert((size_t)ROT_NPOS * 128 * 8 <= 13 * MiB, "rot table");
constexpr size_t WS_MEMN = 80 * MiB, WS_MEMNP = 84 * MiB;
constexpr size_t WS_XK = 88 * MiB, WS_XVT = 96 * MiB, XKV_SET = 4 * MiB;
constexpr size_t WS_SSQ = 104 * MiB;
constexpr size_t WS_XHAT = 105 * MiB;
constexpr size_t WS_BIG = 233 * MiB;
constexpr size_t BIG_H = WS_BIG;
constexpr size_t BIG_YB = WS_BIG, BIG_ES = WS_BIG + 128 * MiB;
constexpr size_t BIG_RQ = WS_BIG, BIG_RK = WS_BIG + 128 * MiB, BIG_RVT = WS_BIG + 256 * MiB, BIG_RO = WS_BIG + 512 * MiB, BIG_RST = WS_BIG + 768 * MiB;
constexpr size_t BIG_XQ = WS_BIG, BIG_XO = WS_BIG + 128 * MiB;
constexpr size_t WS_END = WS_BIG + 784 * MiB;
static_assert(WS_END <= (size_t)1024 * MiB, "workspace map");
#ifndef HOST_EMU
namespace pg8 {
#define PG8_LAS __attribute__((address_space(3)))
typedef unsigned short bf16_t;
typedef short bf16x8 __attribute__((ext_vector_type(8)));
typedef float f32x4 __attribute__((ext_vector_type(4)));
typedef unsigned u32x4 __attribute__((ext_vector_type(4)));
constexpr int BM = 256, BK = 64, HALF = 128, HTB = HALF * BK * 2  , STAGE_BYTES = 8 * HTB, NXCD = 8, WGM = 8;

__host__ __device__ __forceinline__ int lds_byte(int r, int c) { const int st = (r >> 4) * 2 + (c >> 5), rr = r & 15, cc = c & 31, ob = rr * 64 + cc * 2; return st * 1024 + (ob ^ (((ob >> 9) & 1) << 5)); }
__host__ __device__ __forceinline__ void stage_rc(int b, int& R, int& C) { const int st = b / 1024, sb = b % 1024, swz = sb ^ (((sb >> 9) & 1) << 5); R = (st >> 1) * 16 + swz / 64; C = (st & 1) * 32 + (swz % 64) / 2; }
__host__ __device__ __forceinline__ int perm32(int rho) { const int n = rho >> 4, i = rho & 15; return 8 * (i >> 2) + 4 * n + (i & 3); }

struct Unit { int pm, pn; };
struct Gemm { const bf16_t* A; const bf16_t* Bt; int M, N, K; int ld = 0; };

struct StaticOrder {
    int nM, nN, nwg, G, c;
    __host__ __device__ void init(int M, int N, int G_, int c_) { nM = M / BM; nN = N / BM; nwg = nM * nN; G = G_; c = c_; }
    __host__ __device__ bool next(int i, Unit& u) const {
        const long L = (long)i * G + c; if (L >= nwg) return false;
        int wgid = (int)L; { const int q = nwg / NXCD, r = nwg % NXCD, xcd = wgid % NXCD, off = wgid / NXCD; wgid = (xcd < r ? xcd * (q + 1) : r * (q + 1) + (xcd - r) * q) + off; }
        const int nig = WGM * nN, gid = wgid / nig, fm = gid * WGM, gsz = (nM - fm) < WGM ? (nM - fm) : WGM;
        u.pm = fm + ((wgid % nig) % gsz); u.pn = (wgid % nig) / gsz; return true;
    }
    __device__ __forceinline__ void a_ready(const Unit&) const {}
    __device__ __forceinline__ void done(const Unit&) const {}
};
}
#endif
#ifdef HOST_EMU
namespace pg8 { struct Unit { int pm, pn; }; constexpr int BM = 256, HALF = 128; }
#endif
typedef f32x4 AccT[2][2][4][2];
#if !defined(HOST_EMU) && defined(KB_NT_H)
#define NT_STORE16(p, v) __builtin_nontemporal_store((v), (p))
#else
#define NT_STORE16(p, v) (*(p) = (v))
#endif
#ifndef HOST_EMU
#define EPI_OPAQUE(a, b) asm volatile("" : "+v"(a), "+v"(b))
#else
#define EPI_OPAQUE(a, b) do {} while (0)
#endif

typedef unsigned long long ssq_t;
constexpr float SSQ_SCALE = 1048576.0f, SSQ_INV = 1.0f / 1048576.0f;
DEV ssq_t ss_fix(float v) { return (ssq_t)(v * SSQ_SCALE + 0.5f); }
DEV float ss_val(ssq_t v) { return (float)v * SSQ_INV; }
#ifndef HOST_EMU
DEV ssq_t zero64() { unsigned lo = 0u, hi = 0u; asm volatile("" : "+v"(lo), "+v"(hi)); return ((ssq_t)hi << 32) | lo; }
#else
DEV ssq_t zero64() { return 0ull; }
#endif
DEV void row_rstd(const ssq_t* ss, int row0, float (&rs)[2][4]) {
#pragma unroll
    for (int ai = 0; ai < 2; ++ai)
#pragma unroll
        for (int m = 0; m < 4; ++m) rs[ai][m] = frsq(ss_val(ss[row0 + 128 * ai + 16 * m]) * (1.0f / DM) + EPS);
}
#ifndef HOST_EMU
DEV void ss_add(ssq_t* p, float v) { atomicAdd(p, ss_fix(v)); }
#else
#include <mutex>
static std::mutex e_atomic_mtx;
DEV void ss_add(ssq_t* p, float v) { std::lock_guard<std::mutex> g(e_atomic_mtx); *p += ss_fix(v); }
#endif

struct EpiResid {
    static constexpr bool PERM = true, AFTER_DRAIN = false;
    bf16* xh; ssq_t* ss_acc; ssq_t* ss_zero; float scale;
    DEV void operator()(const AccT& acc, const pg8::Unit& u, int wr, int wc, int fr, int fq) const {
        EPI_OPAQUE(fr, fq);
        const int row0 = u.pm * 256 + wr * 64 + fr, col0 = u.pn * 256 + wc * 32 + 8 * fq;
#pragma unroll
        for (int ai = 0; ai < 2; ++ai)
#pragma unroll
            for (int m = 0; m < 4; ++m) { const int row = row0 + 128 * ai + 16 * m; bf16* rowp = xh + (size_t)row * DM + col0; float ss = 0.f;
#pragma unroll
                for (int bj = 0; bj < 2; ++bj) { const u32x4 b = *(const u32x4*)(rowp + 128 * bj); const f32x4 a0 = acc[ai][bj][m][0] * scale, a1 = acc[ai][bj][m][1] * scale;
                    u32x4 w; w.x = pk2(bflo(b.x) + a0[0], bfhi(b.x) + a0[1]); w.y = pk2(bflo(b.y) + a0[2], bfhi(b.y) + a0[3]); w.z = pk2(bflo(b.z) + a1[0], bfhi(b.z) + a1[1]); w.w = pk2(bflo(b.w) + a1[2], bfhi(b.w) + a1[3]);
                    *(u32x4*)(rowp + 128 * bj) = w;
                    const float o0 = bflo(w.x), o1 = bfhi(w.x), o2 = bflo(w.y), o3 = bfhi(w.y), o4 = bflo(w.z), o5 = bfhi(w.z), o6 = bflo(w.w), o7 = bfhi(w.w);
                    ss += ((o0 * o0 + o1 * o1) + (o2 * o2 + o3 * o3)) + ((o4 * o4 + o5 * o5) + (o6 * o6 + o7 * o7)); }
                ss += __shfl_xor(ss, 16); ss += __shfl_xor(ss, 32);
                if (fq == 0) { ss_add(ss_acc + row, ss); ss_zero[row] = zero64(); }
            }
    }
};
struct EpiS5Glu {
    static constexpr bool PERM = true, AFTER_DRAIN = false;
    bf16* xh; ssq_t* ss_acc; ssq_t* ss_zero;
    DEV void operator()(const AccT& acc, const pg8::Unit& u, int wr, int wc, int fr, int fq) const {
        EPI_OPAQUE(fr, fq);
        const int row0 = u.pm * 256 + wr * 64 + fr, col0 = u.pn * 128 + wc * 32 + 8 * fq;
#pragma unroll
        for (int ai = 0; ai < 2; ++ai)
#pragma unroll
            for (int m = 0; m < 4; ++m) { const int row = row0 + 128 * ai + 16 * m; bf16* rowp = xh + (size_t)row * DM + col0;
                const u32x4 b = *(const u32x4*)rowp; const float bb[8] = {bflo(b.x), bfhi(b.x), bflo(b.y), bfhi(b.y), bflo(b.z), bfhi(b.z), bflo(b.w), bfhi(b.w)}; float o[8];
#pragma unroll
                for (int n = 0; n < 2; ++n)
#pragma unroll
                    for (int e = 0; e < 4; ++e) o[4 * n + e] = bb[4 * n + e] + acc[ai][0][m][n][e] * sigmoidf_(acc[ai][1][m][n][e]);
                u32x4 w; w.x = pk2(o[0], o[1]); w.y = pk2(o[2], o[3]); w.z = pk2(o[4], o[5]); w.w = pk2(o[6], o[7]);
                *(u32x4*)rowp = w;
                const float o0 = bflo(w.x), o1 = bfhi(w.x), o2 = bflo(w.y), o3 = bfhi(w.y), o4 = bflo(w.z), o5 = bfhi(w.z), o6 = bflo(w.w), o7 = bfhi(w.w);
                float ss = ((o0 * o0 + o1 * o1) + (o2 * o2 + o3 * o3)) + ((o4 * o4 + o5 * o5) + (o6 * o6 + o7 * o7));
                ss += __shfl_xor(ss, 16); ss += __shfl_xor(ss, 32);
                if (fq == 0) { ss_add(ss_acc + row, ss); ss_zero[row] = zero64(); }
            }
    }
};
struct EpiSwiGLU {
    static constexpr bool PERM = true, AFTER_DRAIN = false;
    bf16* H; const ssq_t* ssq;
    DEV void operator()(const AccT& acc, const pg8::Unit& u, int wr, int wc, int fr, int fq) const {
        EPI_OPAQUE(fr, fq);
        const int row0 = u.pm * 256 + wr * 64 + fr, col0 = u.pn * 128 + wc * 32 + 8 * fq;
        float rs[2][4]; row_rstd(ssq, row0, rs);
#pragma unroll
        for (int ai = 0; ai < 2; ++ai)
#pragma unroll
            for (int m = 0; m < 4; ++m) { const float r = rs[ai][m]; float h[8];
#pragma unroll
                for (int n = 0; n < 2; ++n)
#pragma unroll
                    for (int e = 0; e < 4; ++e) { const float a = acc[ai][0][m][n][e] * r, b = acc[ai][1][m][n][e] * r; h[4 * n + e] = siluf_(a) * b; }
                u32x4 w; w.x = pk2(h[0], h[1]); w.y = pk2(h[2], h[3]); w.z = pk2(h[4], h[5]); w.w = pk2(h[6], h[7]);
                NT_STORE16((u32x4*)(H + (size_t)(row0 + 128 * ai + 16 * m) * DFF + col0), w); }
    }
};
template <int NSLOT> struct EpiBf16 {
    static constexpr bool PERM = true, AFTER_DRAIN = false;
    bf16* O; int ldc; const ssq_t* ssq;
    DEV void operator()(const AccT& acc, const pg8::Unit& u, int wr, int wc, int fr, int fq) const {
        EPI_OPAQUE(fr, fq);
        const int row0 = u.pm * 256 + wr * 64 + fr, col0 = u.pn * 256 + wc * 32 + 8 * fq;
        float rs[2][4];
        if constexpr (NSLOT > 0) row_rstd(ssq, row0, rs);
#pragma unroll
        for (int ai = 0; ai < 2; ++ai)
#pragma unroll
            for (int m = 0; m < 4; ++m) { const float r = NSLOT > 0 ? rs[ai][m] : 1.0f; bf16* rowp = O + (size_t)(row0 + 128 * ai + 16 * m) * ldc + col0;
#pragma unroll
                for (int bj = 0; bj < 2; ++bj) { const f32x4 v0 = acc[ai][bj][m][0] * r, v1 = acc[ai][bj][m][1] * r;
                    u32x4 w; w.x = pk2(v0[0], v0[1]); w.y = pk2(v0[2], v0[3]); w.z = pk2(v1[0], v1[1]); w.w = pk2(v1[2], v1[3]);
                    *(u32x4*)(rowp + 128 * bj) = w; } }
    }
};
struct EpiRetIn {
    static constexpr bool PERM = true, AFTER_DRAIN = false;
    bf16 *Q, *K; const ssq_t* ssq; const float* rot; const int* positions;
    DEV void operator()(const AccT& acc, const pg8::Unit& u, int wr, int wc, int fr, int fq) const {
        EPI_OPAQUE(fr, fq);
        const int row0 = u.pm * 256 + wr * 64 + fr, pn = u.pn;
        float rs[2][4]; row_rstd(ssq, row0, rs);
        {
            const int h = pn & 3; const bool isk = pn >= 4; bf16* dst = isk ? K : Q;
            const float lg = log2f(1.0f - exp2f(-5.0f - (float)h)); const int d0 = wc * 32 + 8 * fq;
#pragma unroll
            for (int ai = 0; ai < 2; ++ai)
#pragma unroll
                for (int m = 0; m < 4; ++m) { const int row = row0 + 128 * ai + 16 * m; const int i256 = row & (RMC - 1);
                    const float sc = rs[ai][m] * (isk ? fexp2(-lg * (float)i256) * 0.0625f : fexp2(lg * (float)i256));
                    const float* rp = rot + ((size_t)positions[row] * 128 + d0) * 2;
                    const f32x4 r0 = *(const f32x4*)rp, r1 = *(const f32x4*)(rp + 4), r2 = *(const f32x4*)(rp + 8), r3 = *(const f32x4*)(rp + 12);
                    const float cs[8] = {r0[0], r0[2], r1[0], r1[2], r2[0], r2[2], r3[0], r3[2]}, sn[8] = {r0[1], r0[3], r1[1], r1[3], r2[1], r2[3], r3[1], r3[3]};
                    float o1[8], o2[8];
#pragma unroll
                    for (int n = 0; n < 2; ++n)
#pragma unroll
                        for (int e = 0; e < 4; ++e) { const float t1 = acc[ai][0][m][n][e] * sc, t2 = acc[ai][1][m][n][e] * sc; const int j = 4 * n + e;
                            o1[j] = t1 * cs[j] - t2 * sn[j]; o2[j] = t1 * sn[j] + t2 * cs[j]; }
                    u32x4 w1, w2; w1.x = pk2(o1[0], o1[1]); w1.y = pk2(o1[2], o1[3]); w1.z = pk2(o1[4], o1[5]); w1.w = pk2(o1[6], o1[7]);
                    w2.x = pk2(o2[0], o2[1]); w2.y = pk2(o2[2], o2[3]); w2.z = pk2(o2[4], o2[5]); w2.w = pk2(o2[6], o2[7]);
                    bf16* p = dst + (size_t)row * DM + 256 * h + d0; *(u32x4*)p = w1; *(u32x4*)(p + 128) = w2; }
        }
    }
};
struct EpiRetGate {
    static constexpr bool PERM = true, AFTER_DRAIN = false;
    bf16* O; const ssq_t* ssq; const float* stat;
    DEV void operator()(const AccT& acc, const pg8::Unit& u, int wr, int wc, int fr, int fq) const {
        EPI_OPAQUE(fr, fq);
        const int row0 = u.pm * 256 + wr * 64 + fr, h = u.pn >> 1, col0 = u.pn * 256 + wc * 32 + 8 * fq;
        float rs[2][4]; row_rstd(ssq, row0, rs);
#pragma unroll
        for (int ai = 0; ai < 2; ++ai)
#pragma unroll
            for (int m = 0; m < 4; ++m) { const int row = row0 + 128 * ai + 16 * m; const float r = rs[ai][m];
                const f32x4 st = *(const f32x4*)(stat + ((size_t)row * RH + h) * 16 + 4 * fq);
                float s1 = st[0] + st[2], s2 = st[1] + st[3];
                s1 += __shfl_xor(s1, 16); s1 += __shfl_xor(s1, 32); s2 += __shfl_xor(s2, 16); s2 += __shfl_xor(s2, 32);
                const float mu = s1 * (1.0f / RDV), var = fmaxf(s2 * (1.0f / RDV) - mu * mu, 0.0f), rg = frsq(var + EPS);
                bf16* rowp = O + (size_t)row * RVW + col0;
#pragma unroll
                for (int bj = 0; bj < 2; ++bj) { const u32x4 ow = *(const u32x4*)(rowp + 128 * bj);
                    const float o[8] = {bflo(ow.x), bfhi(ow.x), bflo(ow.y), bfhi(ow.y), bflo(ow.z), bfhi(ow.z), bflo(ow.w), bfhi(ow.w)}; float y[8];
#pragma unroll
                    for (int n = 0; n < 2; ++n)
#pragma unroll
                        for (int e = 0; e < 4; ++e) { const int j = 4 * n + e; y[j] = siluf_(acc[ai][bj][m][n][e] * r) * ((o[j] - mu) * rg); }
                    u32x4 w; w.x = pk2(y[0], y[1]); w.y = pk2(y[2], y[3]); w.z = pk2(y[4], y[5]); w.w = pk2(y[6], y[7]);
                    *(u32x4*)(rowp + 128 * bj) = w; } }
    }
};

struct EpiNull {
    static constexpr bool PERM = false, AFTER_DRAIN = false;
    DEV void operator()(const AccT& acc, const pg8::Unit& u, int wr, int wc, int fr, int fq) const {
#ifndef HOST_EMU
#pragma unroll
        for (int ai = 0; ai < 2; ++ai)
#pragma unroll
            for (int bj = 0; bj < 2; ++bj)
#pragma unroll
                for (int m = 0; m < 4; ++m)
#pragma unroll
                    for (int n = 0; n < 2; ++n) asm volatile("" :: "v"(acc[ai][bj][m][n]));
#endif
    }
};

struct EpiRetP {
    static constexpr bool PERM = true, AFTER_DRAIN = false;
    bf16* P;
    DEV void operator()(const AccT& acc, const pg8::Unit& u, int wr, int wc, int fr, int fq) const {
        EPI_OPAQUE(fr, fq);
        bf16* blk = P + (size_t)u.pm * 65536;
        const int i0 = wr * 64 + fr, j0 = wc * 32 + 8 * fq;
#pragma unroll
        for (int ai = 0; ai < 2; ++ai)
#pragma unroll
            for (int m = 0; m < 4; ++m) { const int i = i0 + 128 * ai + 16 * m;
#pragma unroll
                for (int bj = 0; bj < 2; ++bj) { const int jb = j0 + 128 * bj;
                    const int g16 = jb & ~15, f = (jb >> 3) & 1;
#pragma unroll
                    for (int n = 0; n < 2; ++n) { float v[4];
#pragma unroll
                        for (int e_ = 0; e_ < 4; ++e_) v[e_] = (jb + 4 * n + e_ <= i) ? acc[ai][bj][m][n][e_] : 0.f;
                        u32x2 w; w.x = pk2(v[0], v[1]); w.y = pk2(v[2], v[3]);
                        *(u32x2*)(blk + (size_t)i * 256 + g16 + 8 * n + 4 * f) = w; } } }
    }
};

struct EpiRetVT {
    static constexpr bool PERM = true, AFTER_DRAIN = false;
    bf16* VT; const ssq_t* ssq;
    DEV void operator()(const AccT& acc, const pg8::Unit& u, int wr, int wc, int fr, int fq) const {
        EPI_OPAQUE(fr, fq);
        const int row0 = u.pm * 256 + wr * 64 + fr, t0 = u.pn * 256 + wc * 32 + 8 * fq;
        float rs[2][8];
#pragma unroll
        for (int bj = 0; bj < 2; ++bj)
#pragma unroll
            for (int j = 0; j < 8; ++j) rs[bj][j] = frsq(ss_val(ssq[t0 + 128 * bj + j]) * (1.0f / DM) + EPS);
        const int f = fq & 1;
#pragma unroll
        for (int ai = 0; ai < 2; ++ai)
#pragma unroll
            for (int m = 0; m < 4; ++m) { bf16* rowp = VT + (size_t)(row0 + 128 * ai + 16 * m) * M;
#pragma unroll
                for (int bj = 0; bj < 2; ++bj) { const int g16 = (t0 + 128 * bj) & ~15;
#pragma unroll
                    for (int n = 0; n < 2; ++n) { const f32x4 a = acc[ai][bj][m][n]; u32x2 w; w.x = pk2(a[0] * rs[bj][4 * n], a[1] * rs[bj][4 * n + 1]); w.y = pk2(a[2] * rs[bj][4 * n + 2], a[3] * rs[bj][4 * n + 3]);
                        *(u32x2*)(rowp + g16 + 8 * n + 4 * f) = w; } } }
    }
};
#ifndef HOST_EMU
namespace pg8 {
__device__ __forceinline__ int pg8_lane_id_fresh() { unsigned m = ~0u; asm volatile("" : "+s"(m)); return (int)__builtin_amdgcn_mbcnt_hi(m, __builtin_amdgcn_mbcnt_lo(m, 0u)); }
template <class Epi, class Sched, bool ALIGN_EPI = false, bool SP2 = false>
__device__ __forceinline__ void gemm_phase(PG8_LAS unsigned char* lds, const Gemm g, const Sched& S, const Epi& E, int wave_id) {
    int tid_l = wave_id * 64 + pg8_lane_id_fresh(); asm volatile("" : "+v"(tid_l));
    const int tid = tid_l, wid = __builtin_amdgcn_readfirstlane(tid >> 6), lane = tid & 63, wr = wid >> 2, wc = wid & 3, fr = lane & 15, fq = lane >> 4;
    const int K = g.K, nt = K / BK, ldk = g.ld ? g.ld : g.K;
    unsigned voffA[2], voffB[2];
#pragma unroll
    for (int i = 0; i < 2; ++i) { int R, C; stage_rc(tid * 16 + i * 8192, R, C); const int Rb = Epi::PERM ? ((R & ~31) + perm32(R & 31)) : R;
        voffA[i] = (unsigned)(R * ldk + C) * 2u; voffB[i] = (unsigned)(Rb * ldk + C) * 2u; }
    const size_t kstep = (size_t)(BK * 2);
    const size_t hstep = (size_t)HALF * ldk * 2;
    const size_t tstep = 2 * hstep;
    const unsigned ldsw = (unsigned)wid * 1024u;
    const int aoff = lds_byte(wr * 64 + fr, fq * 8), boff = lds_byte(wc * 32 + fr, fq * 8);
#define PG8_SA(b, h) (((b) * 2 + (h)) * HTB)
#define PG8_SB(b, h) ((4 + (b) * 2 + (h)) * HTB)
#define PG8_STAGE(bufoff, gbase, voff) do { _Pragma("unroll") for (int _i = 0; _i < 2; ++_i) \
        __builtin_amdgcn_global_load_lds((const unsigned*)((const char*)(gbase) + (voff)[_i]), (PG8_LAS unsigned*)(lds + (bufoff) + ldsw + _i * 8192), 16, 0, 0); } while (0)
#define PG8_LDA(dst, b, h) do { _Pragma("unroll") for (int m = 0; m < 4; ++m) _Pragma("unroll") for (int k = 0; k < 2; ++k) dst[m][k] = *(const PG8_LAS bf16x8*)(lds + PG8_SA(b, h) + aoff + m * 2048 + k * 1024); } while (0)
#define PG8_LDB(dst, b, h) do { _Pragma("unroll") for (int n = 0; n < 2; ++n) _Pragma("unroll") for (int k = 0; k < 2; ++k) dst[n][k] = *(const PG8_LAS bf16x8*)(lds + PG8_SB(b, h) + boff + n * 2048 + k * 1024); } while (0)
#define PG8_MMA(ai, bj, At, Bt) do { __builtin_amdgcn_s_setprio(1); _Pragma("unroll") for (int m = 0; m < 4; ++m) _Pragma("unroll") for (int n = 0; n < 2; ++n) _Pragma("unroll") for (int k = 0; k < 2; ++k) \
        acc[ai][bj][m][n] = __builtin_amdgcn_mfma_f32_16x16x32_bf16(Bt[n][k], At[m][k], acc[ai][bj][m][n], 0, 0, 0); __builtin_amdgcn_s_setprio(0); } while (0)
#define PG8_WAIT_V(n) asm volatile("s_waitcnt vmcnt(" #n ")" ::: "memory")
#define PG8_WAIT_L(n) asm volatile("s_waitcnt lgkmcnt(" #n ")" ::: "memory")
#define PG8_BAR __builtin_amdgcn_s_barrier()
#define PG8_SCHED __builtin_amdgcn_sched_barrier(0)
    Unit cur, nxt; int ui = 0;
    if (!S.next(0, cur)) return;
    f32x4 acc[2][2][4][2];
#pragma unroll
    for (int a = 0; a < 2; ++a)
#pragma unroll
        for (int b = 0; b < 2; ++b)
#pragma unroll
            for (int m = 0; m < 4; ++m)
#pragma unroll
                for (int n = 0; n < 2; ++n) acc[a][b][m][n] = (f32x4){0.f, 0.f, 0.f, 0.f};
    bf16x8 At[4][2], B0[2][2], B1[2][2];
    const char* cA = (const char*)g.A + (size_t)cur.pm * tstep; const char* cB = (const char*)g.Bt + (size_t)cur.pn * tstep;
    S.a_ready(cur);
    if constexpr (SP2) {
        PG8_STAGE(PG8_SB(0, 0), cB, voffB); PG8_STAGE(PG8_SB(0, 1), cB + hstep, voffB); PG8_STAGE(PG8_SA(0, 0), cA, voffA); PG8_STAGE(PG8_SA(0, 1), cA + hstep, voffA);
        if (wr == 1) PG8_BAR;
        PG8_WAIT_V(2); PG8_BAR;
        PG8_STAGE(PG8_SB(1, 0), cB + kstep, voffB); PG8_STAGE(PG8_SA(1, 0), cA + kstep, voffA); PG8_STAGE(PG8_SB(1, 1), cB + hstep + kstep, voffB);
        PG8_WAIT_V(6); PG8_BAR;
    } else {
        PG8_STAGE(PG8_SB(0, 0), cB, voffB); PG8_STAGE(PG8_SA(0, 0), cA, voffA); PG8_STAGE(PG8_SB(0, 1), cB + hstep, voffB); PG8_STAGE(PG8_SA(0, 1), cA + hstep, voffA);
        if (wr == 1) PG8_BAR;
        PG8_WAIT_V(4); PG8_BAR;
        PG8_STAGE(PG8_SB(1, 0), cB + kstep, voffB); PG8_STAGE(PG8_SA(1, 0), cA + kstep, voffA); PG8_STAGE(PG8_SB(1, 1), cB + hstep + kstep, voffB);
        PG8_WAIT_V(6); PG8_BAR;
    }
    for (;;) {
        const bool has_next = S.next(ui + 1, nxt);
        const char* nA = has_next ? (const char*)g.A + (size_t)nxt.pm * tstep : cA; const char* nB = has_next ? (const char*)g.Bt + (size_t)nxt.pn * tstep : cB;
        for (int t = 0; t < nt; t += 2) {
            const bool last = (t == nt - 2);
            const char* a1 = cA + (size_t)(t + 1) * kstep;
            const char* a2 = last ? nA : cA + (size_t)(t + 2) * kstep; const char* b2 = last ? nB : cB + (size_t)(t + 2) * kstep;
            const char* a3 = a2 + kstep; const char* b3 = b2 + kstep;
            if (last && has_next) S.a_ready(nxt);
            if constexpr (SP2) {
            PG8_LDB(B0, 0, 0); PG8_LDB(B1, 0, 1); PG8_SCHED; PG8_LDA(At, 0, 0); PG8_STAGE(PG8_SA(1, 1), a1 + hstep, voffA);
            PG8_WAIT_V(8); PG8_WAIT_L(0); PG8_BAR; PG8_MMA(0, 0, At, B0); PG8_MMA(0, 1, At, B1); PG8_BAR; PG8_SCHED;
            PG8_LDA(At, 0, 1); PG8_STAGE(PG8_SB(0, 0), b2, voffB); PG8_STAGE(PG8_SB(0, 1), b2 + hstep, voffB); PG8_STAGE(PG8_SA(0, 0), a2, voffA);
            PG8_WAIT_V(8); PG8_WAIT_L(0); PG8_BAR; PG8_MMA(1, 0, At, B0); PG8_MMA(1, 1, At, B1); PG8_BAR; PG8_SCHED;
            PG8_LDB(B0, 1, 0); PG8_LDB(B1, 1, 1); PG8_SCHED; PG8_LDA(At, 1, 0); PG8_STAGE(PG8_SA(0, 1), a2 + hstep, voffA);
            PG8_WAIT_V(8); PG8_WAIT_L(0); PG8_BAR; PG8_MMA(0, 0, At, B0); PG8_MMA(0, 1, At, B1); PG8_BAR; PG8_SCHED;
            PG8_LDA(At, 1, 1); PG8_STAGE(PG8_SB(1, 0), b3, voffB); PG8_STAGE(PG8_SB(1, 1), b3 + hstep, voffB); PG8_STAGE(PG8_SA(1, 0), a3, voffA);
            PG8_WAIT_V(8); PG8_WAIT_L(0); PG8_BAR; PG8_MMA(1, 0, At, B0); PG8_MMA(1, 1, At, B1); PG8_BAR; PG8_SCHED;
            } else {
            PG8_LDB(B0, 0, 0); PG8_SCHED; PG8_LDA(At, 0, 0); PG8_STAGE(PG8_SA(1, 1), a1 + hstep, voffA);
            PG8_WAIT_L(8); PG8_BAR; PG8_WAIT_L(0); PG8_MMA(0, 0, At, B0); PG8_BAR; PG8_SCHED;
            PG8_LDB(B1, 0, 1); PG8_STAGE(PG8_SB(0, 0), b2, voffB);
            PG8_BAR; PG8_WAIT_L(0); PG8_MMA(0, 1, At, B1); PG8_BAR;
            PG8_LDA(At, 0, 1); PG8_STAGE(PG8_SA(0, 0), a2, voffA);
            PG8_BAR; PG8_WAIT_L(0); PG8_MMA(1, 0, At, B0); PG8_BAR; PG8_SCHED;
            PG8_STAGE(PG8_SB(0, 1), b2 + hstep, voffB);
            PG8_WAIT_V(6); PG8_BAR; PG8_MMA(1, 1, At, B1); PG8_BAR;
            PG8_LDB(B0, 1, 0); PG8_SCHED; PG8_LDA(At, 1, 0); PG8_STAGE(PG8_SA(0, 1), a2 + hstep, voffA);
            PG8_WAIT_L(8); PG8_BAR; PG8_WAIT_L(0); PG8_MMA(0, 0, At, B0); PG8_BAR; PG8_SCHED;
            PG8_LDB(B1, 1, 1); PG8_STAGE(PG8_SB(1, 0), b3, voffB);
            PG8_BAR; PG8_WAIT_L(0); PG8_MMA(0, 1, At, B1); PG8_BAR;
            PG8_LDA(At, 1, 1); PG8_STAGE(PG8_SA(1, 0), a3, voffA);
            PG8_BAR; PG8_WAIT_L(0); PG8_MMA(1, 0, At, B0); PG8_BAR; PG8_SCHED;
            PG8_STAGE(PG8_SB(1, 1), b3 + hstep, voffB);
            PG8_WAIT_V(6); PG8_BAR; PG8_MMA(1, 1, At, B1); PG8_BAR;
            }
        }
        if constexpr (ALIGN_EPI) { if (wr == 0) PG8_BAR; }
        if constexpr (!Epi::AFTER_DRAIN) { E(acc, cur, wr, wc, fr, fq); S.done(cur); }
        if (!has_next) break;
#pragma unroll
        for (int a = 0; a < 2; ++a)
#pragma unroll
            for (int b = 0; b < 2; ++b)
#pragma unroll
                for (int m = 0; m < 4; ++m)
#pragma unroll
                    for (int n = 0; n < 2; ++n) acc[a][b][m][n] = (f32x4){0.f, 0.f, 0.f, 0.f};
        cur = nxt; cA = nA; cB = nB; ++ui;
        if constexpr (ALIGN_EPI) { if (wr == 1) PG8_BAR; }
    }
    PG8_WAIT_V(0);
    if constexpr (!ALIGN_EPI) { if (wr == 0) PG8_BAR; }
    PG8_BAR;
    if constexpr (Epi::AFTER_DRAIN) { E.fused(acc, cur, wr, wc, fr, fq, lds, wid, lane); S.done(cur); }
#undef PG8_SA
#undef PG8_SB
#undef PG8_STAGE
#undef PG8_LDA
#undef PG8_LDB
#undef PG8_MMA
#undef PG8_WAIT_V
#undef PG8_WAIT_L
#undef PG8_BAR
#undef PG8_SCHED
}
}
#endif
#ifndef HOST_EMU
#define WAVE_LDS_SYNC() do { asm volatile("s_waitcnt lgkmcnt(0)" ::: "memory"); } while (0)
#else
#define WAVE_LDS_SYNC() do { e_wave->bar.arrive_and_wait(); } while (0)
#endif
DEV void conv_tile(const float* W, int ldw, int k0, int n0, const float* gain, bf16* dst, int Kd, LAS float* scr, int lane) {
#pragma unroll 8
    for (int i = 0; i < 32; ++i) { const int kk = 2 * i + (lane >> 5); float v = W[(size_t)(k0 + kk) * ldw + n0 + (lane & 31)]; if (gain) v *= gain[k0 + kk]; scr[kk * 33 + (lane & 31)] = v; }
    WAVE_LDS_SYNC();
    const int c = lane & 7;
#pragma unroll
    for (int j = 0; j < 4; ++j) { const int n = (lane >> 3) + 8 * j; const LAS float* s = scr + (8 * c) * 33 + n;
        u32x4 o; o.x = pk2(s[0 * 33], s[1 * 33]); o.y = pk2(s[2 * 33], s[3 * 33]); o.z = pk2(s[4 * 33], s[5 * 33]); o.w = pk2(s[6 * 33], s[7 * 33]);
        *(u32x4*)(dst + (size_t)n * Kd + k0 + 8 * c) = o; }
    WAVE_LDS_SYNC();
}
DEV int glu_row(int n, int NH) { const int j = n < NH ? n : n - NH; return (j >> 7) * 256 + (n < NH ? 0 : 128) + (j & 127); }

struct LayerW {
    const float *g;
    const float *f1in, *f1out, *f2in, *f2out;
    const float *mixin, *mixout;
    const float *xq, *xkv, *xkv2, *xo;
    int is_ret;
};
DEV void convert_layer(const LayerW& L, unsigned char* ws, LAS float* scr, int gw, int NGW, int lane) {
    constexpr int I_FIN = (DM / 64) * (2 * DFF / 32), I_FOUT = (DFF / 64) * (DM / 32), I_GLU = (DM / 64) * (2 * DM / 32), I_RIN = (DM / 64) * (RIN / 32), I_ROUT = (RVW / 64) * (DM / 32),
                  I_SQ = (DM / 64) * (DM / 32), I_KV = (DM / 64) * (2 * DM / 32);
    const int i_mix = L.is_ret ? I_RIN + I_ROUT : I_GLU;
    const int n_kv = L.is_ret ? 0 : 2 * I_KV;
    const int total = 2 * (I_FIN + I_FOUT) + i_mix + 2 * I_SQ + n_kv;
    for (int it = gw; it < total; it += NGW) {
        int r = it;
        if (r < 2 * I_FIN) { const int f = r >= I_FIN; r -= f * I_FIN; const int nb = r % (2 * DFF / 32), kb = r / (2 * DFF / 32);
            conv_tile(f ? L.f2in : L.f1in, 2 * DFF, 64 * kb, 32 * nb, L.g + (f ? 3 : 0) * DM, (bf16*)(ws + (f ? W_F2IN : W_F1IN)) + (size_t)glu_row(32 * nb, DFF) * DM, DM, scr, lane); continue; }
        r -= 2 * I_FIN;
        if (r < 2 * I_FOUT) { const int f = r >= I_FOUT; r -= f * I_FOUT; const int nb = r % (DM / 32), kb = r / (DM / 32);
            conv_tile(f ? L.f2out : L.f1out, DM, 64 * kb, 32 * nb, nullptr, (bf16*)(ws + (f ? W_F2OUT : W_F1OUT)) + (size_t)(32 * nb) * DFF, DFF, scr, lane); continue; }
        r -= 2 * I_FOUT;
        if (r < i_mix) {
            if (!L.is_ret) { const int nb = r % (2 * DM / 32), kb = r / (2 * DM / 32);
                conv_tile(L.mixin, 2 * DM, 64 * kb, 32 * nb, nullptr, (bf16*)(ws + W_MIX) + (size_t)glu_row(32 * nb, DM) * DM, DM, scr, lane); }
            else if (r < I_RIN) { const int nb = r % (RIN / 32), kb = r / (RIN / 32);
                conv_tile(L.mixin, RIN, 64 * kb, 32 * nb, L.g + 1 * DM, (bf16*)(ws + W_MIX) + (size_t)(32 * nb) * DM, DM, scr, lane); }
            else { r -= I_RIN; const int nb = r % (DM / 32), kb = r / (DM / 32);
                conv_tile(L.mixout, DM, 64 * kb, 32 * nb, nullptr, (bf16*)(ws + W_ROUT) + (size_t)(32 * nb) * RVW, RVW, scr, lane); }
            continue; }
        r -= i_mix;
        if (r < 2 * I_SQ) { const int f = r >= I_SQ; r -= f * I_SQ; const int nb = r % (DM / 32), kb = r / (DM / 32);
            conv_tile(f ? L.xo : L.xq, DM, 64 * kb, 32 * nb, f ? nullptr : L.g + 2 * DM, (bf16*)(ws + (f ? W_XO : W_XQ)) + (size_t)(32 * nb) * DM, DM, scr, lane); continue; }
        r -= 2 * I_SQ;
        { const int set = r >= I_KV; r -= set * I_KV; const int nb = r % (2 * DM / 32), kb = r / (2 * DM / 32); const int n0 = 32 * nb;
          conv_tile(set ? L.xkv2 : L.xkv, 2 * DM, 64 * kb, n0, nullptr, (bf16*)(ws + (n0 < DM ? W_XK : W_XV) + set * W_XKV_SET) + (size_t)(n0 < DM ? n0 : n0 - DM) * DM, DM, scr, lane); }
    }
}
DEV void s5_tables(const float* lam_re, const float* lam_im, const float* log_dt, const float* b_re, const float* b_im, const float* c_re, const float* c_im, unsigned char* ws, int gt, int NGT) {
    bf16* BBAR = (bf16*)(ws + S5T_BBAR); bf16* CT = (bf16*)(ws + S5T_CT); float* A = (float*)(ws + S5T_A); float* AL = (float*)(ws + S5T_AL);
    for (int idx = gt; idx < S5G * S5P; idx += NGT) {
        const int g = idx / S5P, p = idx % S5P;
        const double dt = exp((double)log_dt[g]), lr = (double)lam_re[idx], li = (double)lam_im[idx];
        const double mag = exp(lr * dt), ang = li * dt, ar = mag * cos(ang), ai = mag * sin(ang);
        const double den = lr * lr + li * li, nr = ar - 1.0, zr = (nr * lr + ai * li) / den, zi = (ai * lr - nr * li) / den;
        for (int hi = 0; hi < S5H; ++hi) { const double br = (double)b_re[(size_t)idx * S5H + hi], bi = (double)b_im[(size_t)idx * S5H + hi];
            BBAR[((size_t)(g * 2 + 0) * S5P + p) * S5H + hi] = (bf16)f2bf((float)(zr * br - zi * bi));
            BBAR[((size_t)(g * 2 + 1) * S5P + p) * S5H + hi] = (bf16)f2bf((float)(zr * bi + zi * br)); }
        for (int ho = 0; ho < S5H; ++ho) { const size_t ci = ((size_t)g * S5H + ho) * S5P + p;
            CT[((size_t)(g * 2 + 0) * S5H + ho) * S5P + p] = (bf16)f2bf(c_re[ci]);
            CT[((size_t)(g * 2 + 1) * S5H + ho) * S5P + p] = (bf16)f2bf(-c_im[ci]); }
        A[(size_t)idx * 2] = (float)ar; A[(size_t)idx * 2 + 1] = (float)ai;
        double pr = 1.0, pi = 0.0, qr = ar, qi = ai;
        for (int e = S5_LC; e > 0; e >>= 1) { if (e & 1) { const double t = pr * qr - pi * qi; pi = pr * qi + pi * qr; pr = t; } const double t = qr * qr - qi * qi; qi = 2.0 * qr * qi; qr = t; }
        AL[(size_t)idx * 2] = (float)pr; AL[(size_t)idx * 2 + 1] = (float)pi;
    }
}
DEV void rot_table(float* rot, int gt, int NGT) {
    for (int idx = gt; idx < ROT_NPOS * 128; idx += NGT) { const int pos = idx >> 7, k = idx & 127;
        const double invf = exp(-9.210340371976184 * ((double)k / 127.0)), ang = (double)pos * invf;
        rot[(size_t)idx * 2] = (float)cos(ang); rot[(size_t)idx * 2 + 1] = (float)sin(ang); }
}
DEV void memn_rows(const float* mem, const float* gain, bf16* MEMN, bf16* MEMNP, int gw, int NGW, int lane) {
    for (int row = gw; row < MMEM; row += NGW) {
        const f32x4* xr = (const f32x4*)(mem + (size_t)row * DM) + lane; const f32x4* gr = (const f32x4*)gain + lane;
        f32x4 v[4]; float s = 0.f;
#pragma unroll
        for (int j = 0; j < 4; ++j) { v[j] = xr[64 * j]; s += (v[j][0] * v[j][0] + v[j][1] * v[j][1]) + (v[j][2] * v[j][2] + v[j][3] * v[j][3]); }
        const float r = 1.0f / sqrtf(wave_sum(s) * (1.0f / DM) + EPS);
        const int rowp = (row & ~15) | pos16(row & 15);
#pragma unroll
        for (int j = 0; j < 4; ++j) { const f32x4 g = gr[64 * j]; u32x2 w; w.x = pk2(v[j][0] * r * g[0], v[j][1] * r * g[1]); w.y = pk2(v[j][2] * r * g[2], v[j][3] * r * g[3]);
            *((u32x2*)(MEMN + (size_t)row * DM) + lane + 64 * j) = w; *((u32x2*)(MEMNP + (size_t)rowp * DM) + lane + 64 * j) = w; }
    }
}
DEV void x0_rows(const float* x, bf16* xh, ssq_t* ss0, ssq_t* ss1, int gw, int NGW, int lane) {
    for (int row = gw; row < M; row += NGW) {
        const f32x4* xr = (const f32x4*)(x + (size_t)row * DM) + lane; float s = 0.f;
#pragma unroll
        for (int j = 0; j < 4; ++j) { const f32x4 v = xr[64 * j]; u32x2 w; w.x = pk2(v[0], v[1]); w.y = pk2(v[2], v[3]); *((u32x2*)(xh + (size_t)row * DM) + lane + 64 * j) = w;
            const float q0 = bflo(w.x), q1 = bfhi(w.x), q2 = bflo(w.y), q3 = bfhi(w.y); s += (q0 * q0 + q1 * q1) + (q2 * q2 + q3 * q3); }
        s = wave_sum(s);
        if (lane == 0) { ss0[row] = ss_fix(s); ss1[row] = 0ull; }
    }
}
DEV void final_rows(const bf16* xh, const ssq_t* ssq, const float* gain, float* out, int gw, int NGW, int lane) {
    const f32x4* gr = (const f32x4*)gain + lane; f32x4 g[4];
#pragma unroll
    for (int j = 0; j < 4; ++j) g[j] = gr[64 * j];
    for (int row0 = gw * 4; row0 < M; row0 += NGW * 4) {
        u32x2 v[4][4]; float r[4];
#pragma unroll
        for (int i = 0; i < 4; ++i) { r[i] = 1.0f / sqrtf(ss_val(ssq[row0 + i]) * (1.0f / DM) + EPS); const u32x2* xr = (const u32x2*)(xh + (size_t)(row0 + i) * DM) + lane;
#pragma unroll
            for (int j = 0; j < 4; ++j) v[i][j] = xr[64 * j]; }
#pragma unroll
        for (int i = 0; i < 4; ++i) { f32x4* orow = (f32x4*)(out + (size_t)(row0 + i) * DM) + lane;
#pragma unroll
            for (int j = 0; j < 4; ++j) { f32x4 o; o[0] = bflo(v[i][j].x) * r[i] * g[j][0]; o[1] = bfhi(v[i][j].x) * r[i] * g[j][1]; o[2] = bflo(v[i][j].y) * r[i] * g[j][2]; o[3] = bfhi(v[i][j].y) * r[i] * g[j][3]; orow[64 * j] = o; } }
    }
}
template <int PASS> DEV void s5_pass(const bf16* xh, const ssq_t* ssq, const float* gain, const float* dskip, const unsigned char* ws, float* ES, bf16* YB, LAS unsigned char* lds, int vcu, int G, int tid) {
    const int wave = tid >> 6, lane = tid & 63, fr = lane & 15, fq = lane >> 4;
    const bf16* BBAR = (const bf16*)(ws + S5T_BBAR); const bf16* CT = (const bf16*)(ws + S5T_CT); const float* A = (const float*)(ws + S5T_A);
    LAS float* rtab = (LAS float*)lds;
    constexpr int NT = BATCH * 4 * 8, QLEN = SEQ / 4;
    for (int wt = vcu; wt < NT; wt += G) {
        const int gb = wt & 7, bq = wt >> 3, q4 = bq & 3, b = bq >> 2, g = 8 * gb + wave;
        const int tok0 = b * SEQ + q4 * QLEN;
        __syncthreads();
        for (int t = tid; t < QLEN; t += 512) rtab[t] = frsq(ss_val(ssq[tok0 + t]) * (1.0f / DM) + EPS);
        __syncthreads();
        s16x4 bb[4][2], cc[4][2]; float ar[4][4], ai[4][4];
#pragma unroll
        for (int ct = 0; ct < 4; ++ct) {
#pragma unroll
            for (int part = 0; part < 2; ++part) {
                bb[ct][part] = *(const s16x4*)(BBAR + ((size_t)(g * 2 + part) * S5P + 16 * ct + fr) * S5H + 4 * fq);
                cc[ct][part] = *(const s16x4*)(CT + ((size_t)(g * 2 + part) * S5H + fr) * S5P + 16 * ct + 4 * fq); }
            const f32x4 a0 = *(const f32x4*)(A + ((size_t)g * S5P + 16 * ct + 4 * fq) * 2), a1 = *(const f32x4*)(A + ((size_t)g * S5P + 16 * ct + 4 * fq) * 2 + 4);
            ar[ct][0] = a0[0]; ai[ct][0] = a0[1]; ar[ct][1] = a0[2]; ai[ct][1] = a0[3]; ar[ct][2] = a1[0]; ai[ct][2] = a1[1]; ar[ct][3] = a1[2]; ai[ct][3] = a1[3]; }
        const f32x4 gn = *(const f32x4*)(gain + 16 * g + 4 * fq), dk = *(const f32x4*)(dskip + 16 * g + 4 * fq);
        float xr[4][4], xi[4][4];
        const int bg = b * S5G + g, ch = 16 * q4 + fr;
        float* es = ES + ((size_t)bg * S5_NCH + ch) * 128 + 4 * fq;
#pragma unroll
        for (int ct = 0; ct < 4; ++ct) {
            if (PASS == 3) { const f32x4 r_ = *(const f32x4*)(es + 16 * ct), i_ = *(const f32x4*)(es + 64 + 16 * ct);
#pragma unroll
                for (int i = 0; i < 4; ++i) { xr[ct][i] = r_[i]; xi[ct][i] = i_[i]; } }
            else {
#pragma unroll
                for (int i = 0; i < 4; ++i) { xr[ct][i] = 0.f; xi[ct][i] = 0.f; } } }
        const size_t rowbase = (size_t)(tok0 + S5_LC * fr) * DM + 16 * g + 4 * fq;
        u32x2 nxt = *(const u32x2*)(xh + rowbase);
#pragma unroll 1
        for (int j = 0; j < S5_LC; ++j) {
            const u32x2 cur = nxt; if (j + 1 < S5_LC) nxt = *(const u32x2*)(xh + rowbase + (size_t)(j + 1) * DM);
            const float r = rtab[S5_LC * fr + j];
            const float u0 = bflo(cur.x) * r * gn[0], u1 = bfhi(cur.x) * r * gn[1], u2 = bflo(cur.y) * r * gn[2], u3 = bfhi(cur.y) * r * gn[3];
            const s16x4 ub = pack4(u0, u1, u2, u3);
#pragma unroll
            for (int ct = 0; ct < 4; ++ct) {
                const f32x4 z = {0.f, 0.f, 0.f, 0.f};
                const f32x4 br = MFMA16K16(bb[ct][0], ub, z), bi = MFMA16K16(bb[ct][1], ub, z);
#pragma unroll
                for (int i = 0; i < 4; ++i) { const float nr = br[i] + ar[ct][i] * xr[ct][i] - ai[ct][i] * xi[ct][i], ni = bi[i] + ar[ct][i] * xi[ct][i] + ai[ct][i] * xr[ct][i]; xr[ct][i] = nr; xi[ct][i] = ni; } }
            if (PASS == 3) {
                f32x4 y = {0.f, 0.f, 0.f, 0.f};
#pragma unroll
                for (int ct = 0; ct < 4; ++ct) { y = MFMA16K16(cc[ct][0], pack4(xr[ct][0], xr[ct][1], xr[ct][2], xr[ct][3]), y); y = MFMA16K16(cc[ct][1], pack4(xi[ct][0], xi[ct][1], xi[ct][2], xi[ct][3]), y); }
                u32x2 w; w.x = pk2(gelu_tanh(y[0] + dk[0] * u0), gelu_tanh(y[1] + dk[1] * u1)); w.y = pk2(gelu_tanh(y[2] + dk[2] * u2), gelu_tanh(y[3] + dk[3] * u3));
                *(u32x2*)(YB + rowbase + (size_t)j * DM) = w; }
        }
        if (PASS == 1) {
#pragma unroll
            for (int ct = 0; ct < 4; ++ct) { const f32x4 r_ = {xr[ct][0], xr[ct][1], xr[ct][2], xr[ct][3]}, i_ = {xi[ct][0], xi[ct][1], xi[ct][2], xi[ct][3]};
                *(f32x4*)(es + 16 * ct) = r_; *(f32x4*)(es + 64 + 16 * ct) = i_; } }
    }
}
DEV void s5_carry(float* ES, const unsigned char* ws, int gt, int NGT) {
    const float* AL = (const float*)(ws + S5T_AL);
    for (int idx = gt; idx < BATCH * S5G * S5P; idx += NGT) { const int bg = idx / S5P, k = idx % S5P, g = bg % S5G;
        const float alr = AL[((size_t)g * S5P + k) * 2], ali = AL[((size_t)g * S5P + k) * 2 + 1]; float sr = 0.f, si = 0.f;
        float* p = ES + (size_t)bg * S5_NCH * 128 + k;
        for (int c = 0; c < S5_NCH; ++c) { const float er = p[(size_t)c * 128], ei = p[(size_t)c * 128 + 64]; p[(size_t)c * 128] = sr; p[(size_t)c * 128 + 64] = si;
            const float nr = alr * sr - ali * si + er, ni = alr * si + ali * sr + ei; sr = nr; si = ni; } }
}

#ifndef HOST_EMU
#define LDS_BARRIER() do { asm volatile("s_waitcnt lgkmcnt(0)" ::: "memory"); __builtin_amdgcn_s_barrier(); asm volatile("" ::: "memory"); } while (0)
#else
#define LDS_BARRIER() __syncthreads()
#endif
constexpr int KTS = 264;
#ifndef HOST_EMU
#define FRAG_PIN() __builtin_amdgcn_sched_barrier(0)
#else
#define FRAG_PIN() do {} while (0)
#endif
#define TILE_MFMA16(acc, rowp, bfrag) do { _Pragma("unroll") for (int s4_ = 0; s4_ < 4; ++s4_) { bf16x8 fr_[4]; \
    _Pragma("unroll") for (int q_ = 0; q_ < 4; ++q_) fr_[q_] = *(const LAS bf16x8*)((rowp) + 16 * (4 * s4_ + q_)); FRAG_PIN(); \
    _Pragma("unroll") for (int q_ = 0; q_ < 4; ++q_) acc = MFMA32(fr_[q_], bfrag[4 * s4_ + q_], acc); FRAG_PIN(); } } while (0)
constexpr int RET_LDS = (2 * 32 + 64) * KTS * 2;
DEV void stage_tile_ld(const bf16* src, size_t ld, int tid, u32x4 (&rg)[2]) {
#pragma unroll
    for (int i = 0; i < 2; ++i) { const int q = tid + 512 * i, row = q >> 5, chk = q & 31; rg[i] = *(const u32x4*)(src + (size_t)row * ld + 8 * chk); }
}
DEV void stage_tile_st(LAS bf16* dst, int tid, const u32x4 (&rg)[2]) {
#pragma unroll
    for (int i = 0; i < 2; ++i) { const int q = tid + 512 * i, row = q >> 5, chk = q & 31; *(LAS u32x4*)(dst + row * KTS + 8 * chk) = rg[i]; }
}
#define RET_STAGE_LD(...) do { if (!(SKIP & 16)) stage_tile_ld(__VA_ARGS__); } while (0)
template <int SKIP = 0>
DEV void ret_core(const bf16* Q, const bf16* K, const bf16* VT, bf16* O, float* STAT, LAS unsigned char* lds, int vcu, int G, int tid) {
    const int w = tid >> 6, lane = tid & 63, c = lane & 31, hh = lane >> 5;
    LAS bf16* KT0 = (LAS bf16*)lds; LAS bf16* KT1 = KT0 + 32 * KTS; LAS bf16* SB = KT1 + 32 * KTS;
    constexpr int NT = BATCH * RH * 8, NMC = SEQ / RMC;
    bf16x8 idf[2];
#pragma unroll
    for (int sg = 0; sg < 2; ++sg)
#pragma unroll
        for (int e = 0; e < 8; ++e) idf[sg][e] = (16 * sg + 8 * hh + e == c) ? (short)0x3F80 : (short)0;
    for (int tsk = vcu; tsk < NT; tsk += G) {
        const int b = tsk >> 5, h = (tsk >> 3) & 3, vs = tsk & 7;
        const float lg = log2f(1.0f - exp2f(-5.0f - (float)h)), g256 = exp2f(lg * (float)RMC);
        f32x16 sacc[2];
#pragma unroll
        for (int vt = 0; vt < 2; ++vt)
#pragma unroll
            for (int r = 0; r < 16; ++r) sacc[vt][r] = 0.f;
        LDS_BARRIER();
        for (int i = tid; i < 64 * KTS / 2; i += 512) ((LAS unsigned*)SB)[i] = 0u;
        LDS_BARRIER();
        const bf16* vtrow = VT + (size_t)(RDV * h + 64 * vs + c) * M + 8 * hh;
        bf16x8 qf[16];
        { const bf16* qrow = Q + (size_t)(b * SEQ + 32 * w + c) * DM + 256 * h + 8 * hh;
#pragma unroll
          for (int s = 0; s < 16; ++s) qf[s] = (SKIP & 32) ? idf[s & 1] : *(const bf16x8*)(qrow + 16 * s); }
        for (int mc = 0; mc < NMC; ++mc) {
            const int T0 = b * SEQ + RMC * mc;
            const bf16* ksrc = K + (size_t)T0 * DM + 256 * h;
            u32x4 rg0[2], rg1[2];
            RET_STAGE_LD(ksrc, DM, tid, rg0);
            f32x16 oacc[2];
#pragma unroll
            for (int vt = 0; vt < 2; ++vt) {
#pragma unroll
                for (int r = 0; r < 16; ++r) oacc[vt][r] = 0.f;
#pragma unroll
                for (int s = 0; s < 16; ++s) if (!(SKIP & 4)) oacc[vt] = MFMA32(*(const LAS bf16x8*)(SB + (32 * vt + c) * KTS + 16 * s + 8 * hh), qf[s], oacc[vt]);
#pragma unroll
                for (int r = 0; r < 16; ++r) { oacc[vt][r] *= g256; sacc[vt][r] *= g256; } }
            stage_tile_st(KT0, tid, rg0);
            RET_STAGE_LD(ksrc + (size_t)32 * DM, DM, tid, rg1);
            LDS_BARRIER();
#pragma unroll
            for (int jt = 0; jt < 8; ++jt) {
                LAS bf16* cur = (jt & 1) ? KT1 : KT0; LAS bf16* nx = (jt & 1) ? KT0 : KT1;
                bf16x8 vf[2][2];
#pragma unroll
                for (int vt = 0; vt < 2; ++vt)
#pragma unroll
                    for (int s2 = 0; s2 < 2; ++s2) vf[vt][s2] = (SKIP & 8) ? idf[s2] : *(const bf16x8*)(vtrow + (size_t)(32 * vt) * M + T0 + 32 * jt + 16 * s2);
                FRAG_PIN();
                if (jt < 6) { if (jt & 1) RET_STAGE_LD(ksrc + (size_t)(32 * (jt + 2)) * DM, DM, tid, rg1); else RET_STAGE_LD(ksrc + (size_t)(32 * (jt + 2)) * DM, DM, tid, rg0); }
                FRAG_PIN();
                if (!(SKIP & 1) && w >= jt) {
                    f32x16 X;
#pragma unroll
                    for (int r = 0; r < 16; ++r) X[r] = 0.f;
                    TILE_MFMA16(X, cur + c * KTS + 8 * hh, qf);
                    if (w == jt) {
#pragma unroll
                        for (int r = 0; r < 16; ++r) if (rowmap32(r, hh) > c) X[r] = 0.f; }
#pragma unroll
                    for (int s2 = 0; s2 < 2; ++s2) { const bf16x8 pf = pack8(X[8 * s2], X[8 * s2 + 1], X[8 * s2 + 2], X[8 * s2 + 3], X[8 * s2 + 4], X[8 * s2 + 5], X[8 * s2 + 6], X[8 * s2 + 7]);
#pragma unroll
                        for (int vt = 0; vt < 2; ++vt) oacc[vt] = MFMA32(vf[vt][s2], pf, oacc[vt]); }
                }
                if (jt == 7 && mc + 1 < NMC) { const bf16* qrow = Q + (size_t)(T0 + RMC + 32 * w + c) * DM + 256 * h + 8 * hh;
#pragma unroll
                    for (int s = 0; s < 16; ++s) qf[s] = (SKIP & 32) ? idf[s & 1] : *(const bf16x8*)(qrow + 16 * s); }
                if (!(SKIP & 2)) {
                    f32x16 Xk;
#pragma unroll
                    for (int r = 0; r < 16; ++r) Xk[r] = 0.f;
                    Xk = MFMA32(*(const LAS bf16x8*)(cur + c * KTS + 32 * w + 8 * hh), idf[0], Xk);
                    Xk = MFMA32(*(const LAS bf16x8*)(cur + c * KTS + 32 * w + 16 + 8 * hh), idf[1], Xk);
#pragma unroll
                    for (int s2 = 0; s2 < 2; ++s2) { const bf16x8 kf = pack8(Xk[8 * s2], Xk[8 * s2 + 1], Xk[8 * s2 + 2], Xk[8 * s2 + 3], Xk[8 * s2 + 4], Xk[8 * s2 + 5], Xk[8 * s2 + 6], Xk[8 * s2 + 7]);
#pragma unroll
                        for (int vt = 0; vt < 2; ++vt) sacc[vt] = MFMA32(kf, vf[vt][s2], sacc[vt]); }
                }
                if (jt < 7) { if (jt & 1) stage_tile_st(nx, tid, rg0); else stage_tile_st(nx, tid, rg1); }
                LDS_BARRIER();
            }
            float s1 = 0.f, s2_ = 0.f;
            bf16* orow = O + (size_t)(T0 + 32 * w + c) * RVW + RDV * h + 64 * vs + 4 * hh;
#pragma unroll
            for (int vt = 0; vt < 2; ++vt)
#pragma unroll
                for (int q = 0; q < 4; ++q) { const float a0 = oacc[vt][4 * q], a1 = oacc[vt][4 * q + 1], a2 = oacc[vt][4 * q + 2], a3 = oacc[vt][4 * q + 3];
                    s1 += (a0 + a1) + (a2 + a3); s2_ += (a0 * a0 + a1 * a1) + (a2 * a2 + a3 * a3);
                    u32x2 wv; wv.x = pk2(a0, a1); wv.y = pk2(a2, a3); *(u32x2*)(orow + 32 * vt + 8 * q) = wv; }
            s1 += __shfl_xor(s1, 32); s2_ += __shfl_xor(s2_, 32);
            if (hh == 0) { f32x2 sv; sv[0] = s1; sv[1] = s2_; *(f32x2*)(STAT + ((size_t)(T0 + 32 * w + c) * RH + h) * 16 + 2 * vs) = sv; }
#pragma unroll
            for (int vt = 0; vt < 2; ++vt)
#pragma unroll
                for (int q = 0; q < 4; ++q) { u32x2 wv; wv.x = pk2(sacc[vt][4 * q], sacc[vt][4 * q + 1]); wv.y = pk2(sacc[vt][4 * q + 2], sacc[vt][4 * q + 3]);
                    *(LAS u32x2*)(SB + (32 * vt + c) * KTS + 32 * w + 8 * q + 4 * hh) = wv; }
            LDS_BARRIER();
        }
    }
}

#undef RET_STAGE_LD
struct DiagOrder {
    int nblk, G, c;
    DEV bool next(int i, pg8::Unit& u) const { const int k = i * G + c; if (k >= nblk) return false; u.pm = k; u.pn = k; return true; }
    DEV void a_ready(const pg8::Unit&) const {}
    DEV void done(const pg8::Unit&) const {}
};

DEV void xattn_core(const bf16* QX, const bf16* XK, const bf16* XVT, bf16* OX, LAS unsigned char* lds, int vcu, int G, int tid) {
    const int w = tid >> 6, lane = tid & 63, c = lane & 31, hh = lane >> 5;
    LAS bf16* T0_ = (LAS bf16*)lds; LAS bf16* T1_ = T0_ + 32 * KTS;
    constexpr int NQB = SEQ / 256, NU = BATCH * XH * NQB;
    for (int un = vcu; un < NU; un += G) {
        const int qb = un % NQB, bh = un / NQB, h = bh & 3, b = bh >> 2;
        const size_t R0 = (size_t)b * SEQ + 256 * qb + 32 * w + c;
        bf16x8 qf[16];
#pragma unroll
        for (int s = 0; s < 16; ++s) qf[s] = *(const bf16x8*)(QX + R0 * DM + 256 * h + 16 * s + 8 * hh);
        const bf16* ksrc = XK + (size_t)(b * NMEM) * DM + 256 * h;
        const bf16* vsrc = XVT + (size_t)(256 * h) * MMEM + b * NMEM;
        u32x4 rg[2];
        f32x16 st[8];
        LDS_BARRIER();
        stage_tile_ld(ksrc, DM, tid, rg); stage_tile_st(T0_, tid, rg);
        LDS_BARRIER();
#pragma unroll
        for (int kt = 0; kt < 8; ++kt) {
            LAS bf16* cur = (kt & 1) ? T1_ : T0_; LAS bf16* nx = (kt & 1) ? T0_ : T1_;
            if (kt < 7) stage_tile_ld(ksrc + (size_t)(32 * (kt + 1)) * DM, DM, tid, rg); else stage_tile_ld(vsrc, MMEM, tid, rg);
#pragma unroll
            for (int r = 0; r < 16; ++r) st[kt][r] = 0.f;
            TILE_MFMA16(st[kt], cur + c * KTS + 8 * hh, qf);
            stage_tile_st(nx, tid, rg);
            LDS_BARRIER();
        }
        float mx = st[0][0];
#pragma unroll
        for (int kt = 0; kt < 8; ++kt)
#pragma unroll
            for (int r = 0; r < 16; ++r) mx = fmaxf(mx, st[kt][r]);
        mx = fmaxf(mx, __shfl_xor(mx, 32));
        const float c2 = 1.4426950408889634f * 0.0625f, mc2 = -mx * c2; float l = 0.f;
        bf16x8 pf[16];
#pragma unroll
        for (int kt = 0; kt < 8; ++kt) {
#pragma unroll
            for (int r = 0; r < 16; ++r) { const float p = fexp2(st[kt][r] * c2 + mc2); st[kt][r] = p; l += p; }
#pragma unroll
            for (int s2 = 0; s2 < 2; ++s2) pf[2 * kt + s2] = pack8(st[kt][8 * s2], st[kt][8 * s2 + 1], st[kt][8 * s2 + 2], st[kt][8 * s2 + 3], st[kt][8 * s2 + 4], st[kt][8 * s2 + 5], st[kt][8 * s2 + 6], st[kt][8 * s2 + 7]); }
        l += __shfl_xor(l, 32);
        const float il = 1.0f / l;
        bf16* orow = OX + R0 * DM + 256 * h + 4 * hh;
#pragma unroll
        for (int dt = 0; dt < 8; ++dt) {
            LAS bf16* cur = (dt & 1) ? T1_ : T0_; LAS bf16* nx = (dt & 1) ? T0_ : T1_;
            if (dt < 7) stage_tile_ld(vsrc + (size_t)(32 * (dt + 1)) * MMEM, MMEM, tid, rg);
            f32x16 ot;
#pragma unroll
            for (int r = 0; r < 16; ++r) ot[r] = 0.f;
            TILE_MFMA16(ot, cur + c * KTS + 8 * hh, pf);
#pragma unroll
            for (int q = 0; q < 4; ++q) { u32x2 wv; wv.x = pk2(ot[4 * q] * il, ot[4 * q + 1] * il); wv.y = pk2(ot[4 * q + 2] * il, ot[4 * q + 3] * il); *(u32x2*)(orow + 32 * dt + 8 * q) = wv; }
            if (dt < 7) stage_tile_st(nx, tid, rg);
            LDS_BARRIER();
        }
    }
}
#ifndef HOST_EMU
#define RLX_AGENT __ATOMIC_RELAXED, __HIP_MEMORY_SCOPE_AGENT
#define XB_TMO      128
#define XB_XCNT(j)  (256  + 64 * (j))
#define XB_XSUB(j)  (1280 + 64 * (j))
#define XB_XGEN(j)  (2304 + 64 * (j))
#define XB_TOP      3328
#define XB_TOPGEN   3392
#define XCD_BAR_WORDS 3456
#define XB_SPIN_CAP (1u << 18)

__device__ __forceinline__ unsigned xb_ld(unsigned* p)              { return __hip_atomic_load(p, __ATOMIC_RELAXED, __HIP_MEMORY_SCOPE_AGENT); }
__device__ __forceinline__ unsigned xb_add(unsigned* p, unsigned v) { return __hip_atomic_fetch_add(p, v, __ATOMIC_RELAXED, __HIP_MEMORY_SCOPE_AGENT); }
__device__ __forceinline__ unsigned xb_xcc_id() { return (unsigned)__builtin_amdgcn_s_getreg((3 << 11) | 20) & 0xFu; }
#define XB_SPIN(cond, bar) do { unsigned _sp = 0; while (cond) { __builtin_amdgcn_s_sleep(1); \
    if ((++_sp & 255u) == 0u) { if (xb_ld(&(bar)[XB_TMO])) break; if (_sp > XB_SPIN_CAP) { atomicAdd(&(bar)[XB_TMO], 1u); break; } } } } while (0)

struct XcdBarrier {
    unsigned* bar; unsigned x;
    volatile LAS unsigned* st;
};

__device__ __forceinline__ XcdBarrier xcd_barrier_post(unsigned* bar, volatile LAS unsigned* st) {
    XcdBarrier b; b.bar = bar; b.x = xb_xcc_id(); b.st = st;
    if (threadIdx.x == 0) (void)xb_add(&bar[XB_XCNT(b.x)], 1u);
    return b;
}
__device__ __forceinline__ void xcd_barrier_complete(unsigned* bar, unsigned x, unsigned& nloc, unsigned& nx) {
    const unsigned G = gridDim.x * gridDim.y * gridDim.z;
    unsigned sum, cnt, mine, sp = 0u;
    for (;;) {
        sum = 0u; cnt = 0u; mine = 0u;
#pragma unroll
        for (unsigned j = 0; j < 16; ++j) { const unsigned c = xb_ld(&bar[XB_XCNT(j)]); sum += c; cnt += (c > 0u) ? 1u : 0u; mine = (j == x) ? c : mine; }
        if (sum == G) break;
        __builtin_amdgcn_s_sleep(1);
        if ((++sp & 255u) == 0u) { if (xb_ld(&bar[XB_TMO])) break; if (sp > XB_SPIN_CAP) { atomicAdd(&bar[XB_TMO], 1u); break; } }
    }
    nloc = mine > 0u ? mine : 1u; nx = cnt > 0u ? cnt : 1u;
}

__device__ __forceinline__ void xcd_barrier(const XcdBarrier& b) {
    asm volatile("s_waitcnt vmcnt(0)" ::: "memory");
    __syncthreads();
    if (threadIdx.x == 0) {
        unsigned* bar = b.bar;
        __builtin_amdgcn_s_waitcnt(0);
        unsigned nloc = b.st[0], nx = b.st[1];
        if (nloc == 0u) { xcd_barrier_complete(bar, b.x, nloc, nx); b.st[0] = nloc; b.st[1] = nx; }
        const unsigned old = xb_add(&bar[XB_XSUB(b.x)], 1u);
        const unsigned gen = old / nloc;
        if (old + 1u == (gen + 1u) * nloc) {
            __builtin_amdgcn_fence(__ATOMIC_RELEASE, "agent");
            asm volatile("s_waitcnt vmcnt(0)" ::: "memory");
            const unsigned og = xb_add(&bar[XB_TOP], 1u);
            const unsigned tg = og / nx;
            if (og + 1u == (tg + 1u) * nx) xb_add(&bar[XB_TOPGEN], 1u);
            else XB_SPIN(xb_ld(&bar[XB_TOPGEN]) == tg, bar);
            __builtin_amdgcn_fence(__ATOMIC_ACQUIRE, "agent");
            xb_add(&bar[XB_XGEN(b.x)], 1u);
            asm volatile("s_waitcnt vmcnt(0)" ::: "memory");
        } else {
            XB_SPIN(xb_ld(&bar[XB_XGEN(b.x)]) == gen, bar);
            __builtin_amdgcn_fence(__ATOMIC_ACQUIRE, "agent");
            asm volatile("s_waitcnt vmcnt(0)" ::: "memory");
        }
    }
    __syncthreads();
}
#endif
#ifndef HOST_EMU
constexpr int NWAVES = 8;
constexpr int RING_BYTES = 131072, LDSCTL_OFF = RING_BYTES, MISC_OFF = LDSCTL_OFF + 320, LDS_BYTES = 147456;
constexpr int PTAB_OFF = LDSCTL_OFF + 1024;
constexpr int CW_BAR = 4096;
#ifndef MK_PER_PHASE
#define MK_PER_PHASE 0
#endif
constexpr int PH_PER_LAYER = 12, PH_FINAL = 1 + PH_PER_LAYER * DEPTH, N_PHASES = PH_FINAL + 1;
static_assert(RET_LDS <= RING_BYTES, "lds");

DEV volatile LAS unsigned long long* ptab_base(LAS unsigned char* lds) { unsigned o = PTAB_OFF; asm volatile("" : "+v"(o)); return (volatile LAS unsigned long long*)(lds + o); }
DEV unsigned long long ldptr(volatile LAS unsigned long long* pt, int k) { const unsigned long long v = pt[k];
    const unsigned lo = __builtin_amdgcn_readfirstlane((unsigned)v), hi = __builtin_amdgcn_readfirstlane((unsigned)(v >> 32)); return ((unsigned long long)hi << 32) | lo; }
#ifndef KB_REP
#define KB_REP 0
#endif
#define REPS(k) (1 + ((KB_REP >> (k)) & 1))
#ifndef KB_FFN_SPLIT
#define KB_FFN_SPLIT 1
#endif
#ifndef KB_STAGGER
#define KB_STAGGER 0
#endif
#ifndef KB_RSTAG
#define KB_RSTAG 0
#endif
#define RSTAG() do { if (KB_RSTAG) { if ((LG(bx) >> 3) & 1) { for (int i_ = 0; i_ < KB_RSTAG; ++i_) __builtin_amdgcn_s_sleep(127); } } } while (0)
#ifndef KB_PHMASK1
#define KB_PHMASK1 0xFFF
#endif
#ifndef KB_FINAL_SS
#define KB_FINAL_SS 0
#endif
#ifndef KB_LAYERS
#define KB_LAYERS 4
#endif
#ifndef KB_PHMASK
#define KB_PHMASK 0xFFF
#endif
DEV bool ph_enabled(int k) { if (k == 0 || k >= 1 + PH_PER_LAYER * DEPTH) return true; const int L = (k - 1) / PH_PER_LAYER, s = (k - 1) % PH_PER_LAYER; return L < KB_LAYERS && ((((L & 1) ? KB_PHMASK1 : KB_PHMASK) >> s) & 1); }
DEV int lane_id_fresh() { unsigned m = ~0u; asm volatile("" : "+s"(m)); return (int)__builtin_amdgcn_mbcnt_hi(m, __builtin_amdgcn_mbcnt_lo(m, 0u)); }
DEV XcdBarrier mk_bar(unsigned* p, volatile LAS unsigned* st) { XcdBarrier b; b.bar = p; b.x = xb_xcc_id(); b.st = st; return b; }
struct Args { const void* in[24]; float* out; unsigned char* ws; int ph_lo, ph_hi, li, pad; };

__global__ void __launch_bounds__(NWAVES * 64, 2) hybrid_fwd(Args args) {
    extern __shared__ __attribute__((aligned(16))) unsigned char lds_raw[];
    LAS unsigned char* lds = (LAS unsigned char*)lds_raw;
    volatile LAS unsigned* MISC = (volatile LAS unsigned*)(lds + MISC_OFF);
    const int tid0 = threadIdx.x; const int wave0 = __builtin_amdgcn_readfirstlane(tid0 >> 6);
    const int G = gridDim.x, bx = blockIdx.x, vcu = (G % 8 == 0) ? (bx % 8) * (G / 8) + bx / 8 : bx;
    const int NGW = G * NWAVES, NGT = G * NWAVES * 64;
#define LG(v) ({ int v_ = (v); asm volatile("" : "+s"(v_)); v_; })
#define PH_IDS int tid = LG(wave0) * 64 + lane_id_fresh(); asm volatile("" : "+v"(tid)); const int lane = tid & 63, wave = __builtin_amdgcn_readfirstlane(tid >> 6), gw = LG(vcu) * NWAVES + wave, gt = LG(vcu) * (NWAVES * 64) + tid; (void)lane; (void)gw; (void)gt;
    for (int u = tid0; u < (LDS_BYTES - LDSCTL_OFF) / 4; u += NWAVES * 64) ((LAS unsigned*)(lds + LDSCTL_OFF))[u] = 0u;
    __syncthreads();
    volatile LAS unsigned long long* PT = (volatile LAS unsigned long long*)(lds + PTAB_OFF);
    if (tid0 < 24) PT[tid0] = (unsigned long long)args.in[tid0];
    if (tid0 == 24) PT[24] = (unsigned long long)args.out;
    if (tid0 == 25) PT[25] = (unsigned long long)args.ws;
    __syncthreads();
#define PTR(k) ((const void*)(GAS const void*)ldptr(ptab_base(lds), (k)))
    (void)xcd_barrier_post((unsigned*)(args.ws + WS_CTL) + CW_BAR + args.li * XCD_BAR_WORDS, MISC + 8);
    const int li_ = args.li;
#define bar mk_bar((unsigned*)((unsigned char*)PTR(25) + WS_CTL) + CW_BAR + LG(li_) * XCD_BAR_WORDS, (volatile LAS unsigned*)(lds + MISC_OFF) + 8)
    const int lo = args.ph_lo, hi = args.ph_hi;
#if MK_PER_PHASE || defined(KB_DEBUG)
#define RUN(k) (lo <= (k) && (k) < hi && ph_enabled(k))
#define SEAM(k) do { if (RUN(k) && RUN((k) + 1)) xcd_barrier(bar); } while (0)
#else
#define RUN(k) true
#define SEAM(k) xcd_barrier(bar)
#endif
#define WSP ((unsigned char*)PTR(25))
#define OUTP ((float*)PTR(24))
#define INF(k) ((const float*)PTR(k))
    LAS unsigned char* ring = lds;

    for (int rep_ = 0; rep_ < REPS(11); ++rep_) { if (rep_) xcd_barrier(bar);
    if (RUN(0)) { PH_IDS unsigned char* ws = WSP; ssq_t* SS0 = (ssq_t*)(ws + WS_SSQ);
        rot_table((float*)(ws + WS_ROT), gt, NGT);
        for (int j = 0; j < DEPTH / 2; ++j) s5_tables(INF(10) + (size_t)j * S5G * S5P, INF(11) + (size_t)j * S5G * S5P, INF(12) + (size_t)j * S5G, INF(13) + (size_t)j * S5G * S5P * S5H, INF(14) + (size_t)j * S5G * S5P * S5H,
                                                      INF(15) + (size_t)j * S5G * S5H * S5P, INF(16) + (size_t)j * S5G * S5H * S5P, ws + (size_t)j * S5T_STRIDE, gt, NGT); memn_rows(INF(1), INF(4), (bf16*)(ws + WS_MEMN), (bf16*)(ws + WS_MEMNP), gw, NGW, lane); x0_rows(INF(0), (bf16*)(ws + WS_XHAT), SS0, SS0 + M, gw, NGW, lane); }
    }
    for (int L = 0; L < DEPTH; ++L) {
        const int pb = 1 + PH_PER_LAYER * L; const bool isret = (L & 1) != 0; const int j = L >> 1;
for (int rep_ = 0; rep_ < REPS(0); ++rep_) { if (rep_) xcd_barrier(bar);
        if (RUN(pb + 0)) { PH_IDS unsigned char* ws = WSP;
            LayerW lw;
            lw.g = INF(3) + (size_t)L * 4 * DM;
            lw.f1in = INF(6) + (size_t)L * DM * 2 * DFF; lw.f1out = INF(7) + (size_t)L * DFF * DM;
            lw.f2in = INF(8) + (size_t)L * DM * 2 * DFF; lw.f2out = INF(9) + (size_t)L * DFF * DM;
            lw.mixin = isret ? INF(19) + (size_t)j * DM * RIN : INF(18) + (size_t)j * DM * 2 * DM;
            lw.mixout = isret ? INF(20) + (size_t)j * RVW * DM : nullptr;
            lw.xq = INF(21) + (size_t)L * DM * DM; lw.xkv = INF(22) + (size_t)L * DM * 2 * DM; lw.xkv2 = INF(22) + (size_t)(L + 1 < DEPTH ? L + 1 : L) * DM * 2 * DM; lw.xo = INF(23) + (size_t)L * DM * DM;
            lw.is_ret = isret ? 1 : 0;
            convert_layer(lw, ws, (LAS float*)(ring + wave * 16384), gw, NGW, lane);
        }
}
        SEAM(pb + 0);
for (int rep_ = 0; rep_ < REPS(1); ++rep_) { if (rep_) xcd_barrier(bar);
        if (RUN(pb + 1)) { unsigned char* ws = WSP; ssq_t* SS0 = (ssq_t*)(ws + WS_SSQ);
            for (int hb = 0; hb < KB_FFN_SPLIT; ++hb) { const size_t r0 = (size_t)hb * (M / KB_FFN_SPLIT);
                { pg8::Gemm g{(const bf16*)(ws + WS_XHAT) + r0 * DM, (const bf16*)(ws + W_F1IN), M / KB_FFN_SPLIT, 2 * DFF, DM}; pg8::StaticOrder S; S.init(M / KB_FFN_SPLIT, 2 * DFF, LG(G), LG(bx)); EpiSwiGLU E{(bf16*)(ws + BIG_H) + r0 * DFF, SS0 + r0};
                  pg8::gemm_phase<EpiSwiGLU, pg8::StaticOrder, true, true>(ring, g, S, E, LG(wave0)); }
                if (hb + 1 < KB_FFN_SPLIT) { xcd_barrier(bar);
                    RSTAG(); pg8::Gemm g{(const bf16*)(ws + BIG_H) + r0 * DFF, (const bf16*)(ws + W_F1OUT), M / KB_FFN_SPLIT, DM, DFF}; pg8::StaticOrder S; S.init(M / KB_FFN_SPLIT, DM, LG(G), LG(bx)); EpiResid E{(bf16*)(ws + WS_XHAT) + r0 * DM, (SS0 + M) + r0, SS0 + r0, 0.5f};
                    pg8::gemm_phase<EpiResid, pg8::StaticOrder, true, true>(ring, g, S, E, LG(wave0)); xcd_barrier(bar); } }
        }
}
        SEAM(pb + 1);
        if (RUN(pb + 2)) { unsigned char* ws = WSP; ssq_t* SS0 = (ssq_t*)(ws + WS_SSQ); const size_t r0 = (size_t)(KB_FFN_SPLIT - 1) * (M / KB_FFN_SPLIT);
            RSTAG(); pg8::Gemm g{(const bf16*)(ws + BIG_H) + r0 * DFF, (const bf16*)(ws + W_F1OUT), M / KB_FFN_SPLIT, DM, DFF}; pg8::StaticOrder S; S.init(M / KB_FFN_SPLIT, DM, LG(G), LG(bx)); EpiResid E{(bf16*)(ws + WS_XHAT) + r0 * DM, (SS0 + M) + r0, SS0 + r0, 0.5f};
            pg8::gemm_phase<EpiResid, pg8::StaticOrder, true, true>(ring, g, S, E, LG(wave0)); }
        SEAM(pb + 2);
        if ((KB_REP >> 8) & 1) { unsigned char* ws = WSP; pg8::Gemm g{(const bf16*)(ws + WS_XHAT), (const bf16*)(ws + W_F1IN), M, 2 * DFF, DM}; pg8::StaticOrder S; S.init(M, 2 * DFF, LG(G), LG(bx)); EpiNull E{};
            pg8::gemm_phase<EpiNull, pg8::StaticOrder, true, true>(ring, g, S, E, LG(wave0)); xcd_barrier(bar); }
        if ((KB_REP >> 9) & 1) { unsigned char* ws = WSP; pg8::Gemm g{(const bf16*)(ws + BIG_H), (const bf16*)(ws + W_F1OUT), M, DM, DFF}; pg8::StaticOrder S; S.init(M, DM, LG(G), LG(bx)); EpiNull E{};
            pg8::gemm_phase<EpiNull, pg8::StaticOrder, true, true>(ring, g, S, E, LG(wave0)); xcd_barrier(bar); }
        if ((KB_REP >> 10) & 1) { unsigned char* ws = WSP; pg8::Gemm g{(const bf16*)(ws + BIG_H), (const bf16*)(ws + W_F1OUT), M, DM, DFF}; pg8::StaticOrder S; S.init(M, DM, LG(G), LG(bx));
            EpiResid E{(bf16*)(ws + WS_BIG + 384 * MiB), (ssq_t*)(ws + WS_BIG + 770 * MiB), (ssq_t*)(ws + WS_BIG + 771 * MiB), 0.5f};
            pg8::gemm_phase<EpiResid, pg8::StaticOrder, true, true>(ring, g, S, E, LG(wave0)); xcd_barrier(bar); }
        if (!isret) {
for (int rep_ = 0; rep_ < REPS(2); ++rep_) { if (rep_) xcd_barrier(bar);
            if (RUN(pb + 3)) { PH_IDS unsigned char* ws = WSP; s5_pass<1>((const bf16*)(ws + WS_XHAT), (const ssq_t*)(ws + WS_SSQ) + M, INF(3) + ((size_t)L * 4 + 1) * DM, INF(17) + (size_t)j * DM, ws + (size_t)j * S5T_STRIDE, (float*)(ws + BIG_ES), (bf16*)(ws + BIG_YB), ring, LG(vcu), LG(G), tid); }
            SEAM(pb + 3);
            if (RUN(pb + 4)) { PH_IDS unsigned char* ws = WSP; s5_carry((float*)(ws + BIG_ES), ws + (size_t)j * S5T_STRIDE, gt, NGT);
                for (int set = 0; set < 2; ++set) {
                    { pg8::Gemm g{(const bf16*)(ws + WS_MEMN), (const bf16*)(ws + W_XK + set * W_XKV_SET), MMEM, DM, DM}; pg8::StaticOrder S; S.init(MMEM, DM, LG(G), (LG(bx) + (2 * set) * (LG(G) / 4)) % LG(G)); EpiBf16<0> E{(bf16*)(ws + WS_XK + set * XKV_SET), DM, nullptr};
                      pg8::gemm_phase<EpiBf16<0>, pg8::StaticOrder, true, true>(ring, g, S, E, LG(wave0)); }
                    { pg8::Gemm g{(const bf16*)(ws + W_XV + set * W_XKV_SET), (const bf16*)(ws + WS_MEMNP), DM, MMEM, DM}; pg8::StaticOrder S; S.init(DM, MMEM, LG(G), (LG(bx) + (2 * set + 1) * (LG(G) / 4)) % LG(G)); EpiBf16<0> E{(bf16*)(ws + WS_XVT + set * XKV_SET), MMEM, nullptr};
                      pg8::gemm_phase<EpiBf16<0>, pg8::StaticOrder, true, true>(ring, g, S, E, LG(wave0)); } } }
            SEAM(pb + 4);
            if (RUN(pb + 5)) { PH_IDS unsigned char* ws = WSP; s5_pass<3>((const bf16*)(ws + WS_XHAT), (const ssq_t*)(ws + WS_SSQ) + M, INF(3) + ((size_t)L * 4 + 1) * DM, INF(17) + (size_t)j * DM, ws + (size_t)j * S5T_STRIDE, (float*)(ws + BIG_ES), (bf16*)(ws + BIG_YB), ring, LG(vcu), LG(G), tid); }
}
            SEAM(pb + 5);
            if (RUN(pb + 6)) { unsigned char* ws = WSP; ssq_t* SS0 = (ssq_t*)(ws + WS_SSQ);
                RSTAG(); pg8::Gemm g{(const bf16*)(ws + BIG_YB), (const bf16*)(ws + W_MIX), M, 2 * DM, DM}; pg8::StaticOrder S; S.init(M, 2 * DM, LG(G), LG(bx)); EpiS5Glu E{(bf16*)(ws + WS_XHAT), SS0, SS0 + M};
                pg8::gemm_phase<EpiS5Glu, pg8::StaticOrder, true, true>(ring, g, S, E, LG(wave0)); }
            SEAM(pb + 6);
        } else {
for (int rep_ = 0; rep_ < REPS(3); ++rep_) { if (rep_) xcd_barrier(bar);
            if (RUN(pb + 3)) { unsigned char* ws = WSP;
                { pg8::Gemm g{(const bf16*)(ws + WS_XHAT), (const bf16*)(ws + W_MIX), M, 2 * DM, DM}; pg8::StaticOrder S; S.init(M, 2 * DM, LG(G), LG(bx));
                  EpiRetIn E{(bf16*)(ws + BIG_RQ), (bf16*)(ws + BIG_RK), (const ssq_t*)(ws + WS_SSQ) + M, (const float*)(ws + WS_ROT), (const int*)PTR(2)};
                  pg8::gemm_phase<EpiRetIn, pg8::StaticOrder, true, true>(ring, g, S, E, LG(wave0)); }
                { pg8::Gemm g{(const bf16*)(ws + W_MIX) + (size_t)(2 * DM) * DM, (const bf16*)(ws + WS_XHAT), RVW, M, DM}; pg8::StaticOrder S; S.init(RVW, M, LG(G), LG(bx));
                  EpiRetVT E{(bf16*)(ws + BIG_RVT), (const ssq_t*)(ws + WS_SSQ) + M};
                  pg8::gemm_phase<EpiRetVT, pg8::StaticOrder, true, true>(ring, g, S, E, LG(wave0)); } }
}
            SEAM(pb + 3);
            for (int rep_ = 0; rep_ < REPS(4); ++rep_) { if (rep_) xcd_barrier(bar);
#if defined(KB_RET_STUB)
            if (RUN(pb + 4)) { PH_IDS unsigned char* ws = WSP; bf16* ro = (bf16*)(ws + BIG_RO); const bf16* rq = (const bf16*)(ws + (KB_RET_STUB == 1 ? BIG_RQ : BIG_RK)); float* rst = (float*)(ws + BIG_RST);
                for (size_t i = gt; i < (size_t)M * RVW / 8; i += NGT) { const size_t row = i / (RVW / 8), c8 = i % (RVW / 8); u32x4 v;
                    if (KB_RET_STUB == 3) v = *(const u32x4*)((const bf16*)(ws + BIG_RVT) + (c8 * 8) * (size_t)M / 8 * 8 + row / 8 * 8 + 0) ; else v = *(const u32x4*)(rq + row * DM + (c8 & 127) * 8);
                    *(u32x4*)(ro + i * 8) = v; }
                for (size_t i = gt; i < (size_t)M * RH * 8; i += NGT) { rst[2 * i] = 0.f; rst[2 * i + 1] = 64.f; } }
#else
            if (RUN(pb + 4)) { PH_IDS unsigned char* ws = WSP;

                ret_core((const bf16*)(ws + BIG_RQ), (const bf16*)(ws + BIG_RK), (const bf16*)(ws + BIG_RVT), (bf16*)(ws + BIG_RO), (float*)(ws + BIG_RST), ring, LG(vcu), LG(G), tid); }
#endif
}
#ifdef KB_PROBE_SKIP
            { xcd_barrier(bar); PH_IDS unsigned char* ws = WSP; ret_core<KB_PROBE_SKIP>((const bf16*)(ws + BIG_RQ), (const bf16*)(ws + BIG_RK), (const bf16*)(ws + BIG_RVT), (bf16*)OUTP, (float*)((char*)OUTP + 0), ring, LG(vcu), LG(G), tid); }
#endif
            SEAM(pb + 4);
            if (RUN(pb + 5)) { unsigned char* ws = WSP;
                pg8::Gemm g{(const bf16*)(ws + WS_XHAT), (const bf16*)(ws + W_MIX) + (size_t)(2 * DM + RVW) * DM, M, RVW, DM}; pg8::StaticOrder S; S.init(M, RVW, LG(G), LG(bx));
                EpiRetGate E{(bf16*)(ws + BIG_RO), (const ssq_t*)(ws + WS_SSQ) + M, (const float*)(ws + BIG_RST)};
                pg8::gemm_phase<EpiRetGate, pg8::StaticOrder, true, true>(ring, g, S, E, LG(wave0)); }
            SEAM(pb + 5);
            if (RUN(pb + 6)) { unsigned char* ws = WSP; ssq_t* SS0 = (ssq_t*)(ws + WS_SSQ);
                RSTAG(); pg8::Gemm g{(const bf16*)(ws + BIG_RO), (const bf16*)(ws + W_ROUT), M, DM, RVW}; pg8::StaticOrder S; S.init(M, DM, LG(G), LG(bx)); EpiResid E{(bf16*)(ws + WS_XHAT), SS0, SS0 + M, 1.0f};
                pg8::gemm_phase<EpiResid, pg8::StaticOrder, true, true>(ring, g, S, E, LG(wave0)); }
            SEAM(pb + 6);
        }
for (int rep_ = 0; rep_ < REPS(5); ++rep_) { if (rep_) xcd_barrier(bar);
        if (RUN(pb + 7)) { unsigned char* ws = WSP;
            pg8::Gemm g{(const bf16*)(ws + WS_XHAT), (const bf16*)(ws + W_XQ), M, DM, DM}; pg8::StaticOrder S; S.init(M, DM, LG(G), LG(bx));
            EpiBf16<1> E{(bf16*)(ws + BIG_XQ), DM, (const ssq_t*)(ws + WS_SSQ)}; pg8::gemm_phase<EpiBf16<1>, pg8::StaticOrder, true, true>(ring, g, S, E, LG(wave0)); }
}
        SEAM(pb + 7);
for (int rep_ = 0; rep_ < REPS(6); ++rep_) { if (rep_) xcd_barrier(bar);
        if (RUN(pb + 8)) { PH_IDS unsigned char* ws = WSP; xattn_core((const bf16*)(ws + BIG_XQ), (const bf16*)(ws + WS_XK + (L & 1) * XKV_SET), (const bf16*)(ws + WS_XVT + (L & 1) * XKV_SET), (bf16*)(ws + BIG_XO), ring, LG(vcu), LG(G), tid); }
}
        SEAM(pb + 8);
        if (RUN(pb + 9)) { unsigned char* ws = WSP; ssq_t* SS0 = (ssq_t*)(ws + WS_SSQ);
            RSTAG(); pg8::Gemm g{(const bf16*)(ws + BIG_XO), (const bf16*)(ws + W_XO), M, DM, DM}; pg8::StaticOrder S; S.init(M, DM, LG(G), LG(bx)); EpiResid E{(bf16*)(ws + WS_XHAT), SS0 + M, SS0, 1.0f};
            pg8::gemm_phase<EpiResid, pg8::StaticOrder, true, true>(ring, g, S, E, LG(wave0)); }
        SEAM(pb + 9);
for (int rep_ = 0; rep_ < REPS(7); ++rep_) { if (rep_) xcd_barrier(bar);
        if (RUN(pb + 10)) { unsigned char* ws = WSP; ssq_t* SS0 = (ssq_t*)(ws + WS_SSQ);
            for (int hb = 0; hb < KB_FFN_SPLIT; ++hb) { const size_t r0 = (size_t)hb * (M / KB_FFN_SPLIT);
                { pg8::Gemm g{(const bf16*)(ws + WS_XHAT) + r0 * DM, (const bf16*)(ws + W_F2IN), M / KB_FFN_SPLIT, 2 * DFF, DM}; pg8::StaticOrder S; S.init(M / KB_FFN_SPLIT, 2 * DFF, LG(G), LG(bx)); EpiSwiGLU E{(bf16*)(ws + BIG_H) + r0 * DFF, (SS0 + M) + r0};
                  pg8::gemm_phase<EpiSwiGLU, pg8::StaticOrder, true, true>(ring, g, S, E, LG(wave0)); }
                if (hb + 1 < KB_FFN_SPLIT) { xcd_barrier(bar);
                    RSTAG(); pg8::Gemm g{(const bf16*)(ws + BIG_H) + r0 * DFF, (const bf16*)(ws + W_F2OUT), M / KB_FFN_SPLIT, DM, DFF}; pg8::StaticOrder S; S.init(M / KB_FFN_SPLIT, DM, LG(G), LG(bx)); EpiResid E{(bf16*)(ws + WS_XHAT) + r0 * DM, SS0 + r0, (SS0 + M) + r0, 0.5f};
                    pg8::gemm_phase<EpiResid, pg8::StaticOrder, true, true>(ring, g, S, E, LG(wave0)); xcd_barrier(bar); } }
        }
}
        SEAM(pb + 10);
        if (RUN(pb + 11)) { unsigned char* ws = WSP; ssq_t* SS0 = (ssq_t*)(ws + WS_SSQ); const size_t r0 = (size_t)(KB_FFN_SPLIT - 1) * (M / KB_FFN_SPLIT);
            RSTAG(); pg8::Gemm g{(const bf16*)(ws + BIG_H) + r0 * DFF, (const bf16*)(ws + W_F2OUT), M / KB_FFN_SPLIT, DM, DFF}; pg8::StaticOrder S; S.init(M / KB_FFN_SPLIT, DM, LG(G), LG(bx)); EpiResid E{(bf16*)(ws + WS_XHAT) + r0 * DM, SS0 + r0, (SS0 + M) + r0, 0.5f};
            pg8::gemm_phase<EpiResid, pg8::StaticOrder, true, true>(ring, g, S, E, LG(wave0)); }
        SEAM(pb + 11);
    }
    for (int rep_ = 0; rep_ < REPS(12); ++rep_) { if (rep_) xcd_barrier(bar);
    if (RUN(PH_FINAL)) { PH_IDS unsigned char* ws = WSP; float* out = OUTP; final_rows((const bf16*)(ws + WS_XHAT), (const ssq_t*)(ws + WS_SSQ) + KB_FINAL_SS * M, INF(5), out, gw, NGW, lane); }
    }
#undef RUN
#undef SEAM
#undef bar
}

extern "C" void kernel_launch(void* const* d_in, const int* in_sizes, int n_in, void* d_out, int out_size, void* d_ws, size_t ws_size, hipStream_t stream) {
    static int grid = 0;
    if (grid == 0) {
        if (n_in != 24 || in_sizes[0] != M * DM || out_size != M * DM || ws_size < WS_END) { fprintf(stderr, "kernel_launch: unexpected shapes / workspace (n_in %d, ws %zu, need %zu)\n", n_in, ws_size, (size_t)WS_END); grid = -1; return; }
        int dev = 0, cus = 0, per_cu = 0;
        if (hipGetDevice(&dev) != hipSuccess || hipDeviceGetAttribute(&cus, hipDeviceAttributeMultiprocessorCount, dev) != hipSuccess) { grid = -1; return; }
        if (hipFuncSetAttribute((const void*)hybrid_fwd, hipFuncAttributeMaxDynamicSharedMemorySize, LDS_BYTES) != hipSuccess) { fprintf(stderr, "kernel_launch: hipFuncSetAttribute failed\n"); grid = -1; return; }
        if (hipOccupancyMaxActiveBlocksPerMultiprocessor(&per_cu, (const void*)hybrid_fwd, NWAVES * 64, LDS_BYTES) != hipSuccess || per_cu < 1) { fprintf(stderr, "kernel_launch: occupancy query says %d blocks per CU\n", per_cu); }
        (void)hipGetLastError();
        grid = cus;
    }
    if (grid < 0) return;
    if (hipMemsetAsync((char*)d_ws + WS_CTL, 0, CTL_ZERO_BYTES, stream) != hipSuccess) return;
    Args a{};
    for (int i = 0; i < 24; ++i) a.in[i] = d_in[i];
    a.out = (float*)d_out; a.ws = (unsigned char*)d_ws; a.pad = 0;
#if MK_PER_PHASE
    for (int p = 0; p < N_PHASES; ++p) { a.ph_lo = p; a.ph_hi = p + 1; a.li = 0; hipLaunchKernelGGL(hybrid_fwd, dim3(grid), dim3(NWAVES * 64), LDS_BYTES, stream, a); }
#else
    a.ph_lo = 0; a.ph_hi = N_PHASES; a.li = 0;
    hipLaunchKernelGGL(hybrid_fwd, dim3(grid), dim3(NWAVES * 64), LDS_BYTES, stream, a);
#endif
}
#endif
```

```cpp
#ifndef HOST_EMU
#include <hip/hip_runtime.h>
#include <cstdio>
#include <cstdint>
#define LAS __attribute__((address_space(3)))
#define GAS __attribute__((address_space(1)))
#define DEV __device__ __forceinline__
#else
#include "emu.h"
#define LAS
#define GAS
#define DEV inline
#endif

#ifndef KB_BATCH
#define KB_BATCH 8
#endif
#ifndef KB_SEQ
#define KB_SEQ 8192
#endif
constexpr int BATCH = KB_BATCH, SEQ = KB_SEQ, DM = 1024, DEPTH = 4, NMEM = 256, DFF = 2816;
constexpr int M = BATCH * SEQ;
constexpr int MMEM = BATCH * NMEM;
constexpr int S5G = 64, S5P = 64, S5H = 16;
constexpr int S5_NCH = 64;
constexpr int S5_LC = SEQ / S5_NCH;
constexpr int RH = 4, RDK = 256, RDV = 512, RVW = RH * RDV, RIN = 2 * DM + 2 * RVW;
constexpr int RMC = 256;
constexpr int XH = 4, XD = 256;
constexpr int ROT_NPOS = 12288;
constexpr float EPS = 1e-6f;
constexpr int SSQW = 32;

typedef unsigned short bf16;
typedef short bf16x8 __attribute__((ext_vector_type(8)));
typedef short s16x4 __attribute__((ext_vector_type(4)));
typedef float f32x4 __attribute__((ext_vector_type(4)));
typedef float f32x2 __attribute__((ext_vector_type(2)));
typedef float f32x16 __attribute__((ext_vector_type(16)));
typedef unsigned u32x4 __attribute__((ext_vector_type(4)));
typedef unsigned u32x2 __attribute__((ext_vector_type(2)));

DEV unsigned f2bf(float f) { unsigned u = __builtin_bit_cast(unsigned, f); return (u + 0x7fffu + ((u >> 16) & 1u)) >> 16; }
DEV float bf2f(unsigned h) { return __builtin_bit_cast(float, (h & 0xffffu) << 16); }
DEV float bflo(unsigned w) { return __builtin_bit_cast(float, w << 16); }
DEV float bfhi(unsigned w) { return __builtin_bit_cast(float, w & 0xffff0000u); }
#ifndef HOST_EMU
typedef __bf16 bf16v2_t __attribute__((ext_vector_type(2)));
DEV unsigned pk2(float lo, float hi) { const f32x2 v = {lo, hi}; const bf16v2_t b = __builtin_convertvector(v, bf16v2_t); return __builtin_bit_cast(unsigned, b); }
DEV float fexp2(float x) { return __builtin_amdgcn_exp2f(x); }
DEV float frcp(float x) { return __builtin_amdgcn_rcpf(x); }
DEV float frsq(float x) { return __builtin_amdgcn_rsqf(x); }
#define MFMA32(a, b, c) __builtin_amdgcn_mfma_f32_32x32x16_bf16(a, b, c, 0, 0, 0)
#define MFMA16K16(a, b, c) __builtin_amdgcn_mfma_f32_16x16x16bf16_1k(a, b, c, 0, 0, 0)
#else
DEV unsigned pk2(float lo, float hi) { return f2bf(lo) | (f2bf(hi) << 16); }
DEV float fexp2(float x) { return exp2f(x); }
DEV float frcp(float x) { return 1.0f / x; }
DEV float frsq(float x) { return 1.0f / sqrtf(x); }
#define MFMA32(a, b, c) emu_mfma32(a, b, c)
#define MFMA16K16(a, b, c) emu_mfma16k16(a, b, c)
#endif
DEV float sigmoidf_(float x) { return frcp(1.0f + fexp2(-1.4426950408889634f * x)); }
DEV float siluf_(float x) { return x * sigmoidf_(x); }
DEV float gelu_tanh(float x) { const float u = 0.7978845608028654f * (x + 0.044715f * x * x * x); return x * sigmoidf_(2.0f * u); }
DEV int pos16(int n) { return (n & 3) | ((n & 4) << 1) | ((n & 8) >> 1); }
DEV int rowmap32(int reg, int hh) { return (reg & 3) + 8 * (reg >> 2) + 4 * hh; }
DEV bf16x8 pack8(float a0, float a1, float a2, float a3, float a4, float a5, float a6, float a7) {
    u32x4 w; w.x = pk2(a0, a1); w.y = pk2(a2, a3); w.z = pk2(a4, a5); w.w = pk2(a6, a7); return __builtin_bit_cast(bf16x8, w); }
DEV s16x4 pack4(float a0, float a1, float a2, float a3) { u32x2 w; w.x = pk2(a0, a1); w.y = pk2(a2, a3); return __builtin_bit_cast(s16x4, w); }
DEV float wave_sum(float v) {
#pragma unroll
    for (int o = 1; o < 64; o <<= 1) v += __shfl_xor(v, o);
    return v;
}

constexpr size_t MiB = 1u << 20;
constexpr size_t WS_CTL = 0, CTL_ZERO_BYTES = 1 * MiB;
constexpr size_t WS_W = 1 * MiB;
constexpr size_t W_F1IN = WS_W, W_F1OUT = W_F1IN + (size_t)2 * DFF * DM * 2, W_F2IN = W_F1OUT + (size_t)DM * DFF * 2, W_F2OUT = W_F2IN + (size_t)2 * DFF * DM * 2;
constexpr size_t W_MIX = W_F2OUT + (size_t)DM * DFF * 2;
constexpr size_t W_ROUT = W_MIX + (size_t)RIN * DM * 2;
constexpr size_t W_XQ = W_ROUT + (size_t)DM * RVW * 2, W_XO = W_XQ + (size_t)DM * DM * 2, W_XK = W_XO + (size_t)DM * DM * 2, W_XV = W_XK + (size_t)DM * DM * 2;
constexpr size_t W_XKV_SET = (size_t)2 * DM * DM * 2;
constexpr size_t W_END = W_XV + (size_t)DM * DM * 2 + W_XKV_SET;
static_assert(W_END <= 65 * MiB, "weight region");
constexpr size_t WS_S5T = 65 * MiB, S5T_STRIDE = 1 * MiB;
constexpr size_t S5T_BBAR = WS_S5T, S5T_CT = S5T_BBAR + (size_t)S5G * 2 * S5P * S5H * 2, S5T_A = S5T_CT + (size_t)S5G * 2 * S5H * S5P * 2, S5T_AL = S5T_A + (size_t)S5G * S5P * 2 * 4;
static_assert(S5T_AL + (size_t)S5G * S5P * 2 * 4 <= WS_S5T + S5T_STRIDE, "s5 tables");
constexpr size_t WS_ROT = 67 * MiB;
static_assert((size_t)ROT_NPOS * 128 * 8 <= 13 * MiB, "rot table");
constexpr size_t WS_MEMN = 80 * MiB, WS_MEMNP = 84 * MiB;
constexpr size_t WS_XK = 88 * MiB, WS_XVT = 96 * MiB, XKV_SET = 4 * MiB;
constexpr size_t WS_SSQ = 104 * MiB;
constexpr size_t WS_XHAT = 105 * MiB;
constexpr size_t WS_BIG = 233 * MiB;
constexpr size_t BIG_H = WS_BIG;
constexpr size_t BIG_YB = WS_BIG, BIG_ES = WS_BIG + 128 * MiB;
constexpr size_t BIG_RQ = WS_BIG, BIG_RK = WS_BIG + 128 * MiB, BIG_RVT = WS_BIG + 256 * MiB, BIG_RO = WS_BIG + 512 * MiB, BIG_RST = WS_BIG + 768 * MiB;
constexpr size_t BIG_XQ = WS_BIG, BIG_XO = WS_BIG + 128 * MiB;
constexpr size_t WS_END = WS_BIG + 784 * MiB;
static_assert(WS_END <= (size_t)1024 * MiB, "workspace map");
#ifndef HOST_EMU
namespace pg8 {
#define PG8_LAS __attribute__((address_space(3)))
typedef unsigned short bf16_t;
typedef short bf16x8 __attribute__((ext_vector_type(8)));
typedef float f32x4 __attribute__((ext_vector_type(4)));
typedef unsigned u32x4 __attribute__((ext_vector_type(4)));
constexpr int BM = 256, BK = 64, HALF = 128, HTB = HALF * BK * 2  , STAGE_BYTES = 8 * HTB, NXCD = 8, WGM = 8;

__host__ __device__ __forceinline__ int lds_byte(int r, int c) { const int st = (r >> 4) * 2 + (c >> 5), rr = r & 15, cc = c & 31, ob = rr * 64 + cc * 2; return st * 1024 + (ob ^ (((ob >> 9) & 1) << 5)); }
__host__ __device__ __forceinline__ void stage_rc(int b, int& R, int& C) { const int st = b / 1024, sb = b % 1024, swz = sb ^ (((sb >> 9) & 1) << 5); R = (st >> 1) * 16 + swz / 64; C = (st & 1) * 32 + (swz % 64) / 2; }
__host__ __device__ __forceinline__ int perm32(int rho) { const int n = rho >> 4, i = rho & 15; return 8 * (i >> 2) + 4 * n + (i & 3); }

struct Unit { int pm, pn; };
struct Gemm { const bf16_t* A; const bf16_t* Bt; int M, N, K; int ld = 0; };

struct StaticOrder {
    int nM, nN, nwg, G, c;
    __host__ __device__ void init(int M, int N, int G_, int c_) { nM = M / BM; nN = N / BM; nwg = nM * nN; G = G_; c = c_; }
    __host__ __device__ bool next(int i, Unit& u) const {
        const long L = (long)i * G + c; if (L >= nwg) return false;
        int wgid = (int)L; { const int q = nwg / NXCD, r = nwg % NXCD, xcd = wgid % NXCD, off = wgid / NXCD; wgid = (xcd < r ? xcd * (q + 1) : r * (q + 1) + (xcd - r) * q) + off; }
        const int nig = WGM * nN, gid = wgid / nig, fm = gid * WGM, gsz = (nM - fm) < WGM ? (nM - fm) : WGM;
        u.pm = fm + ((wgid % nig) % gsz); u.pn = (wgid % nig) / gsz; return true;
    }
    __device__ __forceinline__ void a_ready(const Unit&) const {}
    __device__ __forceinline__ void done(const Unit&) const {}
};
}
#endif
#ifdef HOST_EMU
namespace pg8 { struct Unit { int pm, pn; }; constexpr int BM = 256, HALF = 128; }
#endif
typedef f32x4 AccT[2][2][4][2];
#if !defined(HOST_EMU) && defined(KB_NT_H)
#define NT_STORE16(p, v) __builtin_nontemporal_store((v), (p))
#else
#define NT_STORE16(p, v) (*(p) = (v))
#endif
#ifndef HOST_EMU
#define EPI_OPAQUE(a, b) asm volatile("" : "+v"(a), "+v"(b))
#else
#define EPI_OPAQUE(a, b) do {} while (0)
#endif

typedef unsigned long long ssq_t;
constexpr float SSQ_SCALE = 1048576.0f, SSQ_INV = 1.0f / 1048576.0f;
DEV ssq_t ss_fix(float v) { return (ssq_t)(v * SSQ_SCALE + 0.5f); }
DEV float ss_val(ssq_t v) { return (float)v * SSQ_INV; }
#ifndef HOST_EMU
DEV ssq_t zero64() { unsigned lo = 0u, hi = 0u; asm volatile("" : "+v"(lo), "+v"(hi)); return ((ssq_t)hi << 32) | lo; }
#else
DEV ssq_t zero64() { return 0ull; }
#endif
DEV void row_rstd(const ssq_t* ss, int row0, float (&rs)[2][4]) {
#pragma unroll
    for (int ai = 0; ai < 2; ++ai)
#pragma unroll
        for (int m = 0; m < 4; ++m) rs[ai][m] = frsq(ss_val(ss[row0 + 128 * ai + 16 * m]) * (1.0f / DM) + EPS);
}
#ifndef HOST_EMU
DEV void ss_add(ssq_t* p, float v) { atomicAdd(p, ss_fix(v)); }
#else
#include <mutex>
static std::mutex e_atomic_mtx;
DEV void ss_add(ssq_t* p, float v) { std::lock_guard<std::mutex> g(e_atomic_mtx); *p += ss_fix(v); }
#endif

struct EpiResid {
    static constexpr bool PERM = true, AFTER_DRAIN = false;
    bf16* xh; ssq_t* ss_acc; ssq_t* ss_zero; float scale;
    DEV void operator()(const AccT& acc, const pg8::Unit& u, int wr, int wc, int fr, int fq) const {
        EPI_OPAQUE(fr, fq);
        const int row0 = u.pm * 256 + wr * 64 + fr, col0 = u.pn * 256 + wc * 32 + 8 * fq;
#pragma unroll
        for (int ai = 0; ai < 2; ++ai)
#pragma unroll
            for (int m = 0; m < 4; ++m) { const int row = row0 + 128 * ai + 16 * m; bf16* rowp = xh + (size_t)row * DM + col0; float ss = 0.f;
#pragma unroll
                for (int bj = 0; bj < 2; ++bj) { const u32x4 b = *(const u32x4*)(rowp + 128 * bj); const f32x4 a0 = acc[ai][bj][m][0] * scale, a1 = acc[ai][bj][m][1] * scale;
                    u32x4 w; w.x = pk2(bflo(b.x) + a0[0], bfhi(b.x) + a0[1]); w.y = pk2(bflo(b.y) + a0[2], bfhi(b.y) + a0[3]); w.z = pk2(bflo(b.z) + a1[0], bfhi(b.z) + a1[1]); w.w = pk2(bflo(b.w) + a1[2], bfhi(b.w) + a1[3]);
                    *(u32x4*)(rowp + 128 * bj) = w;
                    const float o0 = bflo(w.x), o1 = bfhi(w.x), o2 = bflo(w.y), o3 = bfhi(w.y), o4 = bflo(w.z), o5 = bfhi(w.z), o6 = bflo(w.w), o7 = bfhi(w.w);
                    ss += ((o0 * o0 + o1 * o1) + (o2 * o2 + o3 * o3)) + ((o4 * o4 + o5 * o5) + (o6 * o6 + o7 * o7)); }
                ss += __shfl_xor(ss, 16); ss += __shfl_xor(ss, 32);
                if (fq == 0) { ss_add(ss_acc + row, ss); ss_zero[row] = zero64(); }
            }
    }
};
struct EpiS5Glu {
    static constexpr bool PERM = true, AFTER_DRAIN = false;
    bf16* xh; ssq_t* ss_acc; ssq_t* ss_zero;
    DEV void operator()(const AccT& acc, const pg8::Unit& u, int wr, int wc, int fr, int fq) const {
        EPI_OPAQUE(fr, fq);
        const int row0 = u.pm * 256 + wr * 64 + fr, col0 = u.pn * 128 + wc * 32 + 8 * fq;
#pragma unroll
        for (int ai = 0; ai < 2; ++ai)
#pragma unroll
            for (int m = 0; m < 4; ++m) { const int row = row0 + 128 * ai + 16 * m; bf16* rowp = xh + (size_t)row * DM + col0;
                const u32x4 b = *(const u32x4*)rowp; const float bb[8] = {bflo(b.x), bfhi(b.x), bflo(b.y), bfhi(b.y), bflo(b.z), bfhi(b.z), bflo(b.w), bfhi(b.w)}; float o[8];
#pragma unroll
                for (int n = 0; n < 2; ++n)
#pragma unroll
                    for (int e = 0; e < 4; ++e) o[4 * n + e] = bb[4 * n + e] + acc[ai][0][m][n][e] * sigmoidf_(acc[ai][1][m][n][e]);
                u32x4 w; w.x = pk2(o[0], o[1]); w.y = pk2(o[2], o[3]); w.z = pk2(o[4], o[5]); w.w = pk2(o[6], o[7]);
                *(u32x4*)rowp = w;
                const float o0 = bflo(w.x), o1 = bfhi(w.x), o2 = bflo(w.y), o3 = bfhi(w.y), o4 = bflo(w.z), o5 = bfhi(w.z), o6 = bflo(w.w), o7 = bfhi(w.w);
                float ss = ((o0 * o0 + o1 * o1) + (o2 * o2 + o3 * o3)) + ((o4 * o4 + o5 * o5) + (o6 * o6 + o7 * o7));
                ss += __shfl_xor(ss, 16); ss += __shfl_xor(ss, 32);
                if (fq == 0) { ss_add(ss_acc + row, ss); ss_zero[row] = zero64(); }
            }
    }
};
struct EpiSwiGLU {
    static constexpr bool PERM = true, AFTER_DRAIN = false;
    bf16* H; const ssq_t* ssq;
    DEV void operator()(const AccT& acc, const pg8::Unit& u, int wr, int wc, int fr, int fq) const {
        EPI_OPAQUE(fr, fq);
        const int row0 = u.pm * 256 + wr * 64 + fr, col0 = u.pn * 128 + wc * 32 + 8 * fq;
        float rs[2][4]; row_rstd(ssq, row0, rs);
#pragma unroll
        for (int ai = 0; ai < 2; ++ai)
#pragma unroll
            for (int m = 0; m < 4; ++m) { const float r = rs[ai][m]; float h[8];
#pragma unroll
                for (int n = 0; n < 2; ++n)
#pragma unroll
                    for (int e = 0; e < 4; ++e) { const float a = acc[ai][0][m][n][e] * r, b = acc[ai][1][m][n][e] * r; h[4 * n + e] = siluf_(a) * b; }
                u32x4 w; w.x = pk2(h[0], h[1]); w.y = pk2(h[2], h[3]); w.z = pk2(h[4], h[5]); w.w = pk2(h[6], h[7]);
                NT_STORE16((u32x4*)(H + (size_t)(row0 + 128 * ai + 16 * m) * DFF + col0), w); }
    }
};
template <int NSLOT> struct EpiBf16 {
    static constexpr bool PERM = true, AFTER_DRAIN = false;
    bf16* O; int ldc; const ssq_t* ssq;
    DEV void operator()(const AccT& acc, const pg8::Unit& u, int wr, int wc, int fr, int fq) const {
        EPI_OPAQUE(fr, fq);
        const int row0 = u.pm * 256 + wr * 64 + fr, col0 = u.pn * 256 + wc * 32 + 8 * fq;
        float rs[2][4];
        if constexpr (NSLOT > 0) row_rstd(ssq, row0, rs);
#pragma unroll
        for (int ai = 0; ai < 2; ++ai)
#pragma unroll
            for (int m = 0; m < 4; ++m) { const float r = NSLOT > 0 ? rs[ai][m] : 1.0f; bf16* rowp = O + (size_t)(row0 + 128 * ai + 16 * m) * ldc + col0;
#pragma unroll
                for (int bj = 0; bj < 2; ++bj) { const f32x4 v0 = acc[ai][bj][m][0] * r, v1 = acc[ai][bj][m][1] * r;
                    u32x4 w; w.x = pk2(v0[0], v0[1]); w.y = pk2(v0[2], v0[3]); w.z = pk2(v1[0], v1[1]); w.w = pk2(v1[2], v1[3]);
                    *(u32x4*)(rowp + 128 * bj) = w; } }
    }
};
struct EpiRetIn {
    static constexpr bool PERM = true, AFTER_DRAIN = false;
    bf16 *Q, *K; const ssq_t* ssq; const float* rot; const int* positions;
    DEV void operator()(const AccT& acc, const pg8::Unit& u, int wr, int wc, int fr, int fq) const {
        EPI_OPAQUE(fr, fq);
        const int row0 = u.pm * 256 + wr * 64 + fr, pn = u.pn;
        float rs[2][4]; row_rstd(ssq, row0, rs);
        {
            const int h = pn & 3; const bool isk = pn >= 4; bf16* dst = isk ? K : Q;
            const float lg = log2f(1.0f - exp2f(-5.0f - (float)h)); const int d0 = wc * 32 + 8 * fq;
#pragma unroll
            for (int ai = 0; ai < 2; ++ai)
#pragma unroll
                for (int m = 0; m < 4; ++m) { const int row = row0 + 128 * ai + 16 * m; const int i256 = row & (RMC - 1);
                    const float sc = rs[ai][m] * (isk ? fexp2(-lg * (float)i256) * 0.0625f : fexp2(lg * (float)i256));
                    const float* rp = rot + ((size_t)positions[row] * 128 + d0) * 2;
                    const f32x4 r0 = *(const f32x4*)rp, r1 = *(const f32x4*)(rp + 4), r2 = *(const f32x4*)(rp + 8), r3 = *(const f32x4*)(rp + 12);
                    const float cs[8] = {r0[0], r0[2], r1[0], r1[2], r2[0], r2[2], r3[0], r3[2]}, sn[8] = {r0[1], r0[3], r1[1], r1[3], r2[1], r2[3], r3[1], r3[3]};
                    float o1[8], o2[8];
#pragma unroll
                    for (int n = 0; n < 2; ++n)
#pragma unroll
                        for (int e = 0; e < 4; ++e) { const float t1 = acc[ai][0][m][n][e] * sc, t2 = acc[ai][1][m][n][e] * sc; const int j = 4 * n + e;
                            o1[j] = t1 * cs[j] - t2 * sn[j]; o2[j] = t1 * sn[j] + t2 * cs[j]; }
                    u32x4 w1, w2; w1.x = pk2(o1[0], o1[1]); w1.y = pk2(o1[2], o1[3]); w1.z = pk2(o1[4], o1[5]); w1.w = pk2(o1[6], o1[7]);
                    w2.x = pk2(o2[0], o2[1]); w2.y = pk2(o2[2], o2[3]); w2.z = pk2(o2[4], o2[5]); w2.w = pk2(o2[6], o2[7]);
                    bf16* p = dst + (size_t)row * DM + 256 * h + d0; *(u32x4*)p = w1; *(u32x4*)(p + 128) = w2; }
        }
    }
};
struct EpiRetGate {
    static constexpr bool PERM = true, AFTER_DRAIN = false;
    bf16* O; const ssq_t* ssq; const float* stat;
    DEV void operator()(const AccT& acc, const pg8::Unit& u, int wr, int wc, int fr, int fq) const {
        EPI_OPAQUE(fr, fq);
        const int row0 = u.pm * 256 + wr * 64 + fr, h = u.pn >> 1, col0 = u.pn * 256 + wc * 32 + 8 * fq;
        float rs[2][4]; row_rstd(ssq, row0, rs);
#pragma unroll
        for (int ai = 0; ai < 2; ++ai)
#pragma unroll
            for (int m = 0; m < 4; ++m) { const int row = row0 + 128 * ai + 16 * m; const float r = rs[ai][m];
                const f32x4 st = *(const f32x4*)(stat + ((size_t)row * RH + h) * 16 + 4 * fq);
                float s1 = st[0] + st[2], s2 = st[1] + st[3];
                s1 += __shfl_xor(s1, 16); s1 += __shfl_xor(s1, 32); s2 += __shfl_xor(s2, 16); s2 += __shfl_xor(s2, 32);
                const float mu = s1 * (1.0f / RDV), var = fmaxf(s2 * (1.0f / RDV) - mu * mu, 0.0f), rg = frsq(var + EPS);
                bf16* rowp = O + (size_t)row * RVW + col0;
#pragma unroll
                for (int bj = 0; bj < 2; ++bj) { const u32x4 ow = *(const u32x4*)(rowp + 128 * bj);
                    const float o[8] = {bflo(ow.x), bfhi(ow.x), bflo(ow.y), bfhi(ow.y), bflo(ow.z), bfhi(ow.z), bflo(ow.w), bfhi(ow.w)}; float y[8];
#pragma unroll
                    for (int n = 0; n < 2; ++n)
#pragma unroll
                        for (int e = 0; e < 4; ++e) { const int j = 4 * n + e; y[j] = siluf_(acc[ai][bj][m][n][e] * r) * ((o[j] - mu) * rg); }
                    u32x4 w; w.x = pk2(y[0], y[1]); w.y = pk2(y[2], y[3]); w.z = pk2(y[4], y[5]); w.w = pk2(y[6], y[7]);
                    *(u32x4*)(rowp + 128 * bj) = w; } }
    }
};

struct EpiNull {
    static constexpr bool PERM = false, AFTER_DRAIN = false;
    DEV void operator()(const AccT& acc, const pg8::Unit& u, int wr, int wc, int fr, int fq) const {
#ifndef HOST_EMU
#pragma unroll
        for (int ai = 0; ai < 2; ++ai)
#pragma unroll
            for (int bj = 0; bj < 2; ++bj)
#pragma unroll
                for (int m = 0; m < 4; ++m)
#pragma unroll
                    for (int n = 0; n < 2; ++n) asm volatile("" :: "v"(acc[ai][bj][m][n]));
#endif
    }
};

struct EpiRetP {
    static constexpr bool PERM = true, AFTER_DRAIN = false;
    bf16* P;
    DEV void operator()(const AccT& acc, const pg8::Unit& u, int wr, int wc, int fr, int fq) const {
        EPI_OPAQUE(fr, fq);
        bf16* blk = P + (size_t)u.pm * 65536;
        const int i0 = wr * 64 + fr, j0 = wc * 32 + 8 * fq;
#pragma unroll
        for (int ai = 0; ai < 2; ++ai)
#pragma unroll
            for (int m = 0; m < 4; ++m) { const int i = i0 + 128 * ai + 16 * m;
#pragma unroll
                for (int bj = 0; bj < 2; ++bj) { const int jb = j0 + 128 * bj;
                    const int g16 = jb & ~15, f = (jb >> 3) & 1;
#pragma unroll
                    for (int n = 0; n < 2; ++n) { float v[4];
#pragma unroll
                        for (int e_ = 0; e_ < 4; ++e_) v[e_] = (jb + 4 * n + e_ <= i) ? acc[ai][bj][m][n][e_] : 0.f;
                        u32x2 w; w.x = pk2(v[0], v[1]); w.y = pk2(v[2], v[3]);
                        *(u32x2*)(blk + (size_t)i * 256 + g16 + 8 * n + 4 * f) = w; } } }
    }
};

struct EpiRetVT {
    static constexpr bool PERM = true, AFTER_DRAIN = false;
    bf16* VT; const ssq_t* ssq;
    DEV void operator()(const AccT& acc, const pg8::Unit& u, int wr, int wc, int fr, int fq) const {
        EPI_OPAQUE(fr, fq);
        const int row0 = u.pm * 256 + wr * 64 + fr, t0 = u.pn * 256 + wc * 32 + 8 * fq;
        float rs[2][8];
#pragma unroll
        for (int bj = 0; bj < 2; ++bj)
#pragma unroll
            for (int j = 0; j < 8; ++j) rs[bj][j] = frsq(ss_val(ssq[t0 + 128 * bj + j]) * (1.0f / DM) + EPS);
        const int f = fq & 1;
#pragma unroll
        for (int ai = 0; ai < 2; ++ai)
#pragma unroll
            for (int m = 0; m < 4; ++m) { bf16* rowp = VT + (size_t)(row0 + 128 * ai + 16 * m) * M;
#pragma unroll
                for (int bj = 0; bj < 2; ++bj) { const int g16 = (t0 + 128 * bj) & ~15;
#pragma unroll
                    for (int n = 0; n < 2; ++n) { const f32x4 a = acc[ai][bj][m][n]; u32x2 w; w.x = pk2(a[0] * rs[bj][4 * n], a[1] * rs[bj][4 * n + 1]); w.y = pk2(a[2] * rs[bj][4 * n + 2], a[3] * rs[bj][4 * n + 3]);
                        *(u32x2*)(rowp + g16 + 8 * n + 4 * f) = w; } } }
    }
};
#ifndef HOST_EMU
namespace pg8 {
__device__ __forceinline__ int pg8_lane_id_fresh() { unsigned m = ~0u; asm volatile("" : "+s"(m)); return (int)__builtin_amdgcn_mbcnt_hi(m, __builtin_amdgcn_mbcnt_lo(m, 0u)); }
template <class Epi, class Sched, bool ALIGN_EPI = false, bool SP2 = false>
__device__ __forceinline__ void gemm_phase(PG8_LAS unsigned char* lds, const Gemm g, const Sched& S, const Epi& E, int wave_id) {
    int tid_l = wave_id * 64 + pg8_lane_id_fresh(); asm volatile("" : "+v"(tid_l));
    const int tid = tid_l, wid = __builtin_amdgcn_readfirstlane(tid >> 6), lane = tid & 63, wr = wid >> 2, wc = wid & 3, fr = lane & 15, fq = lane >> 4;
    const int K = g.K, nt = K / BK, ldk = g.ld ? g.ld : g.K;
    unsigned voffA[2], voffB[2];
#pragma unroll
    for (int i = 0; i < 2; ++i) { int R, C; stage_rc(tid * 16 + i * 8192, R, C); const int Rb = Epi::PERM ? ((R & ~31) + perm32(R & 31)) : R;
        voffA[i] = (unsigned)(R * ldk + C) * 2u; voffB[i] = (unsigned)(Rb * ldk + C) * 2u; }
    const size_t kstep = (size_t)(BK * 2);
    const size_t hstep = (size_t)HALF * ldk * 2;
    const size_t tstep = 2 * hstep;
    const unsigned ldsw = (unsigned)wid * 1024u;
    const int aoff = lds_byte(wr * 64 + fr, fq * 8), boff = lds_byte(wc * 32 + fr, fq * 8);
#define PG8_SA(b, h) (((b) * 2 + (h)) * HTB)
#define PG8_SB(b, h) ((4 + (b) * 2 + (h)) * HTB)
#define PG8_STAGE(bufoff, gbase, voff) do { _Pragma("unroll") for (int _i = 0; _i < 2; ++_i) \
        __builtin_amdgcn_global_load_lds((const unsigned*)((const char*)(gbase) + (voff)[_i]), (PG8_LAS unsigned*)(lds + (bufoff) + ldsw + _i * 8192), 16, 0, 0); } while (0)
#define PG8_LDA(dst, b, h) do { _Pragma("unroll") for (int m = 0; m < 4; ++m) _Pragma("unroll") for (int k = 0; k < 2; ++k) dst[m][k] = *(const PG8_LAS bf16x8*)(lds + PG8_SA(b, h) + aoff + m * 2048 + k * 1024); } while (0)
#define PG8_LDB(dst, b, h) do { _Pragma("unroll") for (int n = 0; n < 2; ++n) _Pragma("unroll") for (int k = 0; k < 2; ++k) dst[n][k] = *(const PG8_LAS bf16x8*)(lds + PG8_SB(b, h) + boff + n * 2048 + k * 1024); } while (0)
#define PG8_MMA(ai, bj, At, Bt) do { __builtin_amdgcn_s_setprio(1); _Pragma("unroll") for (int m = 0; m < 4; ++m) _Pragma("unroll") for (int n = 0; n < 2; ++n) _Pragma("unroll") for (int k = 0; k < 2; ++k) \
        acc[ai][bj][m][n] = __builtin_amdgcn_mfma_f32_16x16x32_bf16(Bt[n][k], At[m][k], acc[ai][bj][m][n], 0, 0, 0); __builtin_amdgcn_s_setprio(0); } while (0)
#define PG8_WAIT_V(n) asm volatile("s_waitcnt vmcnt(" #n ")" ::: "memory")
#define PG8_WAIT_L(n) asm volatile("s_waitcnt lgkmcnt(" #n ")" ::: "memory")
#define PG8_BAR __builtin_amdgcn_s_barrier()
#define PG8_SCHED __builtin_amdgcn_sched_barrier(0)
    Unit cur, nxt; int ui = 0;
    if (!S.next(0, cur)) return;
    f32x4 acc[2][2][4][2];
#pragma unroll
    for (int a = 0; a < 2; ++a)
#pragma unroll
        for (int b = 0; b < 2; ++b)
#pragma unroll
            for (int m = 0; m < 4; ++m)
#pragma unroll
                for (int n = 0; n < 2; ++n) acc[a][b][m][n] = (f32x4){0.f, 0.f, 0.f, 0.f};
    bf16x8 At[4][2], B0[2][2], B1[2][2];
    const char* cA = (const char*)g.A + (size_t)cur.pm * tstep; const char* cB = (const char*)g.Bt + (size_t)cur.pn * tstep;
    S.a_ready(cur);
    if constexpr (SP2) {
        PG8_STAGE(PG8_SB(0, 0), cB, voffB); PG8_STAGE(PG8_SB(0, 1), cB + hstep, voffB); PG8_STAGE(PG8_SA(0, 0), cA, voffA); PG8_STAGE(PG8_SA(0, 1), cA + hstep, voffA);
        if (wr == 1) PG8_BAR;
        PG8_WAIT_V(2); PG8_BAR;
        PG8_STAGE(PG8_SB(1, 0), cB + kstep, voffB); PG8_STAGE(PG8_SA(1, 0), cA + kstep, voffA); PG8_STAGE(PG8_SB(1, 1), cB + hstep + kstep, voffB);
        PG8_WAIT_V(6); PG8_BAR;
    } else {
        PG8_STAGE(PG8_SB(0, 0), cB, voffB); PG8_STAGE(PG8_SA(0, 0), cA, voffA); PG8_STAGE(PG8_SB(0, 1), cB + hstep, voffB); PG8_STAGE(PG8_SA(0, 1), cA + hstep, voffA);
        if (wr == 1) PG8_BAR;
        PG8_WAIT_V(4); PG8_BAR;
        PG8_STAGE(PG8_SB(1, 0), cB + kstep, voffB); PG8_STAGE(PG8_SA(1, 0), cA + kstep, voffA); PG8_STAGE(PG8_SB(1, 1), cB + hstep + kstep, voffB);
        PG8_WAIT_V(6); PG8_BAR;
    }
    for (;;) {
        const bool has_next = S.next(ui + 1, nxt);
        const char* nA = has_next ? (const char*)g.A + (size_t)nxt.pm * tstep : cA; const char* nB = has_next ? (const char*)g.Bt + (size_t)nxt.pn * tstep : cB;
        for (int t = 0; t < nt; t += 2) {
            const bool last = (t == nt - 2);
            const char* a1 = cA + (size_t)(t + 1) * kstep;
            const char* a2 = last ? nA : cA + (size_t)(t + 2) * kstep; const char* b2 = last ? nB : cB + (size_t)(t + 2) * kstep;
            const char* a3 = a2 + kstep; const char* b3 = b2 + kstep;
            if (last && has_next) S.a_ready(nxt);
            if constexpr (SP2) {
            PG8_LDB(B0, 0, 0); PG8_LDB(B1, 0, 1); PG8_SCHED; PG8_LDA(At, 0, 0); PG8_STAGE(PG8_SA(1, 1), a1 + hstep, voffA);
            PG8_WAIT_V(8); PG8_WAIT_L(0); PG8_BAR; PG8_MMA(0, 0, At, B0); PG8_MMA(0, 1, At, B1); PG8_BAR; PG8_SCHED;
            PG8_LDA(At, 0, 1); PG8_STAGE(PG8_SB(0, 0), b2, voffB); PG8_STAGE(PG8_SB(0, 1), b2 + hstep, voffB); PG8_STAGE(PG8_SA(0, 0), a2, voffA);
            PG8_WAIT_V(8); PG8_WAIT_L(0); PG8_BAR; PG8_MMA(1, 0, At, B0); PG8_MMA(1, 1, At, B1); PG8_BAR; PG8_SCHED;
            PG8_LDB(B0, 1, 0); PG8_LDB(B1, 1, 1); PG8_SCHED; PG8_LDA(At, 1, 0); PG8_STAGE(PG8_SA(0, 1), a2 + hstep, voffA);
            PG8_WAIT_V(8); PG8_WAIT_L(0); PG8_BAR; PG8_MMA(0, 0, At, B0); PG8_MMA(0, 1, At, B1); PG8_BAR; PG8_SCHED;
            PG8_LDA(At, 1, 1); PG8_STAGE(PG8_SB(1, 0), b3, voffB); PG8_STAGE(PG8_SB(1, 1), b3 + hstep, voffB); PG8_STAGE(PG8_SA(1, 0), a3, voffA);
            PG8_WAIT_V(8); PG8_WAIT_L(0); PG8_BAR; PG8_MMA(1, 0, At, B0); PG8_MMA(1, 1, At, B1); PG8_BAR; PG8_SCHED;
            } else {
            PG8_LDB(B0, 0, 0); PG8_SCHED; PG8_LDA(At, 0, 0); PG8_STAGE(PG8_SA(1, 1), a1 + hstep, voffA);
            PG8_WAIT_L(8); PG8_BAR; PG8_WAIT_L(0); PG8_MMA(0, 0, At, B0); PG8_BAR; PG8_SCHED;
            PG8_LDB(B1, 0, 1); PG8_STAGE(PG8_SB(0, 0), b2, voffB);
            PG8_BAR; PG8_WAIT_L(0); PG8_MMA(0, 1, At, B1); PG8_BAR;
            PG8_LDA(At, 0, 1); PG8_STAGE(PG8_SA(0, 0), a2, voffA);
            PG8_BAR; PG8_WAIT_L(0); PG8_MMA(1, 0, At, B0); PG8_BAR; PG8_SCHED;
            PG8_STAGE(PG8_SB(0, 1), b2 + hstep, voffB);
            PG8_WAIT_V(6); PG8_BAR; PG8_MMA(1, 1, At, B1); PG8_BAR;
            PG8_LDB(B0, 1, 0); PG8_SCHED; PG8_LDA(At, 1, 0); PG8_STAGE(PG8_SA(0, 1), a2 + hstep, voffA);
            PG8_WAIT_L(8); PG8_BAR; PG8_WAIT_L(0); PG8_MMA(0, 0, At, B0); PG8_BAR; PG8_SCHED;
            PG8_LDB(B1, 1, 1); PG8_STAGE(PG8_SB(1, 0), b3, voffB);
            PG8_BAR; PG8_WAIT_L(0); PG8_MMA(0, 1, At, B1); PG8_BAR;
            PG8_LDA(At, 1, 1); PG8_STAGE(PG8_SA(1, 0), a3, voffA);
            PG8_BAR; PG8_WAIT_L(0); PG8_MMA(1, 0, At, B0); PG8_BAR; PG8_SCHED;
            PG8_STAGE(PG8_SB(1, 1), b3 + hstep, voffB);
            PG8_WAIT_V(6); PG8_BAR; PG8_MMA(1, 1, At, B1); PG8_BAR;
            }
        }
        if constexpr (ALIGN_EPI) { if (wr == 0) PG8_BAR; }
        if constexpr (!Epi::AFTER_DRAIN) { E(acc, cur, wr, wc, fr, fq); S.done(cur); }
        if (!has_next) break;
#pragma unroll
        for (int a = 0; a < 2; ++a)
#pragma unroll
            for (int b = 0; b < 2; ++b)
#pragma unroll
                for (int m = 0; m < 4; ++m)
#pragma unroll
                    for (int n = 0; n < 2; ++n) acc[a][b][m][n] = (f32x4){0.f, 0.f, 0.f, 0.f};
        cur = nxt; cA = nA; cB = nB; ++ui;
        if constexpr (ALIGN_EPI) { if (wr == 1) PG8_BAR; }
    }
    PG8_WAIT_V(0);
    if constexpr (!ALIGN_EPI) { if (wr == 0) PG8_BAR; }
    PG8_BAR;
    if constexpr (Epi::AFTER_DRAIN) { E.fused(acc, cur, wr, wc, fr, fq, lds, wid, lane); S.done(cur); }
#undef PG8_SA
#undef PG8_SB
#undef PG8_STAGE
#undef PG8_LDA
#undef PG8_LDB
#undef PG8_MMA
#undef PG8_WAIT_V
#undef PG8_WAIT_L
#undef PG8_BAR
#undef PG8_SCHED
}
}
#endif
#ifndef HOST_EMU
#define WAVE_LDS_SYNC() do { asm volatile("s_waitcnt lgkmcnt(0)" ::: "memory"); } while (0)
#else
#define WAVE_LDS_SYNC() do { e_wave->bar.arrive_and_wait(); } while (0)
#endif
DEV void conv_tile(const float* W, int ldw, int k0, int n0, const float* gain, bf16* dst, int Kd, LAS float* scr, int lane) {
#pragma unroll 8
    for (int i = 0; i < 32; ++i) { const int kk = 2 * i + (lane >> 5); float v = W[(size_t)(k0 + kk) * ldw + n0 + (lane & 31)]; if (gain) v *= gain[k0 + kk]; scr[kk * 33 + (lane & 31)] = v; }
    WAVE_LDS_SYNC();
    const int c = lane & 7;
#pragma unroll
    for (int j = 0; j < 4; ++j) { const int n = (lane >> 3) + 8 * j; const LAS float* s = scr + (8 * c) * 33 + n;
        u32x4 o; o.x = pk2(s[0 * 33], s[1 * 33]); o.y = pk2(s[2 * 33], s[3 * 33]); o.z = pk2(s[4 * 33], s[5 * 33]); o.w = pk2(s[6 * 33], s[7 * 33]);
        *(u32x4*)(dst + (size_t)n * Kd + k0 + 8 * c) = o; }
    WAVE_LDS_SYNC();
}
DEV int glu_row(int n, int NH) { const int j = n < NH ? n : n - NH; return (j >> 7) * 256 + (n < NH ? 0 : 128) + (j & 127); }

struct LayerW {
    const float *g;
    const float *f1in, *f1out, *f2in, *f2out;
    const float *mixin, *mixout;
    const float *xq, *xkv, *xkv2, *xo;
    int is_ret;
};
DEV void convert_layer(const LayerW& L, unsigned char* ws, LAS float* scr, int gw, int NGW, int lane) {
    constexpr int I_FIN = (DM / 64) * (2 * DFF / 32), I_FOUT = (DFF / 64) * (DM / 32), I_GLU = (DM / 64) * (2 * DM / 32), I_RIN = (DM / 64) * (RIN / 32), I_ROUT = (RVW / 64) * (DM / 32),
                  I_SQ = (DM / 64) * (DM / 32), I_KV = (DM / 64) * (2 * DM / 32);
    const int i_mix = L.is_ret ? I_RIN + I_ROUT : I_GLU;
    const int n_kv = L.is_ret ? 0 : 2 * I_KV;
    const int total = 2 * (I_FIN + I_FOUT) + i_mix + 2 * I_SQ + n_kv;
    for (int it = gw; it < total; it += NGW) {
        int r = it;
        if (r < 2 * I_FIN) { const int f = r >= I_FIN; r -= f * I_FIN; const int nb = r % (2 * DFF / 32), kb = r / (2 * DFF / 32);
            conv_tile(f ? L.f2in : L.f1in, 2 * DFF, 64 * kb, 32 * nb, L.g + (f ? 3 : 0) * DM, (bf16*)(ws + (f ? W_F2IN : W_F1IN)) + (size_t)glu_row(32 * nb, DFF) * DM, DM, scr, lane); continue; }
        r -= 2 * I_FIN;
        if (r < 2 * I_FOUT) { const int f = r >= I_FOUT; r -= f * I_FOUT; const int nb = r % (DM / 32), kb = r / (DM / 32);
            conv_tile(f ? L.f2out : L.f1out, DM, 64 * kb, 32 * nb, nullptr, (bf16*)(ws + (f ? W_F2OUT : W_F1OUT)) + (size_t)(32 * nb) * DFF, DFF, scr, lane); continue; }
        r -= 2 * I_FOUT;
        if (r < i_mix) {
            if (!L.is_ret) { const int nb = r % (2 * DM / 32), kb = r / (2 * DM / 32);
                conv_tile(L.mixin, 2 * DM, 64 * kb, 32 * nb, nullptr, (bf16*)(ws + W_MIX) + (size_t)glu_row(32 * nb, DM) * DM, DM, scr, lane); }
            else if (r < I_RIN) { const int nb = r % (RIN / 32), kb = r / (RIN / 32);
                conv_tile(L.mixin, RIN, 64 * kb, 32 * nb, L.g + 1 * DM, (bf16*)(ws + W_MIX) + (size_t)(32 * nb) * DM, DM, scr, lane); }
            else { r -= I_RIN; const int nb = r % (DM / 32), kb = r / (DM / 32);
                conv_tile(L.mixout, DM, 64 * kb, 32 * nb, nullptr, (bf16*)(ws + W_ROUT) + (size_t)(32 * nb) * RVW, RVW, scr, lane); }
            continue; }
        r -= i_mix;
        if (r < 2 * I_SQ) { const int f = r >= I_SQ; r -= f * I_SQ; const int nb = r % (DM / 32), kb = r / (DM / 32);
            conv_tile(f ? L.xo : L.xq, DM, 64 * kb, 32 * nb, f ? nullptr : L.g + 2 * DM, (bf16*)(ws + (f ? W_XO : W_XQ)) + (size_t)(32 * nb) * DM, DM, scr, lane); continue; }
        r -= 2 * I_SQ;
        { const int set = r >= I_KV; r -= set * I_KV; const int nb = r % (2 * DM / 32), kb = r / (2 * DM / 32); const int n0 = 32 * nb;
          conv_tile(set ? L.xkv2 : L.xkv, 2 * DM, 64 * kb, n0, nullptr, (bf16*)(ws + (n0 < DM ? W_XK : W_XV) + set * W_XKV_SET) + (size_t)(n0 < DM ? n0 : n0 - DM) * DM, DM, scr, lane); }
    }
}
DEV void s5_tables(const float* lam_re, const float* lam_im, const float* log_dt, const float* b_re, const float* b_im, const float* c_re, const float* c_im, unsigned char* ws, int gt, int NGT) {
    bf16* BBAR = (bf16*)(ws + S5T_BBAR); bf16* CT = (bf16*)(ws + S5T_CT); float* A = (float*)(ws + S5T_A); float* AL = (float*)(ws + S5T_AL);
    for (int idx = gt; idx < S5G * S5P; idx += NGT) {
        const int g = idx / S5P, p = idx % S5P;
        const double dt = exp((double)log_dt[g]), lr = (double)lam_re[idx], li = (double)lam_im[idx];
        const double mag = exp(lr * dt), ang = li * dt, ar = mag * cos(ang), ai = mag * sin(ang);
        const double den = lr * lr + li * li, nr = ar - 1.0, zr = (nr * lr + ai * li) / den, zi = (ai * lr - nr * li) / den;
        for (int hi = 0; hi < S5H; ++hi) { const double br = (double)b_re[(size_t)idx * S5H + hi], bi = (double)b_im[(size_t)idx * S5H + hi];
            BBAR[((size_t)(g * 2 + 0) * S5P + p) * S5H + hi] = (bf16)f2bf((float)(zr * br - zi * bi));
            BBAR[((size_t)(g * 2 + 1) * S5P + p) * S5H + hi] = (bf16)f2bf((float)(zr * bi + zi * br)); }
        for (int ho = 0; ho < S5H; ++ho) { const size_t ci = ((size_t)g * S5H + ho) * S5P + p;
            CT[((size_t)(g * 2 + 0) * S5H + ho) * S5P + p] = (bf16)f2bf(c_re[ci]);
            CT[((size_t)(g * 2 + 1) * S5H + ho) * S5P + p] = (bf16)f2bf(-c_im[ci]); }
        A[(size_t)idx * 2] = (float)ar; A[(size_t)idx * 2 + 1] = (float)ai;
        double pr = 1.0, pi = 0.0, qr = ar, qi = ai;
        for (int e = S5_LC; e > 0; e >>= 1) { if (e & 1) { const double t = pr * qr - pi * qi; pi = pr * qi + pi * qr; pr = t; } const double t = qr * qr - qi * qi; qi = 2.0 * qr * qi; qr = t; }
        AL[(size_t)idx * 2] = (float)pr; AL[(size_t)idx * 2 + 1] = (float)pi;
    }
}
DEV void rot_table(float* rot, int gt, int NGT) {
    for (int idx = gt; idx < ROT_NPOS * 128; idx += NGT) { const int pos = idx >> 7, k = idx & 127;
        const double invf = exp(-9.210340371976184 * ((double)k / 127.0)), ang = (double)pos * invf;
        rot[(size_t)idx * 2] = (float)cos(ang); rot[(size_t)idx * 2 + 1] = (float)sin(ang); }
}
DEV void memn_rows(const float* mem, const float* gain, bf16* MEMN, bf16* MEMNP, int gw, int NGW, int lane) {
    for (int row = gw; row < MMEM; row += NGW) {
        const f32x4* xr = (const f32x4*)(mem + (size_t)row * DM) + lane; const f32x4* gr = (const f32x4*)gain + lane;
        f32x4 v[4]; float s = 0.f;
#pragma unroll
        for (int j = 0; j < 4; ++j) { v[j] = xr[64 * j]; s += (v[j][0] * v[j][0] + v[j][1] * v[j][1]) + (v[j][2] * v[j][2] + v[j][3] * v[j][3]); }
        const float r = 1.0f / sqrtf(wave_sum(s) * (1.0f / DM) + EPS);
        const int rowp = (row & ~15) | pos16(row & 15);
#pragma unroll
        for (int j = 0; j < 4; ++j) { const f32x4 g = gr[64 * j]; u32x2 w; w.x = pk2(v[j][0] * r * g[0], v[j][1] * r * g[1]); w.y = pk2(v[j][2] * r * g[2], v[j][3] * r * g[3]);
            *((u32x2*)(MEMN + (size_t)row * DM) + lane + 64 * j) = w; *((u32x2*)(MEMNP + (size_t)rowp * DM) + lane + 64 * j) = w; }
    }
}
DEV void x0_rows(const float* x, bf16* xh, ssq_t* ss0, ssq_t* ss1, int gw, int NGW, int lane) {
    for (int row = gw; row < M; row += NGW) {
        const f32x4* xr = (const f32x4*)(x + (size_t)row * DM) + lane; float s = 0.f;
#pragma unroll
        for (int j = 0; j < 4; ++j) { const f32x4 v = xr[64 * j]; u32x2 w; w.x = pk2(v[0], v[1]); w.y = pk2(v[2], v[3]); *((u32x2*)(xh + (size_t)row * DM) + lane + 64 * j) = w;
            const float q0 = bflo(w.x), q1 = bfhi(w.x), q2 = bflo(w.y), q3 = bfhi(w.y); s += (q0 * q0 + q1 * q1) + (q2 * q2 + q3 * q3); }
        s = wave_sum(s);
        if (lane == 0) { ss0[row] = ss_fix(s); ss1[row] = 0ull; }
    }
}
DEV void final_rows(const bf16* xh, const ssq_t* ssq, const float* gain, float* out, int gw, int NGW, int lane) {
    const f32x4* gr = (const f32x4*)gain + lane; f32x4 g[4];
#pragma unroll
    for (int j = 0; j < 4; ++j) g[j] = gr[64 * j];
    for (int row0 = gw * 4; row0 < M; row0 += NGW * 4) {
        u32x2 v[4][4]; float r[4];
#pragma unroll
        for (int i = 0; i < 4; ++i) { r[i] = 1.0f / sqrtf(ss_val(ssq[row0 + i]) * (1.0f / DM) + EPS); const u32x2* xr = (const u32x2*)(xh + (size_t)(row0 + i) * DM) + lane;
#pragma unroll
            for (int j = 0; j < 4; ++j) v[i][j] = xr[64 * j]; }
#pragma unroll
        for (int i = 0; i < 4; ++i) { f32x4* orow = (f32x4*)(out + (size_t)(row0 + i) * DM) + lane;
#pragma unroll
            for (int j = 0; j < 4; ++j) { f32x4 o; o[0] = bflo(v[i][j].x) * r[i] * g[j][0]; o[1] = bfhi(v[i][j].x) * r[i] * g[j][1]; o[2] = bflo(v[i][j].y) * r[i] * g[j][2]; o[3] = bfhi(v[i][j].y) * r[i] * g[j][3]; orow[64 * j] = o; } }
    }
}
template <int PASS> DEV void s5_pass(const bf16* xh, const ssq_t* ssq, const float* gain, const float* dskip, const unsigned char* ws, float* ES, bf16* YB, LAS unsigned char* lds, int vcu, int G, int tid) {
    const int wave = tid >> 6, lane = tid & 63, fr = lane & 15, fq = lane >> 4;
    const bf16* BBAR = (const bf16*)(ws + S5T_BBAR); const bf16* CT = (const bf16*)(ws + S5T_CT); const float* A = (const float*)(ws + S5T_A);
    LAS float* rtab = (LAS float*)lds;
    constexpr int NT = BATCH * 4 * 8, QLEN = SEQ / 4;
    for (int wt = vcu; wt < NT; wt += G) {
        const int gb = wt & 7, bq = wt >> 3, q4 = bq & 3, b = bq >> 2, g = 8 * gb + wave;
        const int tok0 = b * SEQ + q4 * QLEN;
        __syncthreads();
        for (int t = tid; t < QLEN; t += 512) rtab[t] = frsq(ss_val(ssq[tok0 + t]) * (1.0f / DM) + EPS);
        __syncthreads();
        s16x4 bb[4][2], cc[4][2]; float ar[4][4], ai[4][4];
#pragma unroll
        for (int ct = 0; ct < 4; ++ct) {
#pragma unroll
            for (int part = 0; part < 2; ++part) {
                bb[ct][part] = *(const s16x4*)(BBAR + ((size_t)(g * 2 + part) * S5P + 16 * ct + fr) * S5H + 4 * fq);
                cc[ct][part] = *(const s16x4*)(CT + ((size_t)(g * 2 + part) * S5H + fr) * S5P + 16 * ct + 4 * fq); }
            const f32x4 a0 = *(const f32x4*)(A + ((size_t)g * S5P + 16 * ct + 4 * fq) * 2), a1 = *(const f32x4*)(A + ((size_t)g * S5P + 16 * ct + 4 * fq) * 2 + 4);
            ar[ct][0] = a0[0]; ai[ct][0] = a0[1]; ar[ct][1] = a0[2]; ai[ct][1] = a0[3]; ar[ct][2] = a1[0]; ai[ct][2] = a1[1]; ar[ct][3] = a1[2]; ai[ct][3] = a1[3]; }
        const f32x4 gn = *(const f32x4*)(gain + 16 * g + 4 * fq), dk = *(const f32x4*)(dskip + 16 * g + 4 * fq);
        float xr[4][4], xi[4][4];
        const int bg = b * S5G + g, ch = 16 * q4 + fr;
        float* es = ES + ((size_t)bg * S5_NCH + ch) * 128 + 4 * fq;
#pragma unroll
        for (int ct = 0; ct < 4; ++ct) {
            if (PASS == 3) { const f32x4 r_ = *(const f32x4*)(es + 16 * ct), i_ = *(const f32x4*)(es + 64 + 16 * ct);
#pragma unroll
                for (int i = 0; i < 4; ++i) { xr[ct][i] = r_[i]; xi[ct][i] = i_[i]; } }
            else {
#pragma unroll
                for (int i = 0; i < 4; ++i) { xr[ct][i] = 0.f; xi[ct][i] = 0.f; } } }
        const size_t rowbase = (size_t)(tok0 + S5_LC * fr) * DM + 16 * g + 4 * fq;
        u32x2 nxt = *(const u32x2*)(xh + rowbase);
#pragma unroll 1
        for (int j = 0; j < S5_LC; ++j) {
            const u32x2 cur = nxt; if (j + 1 < S5_LC) nxt = *(const u32x2*)(xh + rowbase + (size_t)(j + 1) * DM);
            const float r = rtab[S5_LC * fr + j];
            const float u0 = bflo(cur.x) * r * gn[0], u1 = bfhi(cur.x) * r * gn[1], u2 = bflo(cur.y) * r * gn[2], u3 = bfhi(cur.y) * r * gn[3];
            const s16x4 ub = pack4(u0, u1, u2, u3);
#pragma unroll
            for (int ct = 0; ct < 4; ++ct) {
                const f32x4 z = {0.f, 0.f, 0.f, 0.f};
                const f32x4 br = MFMA16K16(bb[ct][0], ub, z), bi = MFMA16K16(bb[ct][1], ub, z);
#pragma unroll
                for (int i = 0; i < 4; ++i) { const float nr = br[i] + ar[ct][i] * xr[ct][i] - ai[ct][i] * xi[ct][i], ni = bi[i] + ar[ct][i] * xi[ct][i] + ai[ct][i] * xr[ct][i]; xr[ct][i] = nr; xi[ct][i] = ni; } }
            if (PASS == 3) {
                f32x4 y = {0.f, 0.f, 0.f, 0.f};
#pragma unroll
                for (int ct = 0; ct < 4; ++ct) { y = MFMA16K16(cc[ct][0], pack4(xr[ct][0], xr[ct][1], xr[ct][2], xr[ct][3]), y); y = MFMA16K16(cc[ct][1], pack4(xi[ct][0], xi[ct][1], xi[ct][2], xi[ct][3]), y); }
                u32x2 w; w.x = pk2(gelu_tanh(y[0] + dk[0] * u0), gelu_tanh(y[1] + dk[1] * u1)); w.y = pk2(gelu_tanh(y[2] + dk[2] * u2), gelu_tanh(y[3] + dk[3] * u3));
                *(u32x2*)(YB + rowbase + (size_t)j * DM) = w; }
        }
        if (PASS == 1) {
#pragma unroll
            for (int ct = 0; ct < 4; ++ct) { const f32x4 r_ = {xr[ct][0], xr[ct][1], xr[ct][2], xr[ct][3]}, i_ = {xi[ct][0], xi[ct][1], xi[ct][2], xi[ct][3]};
                *(f32x4*)(es + 16 * ct) = r_; *(f32x4*)(es + 64 + 16 * ct) = i_; } }
    }
}
DEV void s5_carry(float* ES, const unsigned char* ws, int gt, int NGT) {
    const float* AL = (const float*)(ws + S5T_AL);
    for (int idx = gt; idx < BATCH * S5G * S5P; idx += NGT) { const int bg = idx / S5P, k = idx % S5P, g = bg % S5G;
        const float alr = AL[((size_t)g * S5P + k) * 2], ali = AL[((size_t)g * S5P + k) * 2 + 1]; float sr = 0.f, si = 0.f;
        float* p = ES + (size_t)bg * S5_NCH * 128 + k;
        for (int c = 0; c < S5_NCH; ++c) { const float er = p[(size_t)c * 128], ei = p[(size_t)c * 128 + 64]; p[(size_t)c * 128] = sr; p[(size_t)c * 128 + 64] = si;
            const float nr = alr * sr - ali * si + er, ni = alr * si + ali * sr + ei; sr = nr; si = ni; } }
}

#ifndef HOST_EMU
#define LDS_BARRIER() do { asm volatile("s_waitcnt lgkmcnt(0)" ::: "memory"); __builtin_amdgcn_s_barrier(); asm volatile("" ::: "memory"); } while (0)
#else
#define LDS_BARRIER() __syncthreads()
#endif
constexpr int KTS = 264;
#ifndef HOST_EMU
#define FRAG_PIN() __builtin_amdgcn_sched_barrier(0)
#else
#define FRAG_PIN() do {} while (0)
#endif
#define TILE_MFMA16(acc, rowp, bfrag) do { _Pragma("unroll") for (int s4_ = 0; s4_ < 4; ++s4_) { bf16x8 fr_[4]; \
    _Pragma("unroll") for (int q_ = 0; q_ < 4; ++q_) fr_[q_] = *(const LAS bf16x8*)((rowp) + 16 * (4 * s4_ + q_)); FRAG_PIN(); \
    _Pragma("unroll") for (int q_ = 0; q_ < 4; ++q_) acc = MFMA32(fr_[q_], bfrag[4 * s4_ + q_], acc); FRAG_PIN(); } } while (0)
constexpr int RET_LDS = (2 * 32 + 64) * KTS * 2;
DEV void stage_tile_ld(const bf16* src, size_t ld, int tid, u32x4 (&rg)[2]) {
#pragma unroll
    for (int i = 0; i < 2; ++i) { const int q = tid + 512 * i, row = q >> 5, chk = q & 31; rg[i] = *(const u32x4*)(src + (size_t)row * ld + 8 * chk); }
}
DEV void stage_tile_st(LAS bf16* dst, int tid, const u32x4 (&rg)[2]) {
#pragma unroll
    for (int i = 0; i < 2; ++i) { const int q = tid + 512 * i, row = q >> 5, chk = q & 31; *(LAS u32x4*)(dst + row * KTS + 8 * chk) = rg[i]; }
}
#define RET_STAGE_LD(...) do { if (!(SKIP & 16)) stage_tile_ld(__VA_ARGS__); } while (0)
template <int SKIP = 0>
DEV void ret_core(const bf16* Q, const bf16* K, const bf16* VT, bf16* O, float* STAT, LAS unsigned char* lds, int vcu, int G, int tid) {
    const int w = tid >> 6, lane = tid & 63, c = lane & 31, hh = lane >> 5;
    LAS bf16* KT0 = (LAS bf16*)lds; LAS bf16* KT1 = KT0 + 32 * KTS; LAS bf16* SB = KT1 + 32 * KTS;
    constexpr int NT = BATCH * RH * 8, NMC = SEQ / RMC;
    bf16x8 idf[2];
#pragma unroll
    for (int sg = 0; sg < 2; ++sg)
#pragma unroll
        for (int e = 0; e < 8; ++e) idf[sg][e] = (16 * sg + 8 * hh + e == c) ? (short)0x3F80 : (short)0;
    for (int tsk = vcu; tsk < NT; tsk += G) {
        const int b = tsk >> 5, h = (tsk >> 3) & 3, vs = tsk & 7;
        const float lg = log2f(1.0f - exp2f(-5.0f - (float)h)), g256 = exp2f(lg * (float)RMC);
        f32x16 sacc[2];
#pragma unroll
        for (int vt = 0; vt < 2; ++vt)
#pragma unroll
            for (int r = 0; r < 16; ++r) sacc[vt][r] = 0.f;
        LDS_BARRIER();
        for (int i = tid; i < 64 * KTS / 2; i += 512) ((LAS unsigned*)SB)[i] = 0u;
        LDS_BARRIER();
        const bf16* vtrow = VT + (size_t)(RDV * h + 64 * vs + c) * M + 8 * hh;
        bf16x8 qf[16];
        { const bf16* qrow = Q + (size_t)(b * SEQ + 32 * w + c) * DM + 256 * h + 8 * hh;
#pragma unroll
          for (int s = 0; s < 16; ++s) qf[s] = (SKIP & 32) ? idf[s & 1] : *(const bf16x8*)(qrow + 16 * s); }
        for (int mc = 0; mc < NMC; ++mc) {
            const int T0 = b * SEQ + RMC * mc;
            const bf16* ksrc = K + (size_t)T0 * DM + 256 * h;
            u32x4 rg0[2], rg1[2];
            RET_STAGE_LD(ksrc, DM, tid, rg0);
            f32x16 oacc[2];
#pragma unroll
            for (int vt = 0; vt < 2; ++vt) {
#pragma unroll
                for (int r = 0; r < 16; ++r) oacc[vt][r] = 0.f;
#pragma unroll
                for (int s = 0; s < 16; ++s) if (!(SKIP & 4)) oacc[vt] = MFMA32(*(const LAS bf16x8*)(SB + (32 * vt + c) * KTS + 16 * s + 8 * hh), qf[s], oacc[vt]);
#pragma unroll
                for (int r = 0; r < 16; ++r) { oacc[vt][r] *= g256; sacc[vt][r] *= g256; } }
            stage_tile_st(KT0, tid, rg0);
            RET_STAGE_LD(ksrc + (size_t)32 * DM, DM, tid, rg1);
            LDS_BARRIER();
#pragma unroll
            for (int jt = 0; jt < 8; ++jt) {
                LAS bf16* cur = (jt & 1) ? KT1 : KT0; LAS bf16* nx = (jt & 1) ? KT0 : KT1;
                bf16x8 vf[2][2];
#pragma unroll
                for (int vt = 0; vt < 2; ++vt)
#pragma unroll
                    for (int s2 = 0; s2 < 2; ++s2) vf[vt][s2] = (SKIP & 8) ? idf[s2] : *(const bf16x8*)(vtrow + (size_t)(32 * vt) * M + T0 + 32 * jt + 16 * s2);
                FRAG_PIN();
                if (jt < 6) { if (jt & 1) RET_STAGE_LD(ksrc + (size_t)(32 * (jt + 2)) * DM, DM, tid, rg1); else RET_STAGE_LD(ksrc + (size_t)(32 * (jt + 2)) * DM, DM, tid, rg0); }
                FRAG_PIN();
                if (!(SKIP & 1) && w >= jt) {
                    f32x16 X;
#pragma unroll
                    for (int r = 0; r < 16; ++r) X[r] = 0.f;
                    TILE_MFMA16(X, cur + c * KTS + 8 * hh, qf);
                    if (w == jt) {
#pragma unroll
                        for (int r = 0; r < 16; ++r) if (rowmap32(r, hh) > c) X[r] = 0.f; }
#pragma unroll
                    for (int s2 = 0; s2 < 2; ++s2) { const bf16x8 pf = pack8(X[8 * s2], X[8 * s2 + 1], X[8 * s2 + 2], X[8 * s2 + 3], X[8 * s2 + 4], X[8 * s2 + 5], X[8 * s2 + 6], X[8 * s2 + 7]);
#pragma unroll
                        for (int vt = 0; vt < 2; ++vt) oacc[vt] = MFMA32(vf[vt][s2], pf, oacc[vt]); }
                }
                if (jt == 7 && mc + 1 < NMC) { const bf16* qrow = Q + (size_t)(T0 + RMC + 32 * w + c) * DM + 256 * h + 8 * hh;
#pragma unroll
                    for (int s = 0; s < 16; ++s) qf[s] = (SKIP & 32) ? idf[s & 1] : *(const bf16x8*)(qrow + 16 * s); }
                if (!(SKIP & 2)) {
                    f32x16 Xk;
#pragma unroll
                    for (int r = 0; r < 16; ++r) Xk[r] = 0.f;
                    Xk = MFMA32(*(const LAS bf16x8*)(cur + c * KTS + 32 * w + 8 * hh), idf[0], Xk);
                    Xk = MFMA32(*(const LAS bf16x8*)(cur + c * KTS + 32 * w + 16 + 8 * hh), idf[1], Xk);
#pragma unroll
                    for (int s2 = 0; s2 < 2; ++s2) { const bf16x8 kf = pack8(Xk[8 * s2], Xk[8 * s2 + 1], Xk[8 * s2 + 2], Xk[8 * s2 + 3], Xk[8 * s2 + 4], Xk[8 * s2 + 5], Xk[8 * s2 + 6], Xk[8 * s2 + 7]);
#pragma unroll
                        for (int vt = 0; vt < 2; ++vt) sacc[vt] = MFMA32(kf, vf[vt][s2], sacc[vt]); }
                }
                if (jt < 7) { if (jt & 1) stage_tile_st(nx, tid, rg0); else stage_tile_st(nx, tid, rg1); }
                LDS_BARRIER();
            }
            float s1 = 0.f, s2_ = 0.f;
            bf16* orow = O + (size_t)(T0 + 32 * w + c) * RVW + RDV * h + 64 * vs + 4 * hh;
#pragma unroll
            for (int vt = 0; vt < 2; ++vt)
#pragma unroll
                for (int q = 0; q < 4; ++q) { const float a0 = oacc[vt][4 * q], a1 = oacc[vt][4 * q + 1], a2 = oacc[vt][4 * q + 2], a3 = oacc[vt][4 * q + 3];
                    s1 += (a0 + a1) + (a2 + a3); s2_ += (a0 * a0 + a1 * a1) + (a2 * a2 + a3 * a3);
                    u32x2 wv; wv.x = pk2(a0, a1); wv.y = pk2(a2, a3); *(u32x2*)(orow + 32 * vt + 8 * q) = wv; }
            s1 += __shfl_xor(s1, 32); s2_ += __shfl_xor(s2_, 32);
            if (hh == 0) { f32x2 sv; sv[0] = s1; sv[1] = s2_; *(f32x2*)(STAT + ((size_t)(T0 + 32 * w + c) * RH + h) * 16 + 2 * vs) = sv; }
#pragma unroll
            for (int vt = 0; vt < 2; ++vt)
#pragma unroll
                for (int q = 0; q < 4; ++q) { u32x2 wv; wv.x = pk2(sacc[vt][4 * q], sacc[vt][4 * q + 1]); wv.y = pk2(sacc[vt][4 * q + 2], sacc[vt][4 * q + 3]);
                    *(LAS u32x2*)(SB + (32 * vt + c) * KTS + 32 * w + 8 * q + 4 * hh) = wv; }
            LDS_BARRIER();
        }
    }
}

#undef RET_STAGE_LD
struct DiagOrder {
    int nblk, G, c;
    DEV bool next(int i, pg8::Unit& u) const { const int k = i * G + c; if (k >= nblk) return false; u.pm = k; u.pn = k; return true; }
    DEV void a_ready(const pg8::Unit&) const {}
    DEV void done(const pg8::Unit&) const {}
};

DEV void stage_pair_ld(const bf16* src, size_t ld, int tid, u32x4 (&rg)[4]) {
#pragma unroll
    for (int i = 0; i < 4; ++i) { const int q = tid + 512 * i, row = q >> 5, chk = q & 31; rg[i] = *(const u32x4*)(src + (size_t)row * ld + 8 * chk); }
}
DEV void stage_pair_st(LAS bf16* dst, int tid, const u32x4 (&rg)[4]) {
#pragma unroll
    for (int i = 0; i < 4; ++i) { const int q = tid + 512 * i, row = q >> 5, chk = q & 31; *(LAS u32x4*)(dst + row * KTS + 8 * chk) = rg[i]; }
}
DEV void xattn_core(const bf16* QX, const bf16* XK, const bf16* XVT, bf16* OX, LAS unsigned char* lds, int vcu, int G, int tid) {
    const int w = tid >> 6, lane = tid & 63, c = lane & 31, hh = lane >> 5;
    LAS bf16* T0_ = (LAS bf16*)lds; LAS bf16* T1_ = T0_ + 64 * KTS;
    constexpr int NQB = SEQ / 256, NU = BATCH * XH * NQB;
    for (int un = vcu; un < NU; un += G) {
        const int qb = un % NQB, bh = un / NQB, h = bh & 3, b = bh >> 2;
        const size_t R0 = (size_t)b * SEQ + 256 * qb + 32 * w + c;
        const bf16* ksrc = XK + (size_t)(b * NMEM) * DM + 256 * h;
        const bf16* vsrc = XVT + (size_t)(256 * h) * MMEM + b * NMEM;
#define XA_LD(p, rg) do { if ((p) < 4) stage_pair_ld(ksrc + (size_t)(64 * (p)) * DM, DM, tid, rg); else stage_pair_ld(vsrc + (size_t)(64 * ((p) - 4)) * MMEM, MMEM, tid, rg); } while (0)
        u32x4 rg0[4];
        f32x16 st[8];
        XA_LD(0, rg0);
        bf16x8 qf[16];
#pragma unroll
        for (int s = 0; s < 16; ++s) qf[s] = *(const bf16x8*)(QX + R0 * DM + 256 * h + 16 * s + 8 * hh);
        LDS_BARRIER();
        stage_pair_st(T0_, tid, rg0);
        LDS_BARRIER();
#pragma unroll
        for (int kp = 0; kp < 4; ++kp) {
            LAS bf16* cur = (kp & 1) ? T1_ : T0_; LAS bf16* nx = (kp & 1) ? T0_ : T1_;
            XA_LD(kp + 1, rg0);
#pragma unroll
            for (int t2 = 0; t2 < 2; ++t2) {
#pragma unroll
                for (int r = 0; r < 16; ++r) st[2 * kp + t2][r] = 0.f;
                TILE_MFMA16(st[2 * kp + t2], cur + (32 * t2 + c) * KTS + 8 * hh, qf); }
            stage_pair_st(nx, tid, rg0);
            LDS_BARRIER();
        }
        float mx = st[0][0];
#pragma unroll
        for (int kt = 0; kt < 8; ++kt)
#pragma unroll
            for (int r = 0; r < 16; ++r) mx = fmaxf(mx, st[kt][r]);
        mx = fmaxf(mx, __shfl_xor(mx, 32));
        const float c2 = 1.4426950408889634f * 0.0625f, mc2 = -mx * c2; float l = 0.f;
        bf16x8 pf[16];
#pragma unroll
        for (int kt = 0; kt < 8; ++kt) {
#pragma unroll
            for (int r = 0; r < 16; ++r) { const float p = fexp2(st[kt][r] * c2 + mc2); st[kt][r] = p; l += p; }
#pragma unroll
            for (int s2 = 0; s2 < 2; ++s2) pf[2 * kt + s2] = pack8(st[kt][8 * s2], st[kt][8 * s2 + 1], st[kt][8 * s2 + 2], st[kt][8 * s2 + 3], st[kt][8 * s2 + 4], st[kt][8 * s2 + 5], st[kt][8 * s2 + 6], st[kt][8 * s2 + 7]); }
        l += __shfl_xor(l, 32);
        const float il = 1.0f / l;
        bf16* orow = OX + R0 * DM + 256 * h + 4 * hh;
#pragma unroll
        for (int dp = 0; dp < 4; ++dp) {
            LAS bf16* cur = (dp & 1) ? T1_ : T0_; LAS bf16* nx = (dp & 1) ? T0_ : T1_;
            if (dp < 3) XA_LD(dp + 5, rg0);
#pragma unroll
            for (int t2 = 0; t2 < 2; ++t2) { const int dt = 2 * dp + t2;
                f32x16 ot;
#pragma unroll
                for (int r = 0; r < 16; ++r) ot[r] = 0.f;
                TILE_MFMA16(ot, cur + (32 * t2 + c) * KTS + 8 * hh, pf);
#pragma unroll
                for (int q = 0; q < 4; ++q) { u32x2 wv; wv.x = pk2(ot[4 * q] * il, ot[4 * q + 1] * il); wv.y = pk2(ot[4 * q + 2] * il, ot[4 * q + 3] * il); *(u32x2*)(orow + 32 * dt + 8 * q) = wv; } }
            if (dp < 3) stage_pair_st(nx, tid, rg0);
            LDS_BARRIER();
        }
#undef XA_LD
    }
}
#ifndef HOST_EMU
#define RLX_AGENT __ATOMIC_RELAXED, __HIP_MEMORY_SCOPE_AGENT
#define XB_TMO      128
#define XB_XCNT(j)  (256  + 64 * (j))
#define XB_XSUB(j)  (1280 + 64 * (j))
#define XB_XGEN(j)  (2304 + 64 * (j))
#define XB_TOP      3328
#define XB_TOPGEN   3392
#define XCD_BAR_WORDS 3456
#define XB_SPIN_CAP (1u << 18)

__device__ __forceinline__ unsigned xb_ld(unsigned* p)              { return __hip_atomic_load(p, __ATOMIC_RELAXED, __HIP_MEMORY_SCOPE_AGENT); }
__device__ __forceinline__ unsigned xb_add(unsigned* p, unsigned v) { return __hip_atomic_fetch_add(p, v, __ATOMIC_RELAXED, __HIP_MEMORY_SCOPE_AGENT); }
__device__ __forceinline__ unsigned xb_xcc_id() { return (unsigned)__builtin_amdgcn_s_getreg((3 << 11) | 20) & 0xFu; }
#define XB_SPIN(cond, bar) do { unsigned _sp = 0; while (cond) { __builtin_amdgcn_s_sleep(1); \
    if ((++_sp & 255u) == 0u) { if (xb_ld(&(bar)[XB_TMO])) break; if (_sp > XB_SPIN_CAP) { atomicAdd(&(bar)[XB_TMO], 1u); break; } } } } while (0)

struct XcdBarrier {
    unsigned* bar; unsigned x;
    volatile LAS unsigned* st;
};

__device__ __forceinline__ XcdBarrier xcd_barrier_post(unsigned* bar, volatile LAS unsigned* st) {
    XcdBarrier b; b.bar = bar; b.x = xb_xcc_id(); b.st = st;
    if (threadIdx.x == 0) (void)xb_add(&bar[XB_XCNT(b.x)], 1u);
    return b;
}
__device__ __forceinline__ void xcd_barrier_complete(unsigned* bar, unsigned x, unsigned& nloc, unsigned& nx) {
    const unsigned G = gridDim.x * gridDim.y * gridDim.z;
    unsigned sum, cnt, mine, sp = 0u;
    for (;;) {
        sum = 0u; cnt = 0u; mine = 0u;
#pragma unroll
        for (unsigned j = 0; j < 16; ++j) { const unsigned c = xb_ld(&bar[XB_XCNT(j)]); sum += c; cnt += (c > 0u) ? 1u : 0u; mine = (j == x) ? c : mine; }
        if (sum == G) break;
        __builtin_amdgcn_s_sleep(1);
        if ((++sp & 255u) == 0u) { if (xb_ld(&bar[XB_TMO])) break; if (sp > XB_SPIN_CAP) { atomicAdd(&bar[XB_TMO], 1u); break; } }
    }
    nloc = mine > 0u ? mine : 1u; nx = cnt > 0u ? cnt : 1u;
}

__device__ __forceinline__ void xcd_barrier(const XcdBarrier& b) {
    asm volatile("s_waitcnt vmcnt(0)" ::: "memory");
    __syncthreads();
    if (threadIdx.x == 0) {
        unsigned* bar = b.bar;
        __builtin_amdgcn_s_waitcnt(0);
        unsigned nloc = b.st[0], nx = b.st[1];
        if (nloc == 0u) { xcd_barrier_complete(bar, b.x, nloc, nx); b.st[0] = nloc; b.st[1] = nx; }
        const unsigned old = xb_add(&bar[XB_XSUB(b.x)], 1u);
        const unsigned gen = old / nloc;
        if (old + 1u == (gen + 1u) * nloc) {
            __builtin_amdgcn_fence(__ATOMIC_RELEASE, "agent");
            asm volatile("s_waitcnt vmcnt(0)" ::: "memory");
            const unsigned og = xb_add(&bar[XB_TOP], 1u);
            const unsigned tg = og / nx;
            if (og + 1u == (tg + 1u) * nx) xb_add(&bar[XB_TOPGEN], 1u);
            else XB_SPIN(xb_ld(&bar[XB_TOPGEN]) == tg, bar);
            __builtin_amdgcn_fence(__ATOMIC_ACQUIRE, "agent");
            xb_add(&bar[XB_XGEN(b.x)], 1u);
            asm volatile("s_waitcnt vmcnt(0)" ::: "memory");
        } else {
            XB_SPIN(xb_ld(&bar[XB_XGEN(b.x)]) == gen, bar);
            __builtin_amdgcn_fence(__ATOMIC_ACQUIRE, "agent");
            asm volatile("s_waitcnt vmcnt(0)" ::: "memory");
        }
    }
    __syncthreads();
}
#endif
#ifndef HOST_EMU
constexpr int NWAVES = 8;
constexpr int RING_BYTES = 131072, LDSCTL_OFF = RING_BYTES, MISC_OFF = LDSCTL_OFF + 320, LDS_BYTES = 147456;
constexpr int PTAB_OFF = LDSCTL_OFF + 1024;
constexpr int CW_BAR = 4096;
#ifndef MK_PER_PHASE
#define MK_PER_PHASE 0
#endif
constexpr int PH_PER_LAYER = 12, PH_FINAL = 1 + PH_PER_LAYER * DEPTH, N_PHASES = PH_FINAL + 1;
static_assert(RET_LDS <= RING_BYTES, "lds");

DEV volatile LAS unsigned long long* ptab_base(LAS unsigned char* lds) { unsigned o = PTAB_OFF; asm volatile("" : "+v"(o)); return (volatile LAS unsigned long long*)(lds + o); }
DEV unsigned long long ldptr(volatile LAS unsigned long long* pt, int k) { const unsigned long long v = pt[k];
    const unsigned lo = __builtin_amdgcn_readfirstlane((unsigned)v), hi = __builtin_amdgcn_readfirstlane((unsigned)(v >> 32)); return ((unsigned long long)hi << 32) | lo; }
#ifndef KB_REP
#define KB_REP 0
#endif
#define REPS(k) (1 + ((KB_REP >> (k)) & 1))
#ifndef KB_FFN_SPLIT
#define KB_FFN_SPLIT 1
#endif
#ifndef KB_STAGGER
#define KB_STAGGER 0
#endif
#ifndef KB_RSTAG
#define KB_RSTAG 0
#endif
#define RSTAG() do { if (KB_RSTAG) { if ((LG(bx) >> 3) & 1) { for (int i_ = 0; i_ < KB_RSTAG; ++i_) __builtin_amdgcn_s_sleep(127); } } } while (0)
#ifndef KB_PHMASK1
#define KB_PHMASK1 0xFFF
#endif
#ifndef KB_FINAL_SS
#define KB_FINAL_SS 0
#endif
#ifndef KB_LAYERS
#define KB_LAYERS 4
#endif
#ifndef KB_PHMASK
#define KB_PHMASK 0xFFF
#endif
DEV bool ph_enabled(int k) { if (k == 0 || k >= 1 + PH_PER_LAYER * DEPTH) return true; const int L = (k - 1) / PH_PER_LAYER, s = (k - 1) % PH_PER_LAYER; return L < KB_LAYERS && ((((L & 1) ? KB_PHMASK1 : KB_PHMASK) >> s) & 1); }
DEV int lane_id_fresh() { unsigned m = ~0u; asm volatile("" : "+s"(m)); return (int)__builtin_amdgcn_mbcnt_hi(m, __builtin_amdgcn_mbcnt_lo(m, 0u)); }
DEV XcdBarrier mk_bar(unsigned* p, volatile LAS unsigned* st) { XcdBarrier b; b.bar = p; b.x = xb_xcc_id(); b.st = st; return b; }
struct Args { const void* in[24]; float* out; unsigned char* ws; int ph_lo, ph_hi, li, pad; };

__global__ void __launch_bounds__(NWAVES * 64, 2) hybrid_fwd(Args args) {
    extern __shared__ __attribute__((aligned(16))) unsigned char lds_raw[];
    LAS unsigned char* lds = (LAS unsigned char*)lds_raw;
    volatile LAS unsigned* MISC = (volatile LAS unsigned*)(lds + MISC_OFF);
    const int tid0 = threadIdx.x; const int wave0 = __builtin_amdgcn_readfirstlane(tid0 >> 6);
    const int G = gridDim.x, bx = blockIdx.x, vcu = (G % 8 == 0) ? (bx % 8) * (G / 8) + bx / 8 : bx;
    const int NGW = G * NWAVES, NGT = G * NWAVES * 64;
#define LG(v) ({ int v_ = (v); asm volatile("" : "+s"(v_)); v_; })
#define PH_IDS int tid = LG(wave0) * 64 + lane_id_fresh(); asm volatile("" : "+v"(tid)); const int lane = tid & 63, wave = __builtin_amdgcn_readfirstlane(tid >> 6), gw = LG(vcu) * NWAVES + wave, gt = LG(vcu) * (NWAVES * 64) + tid; (void)lane; (void)gw; (void)gt;
    for (int u = tid0; u < (LDS_BYTES - LDSCTL_OFF) / 4; u += NWAVES * 64) ((LAS unsigned*)(lds + LDSCTL_OFF))[u] = 0u;
    __syncthreads();
    volatile LAS unsigned long long* PT = (volatile LAS unsigned long long*)(lds + PTAB_OFF);
    if (tid0 < 24) PT[tid0] = (unsigned long long)args.in[tid0];
    if (tid0 == 24) PT[24] = (unsigned long long)args.out;
    if (tid0 == 25) PT[25] = (unsigned long long)args.ws;
    __syncthreads();
#define PTR(k) ((const void*)(GAS const void*)ldptr(ptab_base(lds), (k)))
    (void)xcd_barrier_post((unsigned*)(args.ws + WS_CTL) + CW_BAR + args.li * XCD_BAR_WORDS, MISC + 8);
    const int li_ = args.li;
#define bar mk_bar((unsigned*)((unsigned char*)PTR(25) + WS_CTL) + CW_BAR + LG(li_) * XCD_BAR_WORDS, (volatile LAS unsigned*)(lds + MISC_OFF) + 8)
    const int lo = args.ph_lo, hi = args.ph_hi;
#if MK_PER_PHASE || defined(KB_DEBUG)
#define RUN(k) (lo <= (k) && (k) < hi && ph_enabled(k))
#define SEAM(k) do { if (RUN(k) && RUN((k) + 1)) xcd_barrier(bar); } while (0)
#else
#define RUN(k) true
#define SEAM(k) xcd_barrier(bar)
#endif
#define WSP ((unsigned char*)PTR(25))
#define OUTP ((float*)PTR(24))
#define INF(k) ((const float*)PTR(k))
    LAS unsigned char* ring = lds;

    for (int rep_ = 0; rep_ < REPS(11); ++rep_) { if (rep_) xcd_barrier(bar);
    if (RUN(0)) { PH_IDS unsigned char* ws = WSP; ssq_t* SS0 = (ssq_t*)(ws + WS_SSQ);
        rot_table((float*)(ws + WS_ROT), gt, NGT);
        for (int j = 0; j < DEPTH / 2; ++j) s5_tables(INF(10) + (size_t)j * S5G * S5P, INF(11) + (size_t)j * S5G * S5P, INF(12) + (size_t)j * S5G, INF(13) + (size_t)j * S5G * S5P * S5H, INF(14) + (size_t)j * S5G * S5P * S5H,
                                                      INF(15) + (size_t)j * S5G * S5H * S5P, INF(16) + (size_t)j * S5G * S5H * S5P, ws + (size_t)j * S5T_STRIDE, gt, NGT); memn_rows(INF(1), INF(4), (bf16*)(ws + WS_MEMN), (bf16*)(ws + WS_MEMNP), gw, NGW, lane); x0_rows(INF(0), (bf16*)(ws + WS_XHAT), SS0, SS0 + M, gw, NGW, lane); }
    }
    for (int L = 0; L < DEPTH; ++L) {
        const int pb = 1 + PH_PER_LAYER * L; const bool isret = (L & 1) != 0; const int j = L >> 1;
for (int rep_ = 0; rep_ < REPS(0); ++rep_) { if (rep_) xcd_barrier(bar);
        if (RUN(pb + 0)) { PH_IDS unsigned char* ws = WSP;
            LayerW lw;
            lw.g = INF(3) + (size_t)L * 4 * DM;
            lw.f1in = INF(6) + (size_t)L * DM * 2 * DFF; lw.f1out = INF(7) + (size_t)L * DFF * DM;
            lw.f2in = INF(8) + (size_t)L * DM * 2 * DFF; lw.f2out = INF(9) + (size_t)L * DFF * DM;
            lw.mixin = isret ? INF(19) + (size_t)j * DM * RIN : INF(18) + (size_t)j * DM * 2 * DM;
            lw.mixout = isret ? INF(20) + (size_t)j * RVW * DM : nullptr;
            lw.xq = INF(21) + (size_t)L * DM * DM; lw.xkv = INF(22) + (size_t)L * DM * 2 * DM; lw.xkv2 = INF(22) + (size_t)(L + 1 < DEPTH ? L + 1 : L) * DM * 2 * DM; lw.xo = INF(23) + (size_t)L * DM * DM;
            lw.is_ret = isret ? 1 : 0;
            convert_layer(lw, ws, (LAS float*)(ring + wave * 16384), gw, NGW, lane);
        }
}
        SEAM(pb + 0);
for (int rep_ = 0; rep_ < REPS(1); ++rep_) { if (rep_) xcd_barrier(bar);
        if (RUN(pb + 1)) { unsigned char* ws = WSP; ssq_t* SS0 = (ssq_t*)(ws + WS_SSQ);
            for (int hb = 0; hb < KB_FFN_SPLIT; ++hb) { const size_t r0 = (size_t)hb * (M / KB_FFN_SPLIT);
                { pg8::Gemm g{(const bf16*)(ws + WS_XHAT) + r0 * DM, (const bf16*)(ws + W_F1IN), M / KB_FFN_SPLIT, 2 * DFF, DM}; pg8::StaticOrder S; S.init(M / KB_FFN_SPLIT, 2 * DFF, LG(G), LG(bx)); EpiSwiGLU E{(bf16*)(ws + BIG_H) + r0 * DFF, SS0 + r0};
                  pg8::gemm_phase<EpiSwiGLU, pg8::StaticOrder, true, true>(ring, g, S, E, LG(wave0)); }
                if (hb + 1 < KB_FFN_SPLIT) { xcd_barrier(bar);
                    RSTAG(); pg8::Gemm g{(const bf16*)(ws + BIG_H) + r0 * DFF, (const bf16*)(ws + W_F1OUT), M / KB_FFN_SPLIT, DM, DFF}; pg8::StaticOrder S; S.init(M / KB_FFN_SPLIT, DM, LG(G), LG(bx)); EpiResid E{(bf16*)(ws + WS_XHAT) + r0 * DM, (SS0 + M) + r0, SS0 + r0, 0.5f};
                    pg8::gemm_phase<EpiResid, pg8::StaticOrder, true, true>(ring, g, S, E, LG(wave0)); xcd_barrier(bar); } }
        }
}
        SEAM(pb + 1);
        if (RUN(pb + 2)) { unsigned char* ws = WSP; ssq_t* SS0 = (ssq_t*)(ws + WS_SSQ); const size_t r0 = (size_t)(KB_FFN_SPLIT - 1) * (M / KB_FFN_SPLIT);
            RSTAG(); pg8::Gemm g{(const bf16*)(ws + BIG_H) + r0 * DFF, (const bf16*)(ws + W_F1OUT), M / KB_FFN_SPLIT, DM, DFF}; pg8::StaticOrder S; S.init(M / KB_FFN_SPLIT, DM, LG(G), LG(bx)); EpiResid E{(bf16*)(ws + WS_XHAT) + r0 * DM, (SS0 + M) + r0, SS0 + r0, 0.5f};
            pg8::gemm_phase<EpiResid, pg8::StaticOrder, true, true>(ring, g, S, E, LG(wave0)); }
        SEAM(pb + 2);
        if ((KB_REP >> 8) & 1) { unsigned char* ws = WSP; pg8::Gemm g{(const bf16*)(ws + WS_XHAT), (const bf16*)(ws + W_F1IN), M, 2 * DFF, DM}; pg8::StaticOrder S; S.init(M, 2 * DFF, LG(G), LG(bx)); EpiNull E{};
            pg8::gemm_phase<EpiNull, pg8::StaticOrder, true, true>(ring, g, S, E, LG(wave0)); xcd_barrier(bar); }
        if ((KB_REP >> 9) & 1) { unsigned char* ws = WSP; pg8::Gemm g{(const bf16*)(ws + BIG_H), (const bf16*)(ws + W_F1OUT), M, DM, DFF}; pg8::StaticOrder S; S.init(M, DM, LG(G), LG(bx)); EpiNull E{};
            pg8::gemm_phase<EpiNull, pg8::StaticOrder, true, true>(ring, g, S, E, LG(wave0)); xcd_barrier(bar); }
        if ((KB_REP >> 10) & 1) { unsigned char* ws = WSP; pg8::Gemm g{(const bf16*)(ws + BIG_H), (const bf16*)(ws + W_F1OUT), M, DM, DFF}; pg8::StaticOrder S; S.init(M, DM, LG(G), LG(bx));
            EpiResid E{(bf16*)(ws + WS_BIG + 384 * MiB), (ssq_t*)(ws + WS_BIG + 770 * MiB), (ssq_t*)(ws + WS_BIG + 771 * MiB), 0.5f};
            pg8::gemm_phase<EpiResid, pg8::StaticOrder, true, true>(ring, g, S, E, LG(wave0)); xcd_barrier(bar); }
        if (!isret) {
for (int rep_ = 0; rep_ < REPS(2); ++rep_) { if (rep_) xcd_barrier(bar);
            if (RUN(pb + 3)) { PH_IDS unsigned char* ws = WSP; s5_pass<1>((const bf16*)(ws + WS_XHAT), (const ssq_t*)(ws + WS_SSQ) + M, INF(3) + ((size_t)L * 4 + 1) * DM, INF(17) + (size_t)j * DM, ws + (size_t)j * S5T_STRIDE, (float*)(ws + BIG_ES), (bf16*)(ws + BIG_YB), ring, LG(vcu), LG(G), tid); }
            SEAM(pb + 3);
            if (RUN(pb + 4)) { PH_IDS unsigned char* ws = WSP; s5_carry((float*)(ws + BIG_ES), ws + (size_t)j * S5T_STRIDE, gt, NGT);
                for (int set = 0; set < 2; ++set) {
                    { pg8::Gemm g{(const bf16*)(ws + WS_MEMN), (const bf16*)(ws + W_XK + set * W_XKV_SET), MMEM, DM, DM}; pg8::StaticOrder S; S.init(MMEM, DM, LG(G), (LG(bx) + (2 * set) * (LG(G) / 4)) % LG(G)); EpiBf16<0> E{(bf16*)(ws + WS_XK + set * XKV_SET), DM, nullptr};
                      pg8::gemm_phase<EpiBf16<0>, pg8::StaticOrder, true, true>(ring, g, S, E, LG(wave0)); }
                    { pg8::Gemm g{(const bf16*)(ws + W_XV + set * W_XKV_SET), (const bf16*)(ws + WS_MEMNP), DM, MMEM, DM}; pg8::StaticOrder S; S.init(DM, MMEM, LG(G), (LG(bx) + (2 * set + 1) * (LG(G) / 4)) % LG(G)); EpiBf16<0> E{(bf16*)(ws + WS_XVT + set * XKV_SET), MMEM, nullptr};
                      pg8::gemm_phase<EpiBf16<0>, pg8::StaticOrder, true, true>(ring, g, S, E, LG(wave0)); } } }
            SEAM(pb + 4);
            if (RUN(pb + 5)) { PH_IDS unsigned char* ws = WSP; s5_pass<3>((const bf16*)(ws + WS_XHAT), (const ssq_t*)(ws + WS_SSQ) + M, INF(3) + ((size_t)L * 4 + 1) * DM, INF(17) + (size_t)j * DM, ws + (size_t)j * S5T_STRIDE, (float*)(ws + BIG_ES), (bf16*)(ws + BIG_YB), ring, LG(vcu), LG(G), tid); }
}
            SEAM(pb + 5);
            if (RUN(pb + 6)) { unsigned char* ws = WSP; ssq_t* SS0 = (ssq_t*)(ws + WS_SSQ);
                RSTAG(); pg8::Gemm g{(const bf16*)(ws + BIG_YB), (const bf16*)(ws + W_MIX), M, 2 * DM, DM}; pg8::StaticOrder S; S.init(M, 2 * DM, LG(G), LG(bx)); EpiS5Glu E{(bf16*)(ws + WS_XHAT), SS0, SS0 + M};
                pg8::gemm_phase<EpiS5Glu, pg8::StaticOrder, true, true>(ring, g, S, E, LG(wave0)); }
            SEAM(pb + 6);
        } else {
for (int rep_ = 0; rep_ < REPS(3); ++rep_) { if (rep_) xcd_barrier(bar);
            if (RUN(pb + 3)) { unsigned char* ws = WSP;
                { pg8::Gemm g{(const bf16*)(ws + WS_XHAT), (const bf16*)(ws + W_MIX), M, 2 * DM, DM}; pg8::StaticOrder S; S.init(M, 2 * DM, LG(G), LG(bx));
                  EpiRetIn E{(bf16*)(ws + BIG_RQ), (bf16*)(ws + BIG_RK), (const ssq_t*)(ws + WS_SSQ) + M, (const float*)(ws + WS_ROT), (const int*)PTR(2)};
                  pg8::gemm_phase<EpiRetIn, pg8::StaticOrder, true, true>(ring, g, S, E, LG(wave0)); }
                { pg8::Gemm g{(const bf16*)(ws + W_MIX) + (size_t)(2 * DM) * DM, (const bf16*)(ws + WS_XHAT), RVW, M, DM}; pg8::StaticOrder S; S.init(RVW, M, LG(G), LG(bx));
                  EpiRetVT E{(bf16*)(ws + BIG_RVT), (const ssq_t*)(ws + WS_SSQ) + M};
                  pg8::gemm_phase<EpiRetVT, pg8::StaticOrder, true, true>(ring, g, S, E, LG(wave0)); } }
}
            SEAM(pb + 3);
            for (int rep_ = 0; rep_ < REPS(4); ++rep_) { if (rep_) xcd_barrier(bar);
#if defined(KB_RET_STUB)
            if (RUN(pb + 4)) { PH_IDS unsigned char* ws = WSP; bf16* ro = (bf16*)(ws + BIG_RO); const bf16* rq = (const bf16*)(ws + (KB_RET_STUB == 1 ? BIG_RQ : BIG_RK)); float* rst = (float*)(ws + BIG_RST);
                for (size_t i = gt; i < (size_t)M * RVW / 8; i += NGT) { const size_t row = i / (RVW / 8), c8 = i % (RVW / 8); u32x4 v;
                    if (KB_RET_STUB == 3) v = *(const u32x4*)((const bf16*)(ws + BIG_RVT) + (c8 * 8) * (size_t)M / 8 * 8 + row / 8 * 8 + 0) ; else v = *(const u32x4*)(rq + row * DM + (c8 & 127) * 8);
                    *(u32x4*)(ro + i * 8) = v; }
                for (size_t i = gt; i < (size_t)M * RH * 8; i += NGT) { rst[2 * i] = 0.f; rst[2 * i + 1] = 64.f; } }
#else
            if (RUN(pb + 4)) { PH_IDS unsigned char* ws = WSP;

                ret_core((const bf16*)(ws + BIG_RQ), (const bf16*)(ws + BIG_RK), (const bf16*)(ws + BIG_RVT), (bf16*)(ws + BIG_RO), (float*)(ws + BIG_RST), ring, LG(vcu), LG(G), tid); }
#endif
}
#ifdef KB_PROBE_SKIP
            { xcd_barrier(bar); PH_IDS unsigned char* ws = WSP; ret_core<KB_PROBE_SKIP>((const bf16*)(ws + BIG_RQ), (const bf16*)(ws + BIG_RK), (const bf16*)(ws + BIG_RVT), (bf16*)OUTP, (float*)((char*)OUTP + 0), ring, LG(vcu), LG(G), tid); }
#endif
            SEAM(pb + 4);
            if (RUN(pb + 5)) { unsigned char* ws = WSP;
                pg8::Gemm g{(const bf16*)(ws + WS_XHAT), (const bf16*)(ws + W_MIX) + (size_t)(2 * DM + RVW) * DM, M, RVW, DM}; pg8::StaticOrder S; S.init(M, RVW, LG(G), LG(bx));
                EpiRetGate E{(bf16*)(ws + BIG_RO), (const ssq_t*)(ws + WS_SSQ) + M, (const float*)(ws + BIG_RST)};
                pg8::gemm_phase<EpiRetGate, pg8::StaticOrder, true, true>(ring, g, S, E, LG(wave0)); }
            SEAM(pb + 5);
            if (RUN(pb + 6)) { unsigned char* ws = WSP; ssq_t* SS0 = (ssq_t*)(ws + WS_SSQ);
                RSTAG(); pg8::Gemm g{(const bf16*)(ws + BIG_RO), (const bf16*)(ws + W_ROUT), M, DM, RVW}; pg8::StaticOrder S; S.init(M, DM, LG(G), LG(bx)); EpiResid E{(bf16*)(ws + WS_XHAT), SS0, SS0 + M, 1.0f};
                pg8::gemm_phase<EpiResid, pg8::StaticOrder, true, true>(ring, g, S, E, LG(wave0)); }
            SEAM(pb + 6);
        }
for (int rep_ = 0; rep_ < REPS(5); ++rep_) { if (rep_) xcd_barrier(bar);
        if (RUN(pb + 7)) { unsigned char* ws = WSP;
            pg8::Gemm g{(const bf16*)(ws + WS_XHAT), (const bf16*)(ws + W_XQ), M, DM, DM}; pg8::StaticOrder S; S.init(M, DM, LG(G), LG(bx));
            EpiBf16<1> E{(bf16*)(ws + BIG_XQ), DM, (const ssq_t*)(ws + WS_SSQ)}; pg8::gemm_phase<EpiBf16<1>, pg8::StaticOrder, true, true>(ring, g, S, E, LG(wave0)); }
}
        SEAM(pb + 7);
for (int rep_ = 0; rep_ < REPS(6); ++rep_) { if (rep_) xcd_barrier(bar);
        if (RUN(pb + 8)) { PH_IDS unsigned char* ws = WSP; xattn_core((const bf16*)(ws + BIG_XQ), (const bf16*)(ws + WS_XK + (L & 1) * XKV_SET), (const bf16*)(ws + WS_XVT + (L & 1) * XKV_SET), (bf16*)(ws + BIG_XO), ring, LG(vcu), LG(G), tid); }
}
        SEAM(pb + 8);
        if (RUN(pb + 9)) { unsigned char* ws = WSP; ssq_t* SS0 = (ssq_t*)(ws + WS_SSQ);
            RSTAG(); pg8::Gemm g{(const bf16*)(ws + BIG_XO), (const bf16*)(ws + W_XO), M, DM, DM}; pg8::StaticOrder S; S.init(M, DM, LG(G), LG(bx)); EpiResid E{(bf16*)(ws + WS_XHAT), SS0 + M, SS0, 1.0f};
            pg8::gemm_phase<EpiResid, pg8::StaticOrder, true, true>(ring, g, S, E, LG(wave0)); }
        SEAM(pb + 9);
for (int rep_ = 0; rep_ < REPS(7); ++rep_) { if (rep_) xcd_barrier(bar);
        if (RUN(pb + 10)) { unsigned char* ws = WSP; ssq_t* SS0 = (ssq_t*)(ws + WS_SSQ);
            for (int hb = 0; hb < KB_FFN_SPLIT; ++hb) { const size_t r0 = (size_t)hb * (M / KB_FFN_SPLIT);
                { pg8::Gemm g{(const bf16*)(ws + WS_XHAT) + r0 * DM, (const bf16*)(ws + W_F2IN), M / KB_FFN_SPLIT, 2 * DFF, DM}; pg8::StaticOrder S; S.init(M / KB_FFN_SPLIT, 2 * DFF, LG(G), LG(bx)); EpiSwiGLU E{(bf16*)(ws + BIG_H) + r0 * DFF, (SS0 + M) + r0};
                  pg8::gemm_phase<EpiSwiGLU, pg8::StaticOrder, true, true>(ring, g, S, E, LG(wave0)); }
                if (hb + 1 < KB_FFN_SPLIT) { xcd_barrier(bar);
                    RSTAG(); pg8::Gemm g{(const bf16*)(ws + BIG_H) + r0 * DFF, (const bf16*)(ws + W_F2OUT), M / KB_FFN_SPLIT, DM, DFF}; pg8::StaticOrder S; S.init(M / KB_FFN_SPLIT, DM, LG(G), LG(bx)); EpiResid E{(bf16*)(ws + WS_XHAT) + r0 * DM, SS0 + r0, (SS0 + M) + r0, 0.5f};
                    pg8::gemm_phase<EpiResid, pg8::StaticOrder, true, true>(ring, g, S, E, LG(wave0)); xcd_barrier(bar); } }
        }
}
        SEAM(pb + 10);
        if (RUN(pb + 11)) { unsigned char* ws = WSP; ssq_t* SS0 = (ssq_t*)(ws + WS_SSQ); const size_t r0 = (size_t)(KB_FFN_SPLIT - 1) * (M / KB_FFN_SPLIT);
            RSTAG(); pg8::Gemm g{(const bf16*)(ws + BIG_H) + r0 * DFF, (const bf16*)(ws + W_F2OUT), M / KB_FFN_SPLIT, DM, DFF}; pg8::StaticOrder S; S.init(M / KB_FFN_SPLIT, DM, LG(G), LG(bx)); EpiResid E{(bf16*)(ws + WS_XHAT) + r0 * DM, SS0 + r0, (SS0 + M) + r0, 0.5f};
            pg8::gemm_phase<EpiResid, pg8::StaticOrder, true, true>(ring, g, S, E, LG(wave0)); }
        SEAM(pb + 11);
    }
    for (int rep_ = 0; rep_ < REPS(12); ++rep_) { if (rep_) xcd_barrier(bar);
    if (RUN(PH_FINAL)) { PH_IDS unsigned char* ws = WSP; float* out = OUTP; final_rows((const bf16*)(ws + WS_XHAT), (const ssq_t*)(ws + WS_SSQ) + KB_FINAL_SS * M, INF(5), out, gw, NGW, lane); }
    }
#undef RUN
#undef SEAM
#undef bar
}

extern "C" void kernel_launch(void* const* d_in, const int* in_sizes, int n_in, void* d_out, int out_size, void* d_ws, size_t ws_size, hipStream_t stream) {
    static int grid = 0;
    if (grid == 0) {
        if (n_in != 24 || in_sizes[0] != M * DM || out_size != M * DM || ws_size < WS_END) { fprintf(stderr, "kernel_launch: unexpected shapes / workspace (n_in %d, ws %zu, need %zu)\n", n_in, ws_size, (size_t)WS_END); grid = -1; return; }
        int dev = 0, cus = 0, per_cu = 0;
        if (hipGetDevice(&dev) != hipSuccess || hipDeviceGetAttribute(&cus, hipDeviceAttributeMultiprocessorCount, dev) != hipSuccess) { grid = -1; return; }
        if (hipFuncSetAttribute((const void*)hybrid_fwd, hipFuncAttributeMaxDynamicSharedMemorySize, LDS_BYTES) != hipSuccess) { fprintf(stderr, "kernel_launch: hipFuncSetAttribute failed\n"); grid = -1; return; }
        if (hipOccupancyMaxActiveBlocksPerMultiprocessor(&per_cu, (const void*)hybrid_fwd, NWAVES * 64, LDS_BYTES) != hipSuccess || per_cu < 1) { fprintf(stderr, "kernel_launch: occupancy query says %d blocks per CU\n", per_cu); }
        (void)hipGetLastError();
        grid = cus;
    }
    if (grid < 0) return;
    if (hipMemsetAsync((char*)d_ws + WS_CTL, 0, CTL_ZERO_BYTES, stream) != hipSuccess) return;
    Args a{};
    for (int i = 0; i < 24; ++i) a.in[i] = d_in[i];
    a.out = (float*)d_out; a.ws = (unsigned char*)d_ws; a.pad = 0;
#if MK_PER_PHASE
    for (int p = 0; p < N_PHASES; ++p) { a.ph_lo = p; a.ph_hi = p + 1; a.li = 0; hipLaunchKernelGGL(hybrid_fwd, dim3(grid), dim3(NWAVES * 64), LDS_BYTES, stream, a); }
#else
    a.ph_lo = 0; a.ph_hi = N_PHASES; a.li = 0;
    hipLaunchKernelGGL(hybrid_fwd, dim3(grid), dim3(NWAVES * 64), LDS_BYTES, stream, a);
#endif
}
#endif
```

```cpp
#ifndef HOST_EMU
#include <hip/hip_runtime.h>
#include <cstdio>
#include <cstdint>
#define LAS __attribute__((address_space(3)))
#define GAS __attribute__((address_space(1)))
#define DEV __device__ __forceinline__
#else
#include "emu.h"
#define LAS
#define GAS
#define DEV inline
#endif

#ifndef KB_BATCH
#define KB_BATCH 8
#endif
#ifndef KB_SEQ
#define KB_SEQ 8192
#endif
constexpr int BATCH = KB_BATCH, SEQ = KB_SEQ, DM = 1024, DEPTH = 4, NMEM = 256, DFF = 2816;
constexpr int M = BATCH * SEQ;
constexpr int MMEM = BATCH * NMEM;
constexpr int S5G = 64, S5P = 64, S5H = 16;
constexpr int S5_NCH = 64;
constexpr int S5_LC = SEQ / S5_NCH;
constexpr int RH = 4, RDK = 256, RDV = 512, RVW = RH * RDV, RIN = 2 * DM + 2 * RVW;
constexpr int RMC = 256;
constexpr int XH = 4, XD = 256;
constexpr int ROT_NPOS = 12288;
constexpr float EPS = 1e-6f;
constexpr int SSQW = 32;

typedef unsigned short bf16;
typedef short bf16x8 __attribute__((ext_vector_type(8)));
typedef short s16x4 __attribute__((ext_vector_type(4)));
typedef float f32x4 __attribute__((ext_vector_type(4)));
typedef float f32x2 __attribute__((ext_vector_type(2)));
typedef float f32x16 __attribute__((ext_vector_type(16)));
typedef unsigned u32x4 __attribute__((ext_vector_type(4)));
typedef unsigned u32x2 __attribute__((ext_vector_type(2)));

DEV unsigned f2bf(float f) { unsigned u = __builtin_bit_cast(unsigned, f); return (u + 0x7fffu + ((u >> 16) & 1u)) >> 16; }
DEV float bf2f(unsigned h) { return __builtin_bit_cast(float, (h & 0xffffu) << 16); }
DEV float bflo(unsigned w) { return __builtin_bit_cast(float, w << 16); }
DEV float bfhi(unsigned w) { return __builtin_bit_cast(float, w & 0xffff0000u); }
#ifndef HOST_EMU
typedef __bf16 bf16v2_t __attribute__((ext_vector_type(2)));
DEV unsigned pk2(float lo, float hi) { const f32x2 v = {lo, hi}; const bf16v2_t b = __builtin_convertvector(v, bf16v2_t); return __builtin_bit_cast(unsigned, b); }
DEV float fexp2(float x) { return __builtin_amdgcn_exp2f(x); }
DEV float frcp(float x) { return __builtin_amdgcn_rcpf(x); }
DEV float frsq(float x) { return __builtin_amdgcn_rsqf(x); }
#define MFMA32(a, b, c) __builtin_amdgcn_mfma_f32_32x32x16_bf16(a, b, c, 0, 0, 0)
#define PERMLANE32_SWAP(a, b) __builtin_amdgcn_permlane32_swap(a, b, false, false)
#define MFMA16K16(a, b, c) __builtin_amdgcn_mfma_f32_16x16x16bf16_1k(a, b, c, 0, 0, 0)
#else
DEV unsigned pk2(float lo, float hi) { return f2bf(lo) | (f2bf(hi) << 16); }
DEV float fexp2(float x) { return exp2f(x); }
DEV float frcp(float x) { return 1.0f / x; }
DEV float frsq(float x) { return 1.0f / sqrtf(x); }
#define MFMA32(a, b, c) emu_mfma32(a, b, c)
#define PERMLANE32_SWAP(a, b) emu_permlane32_swap(a, b)
#define MFMA16K16(a, b, c) emu_mfma16k16(a, b, c)
#endif
DEV float sigmoidf_(float x) { return frcp(1.0f + fexp2(-1.4426950408889634f * x)); }
DEV float siluf_(float x) { return x * sigmoidf_(x); }
DEV float gelu_tanh(float x) { const float u = 0.7978845608028654f * (x + 0.044715f * x * x * x); return x * sigmoidf_(2.0f * u); }
DEV int pos16(int n) { return (n & 3) | ((n & 4) << 1) | ((n & 8) >> 1); }
DEV int rowmap32(int reg, int hh) { return (reg & 3) + 8 * (reg >> 2) + 4 * hh; }
DEV bf16x8 pack8(float a0, float a1, float a2, float a3, float a4, float a5, float a6, float a7) {
    u32x4 w; w.x = pk2(a0, a1); w.y = pk2(a2, a3); w.z = pk2(a4, a5); w.w = pk2(a6, a7); return __builtin_bit_cast(bf16x8, w); }
DEV s16x4 pack4(float a0, float a1, float a2, float a3) { u32x2 w; w.x = pk2(a0, a1); w.y = pk2(a2, a3); return __builtin_bit_cast(s16x4, w); }
DEV u32x4 widen_pair(u32x2 gk, u32x2 gk1) { const auto r0 = PERMLANE32_SWAP(gk.x, gk1.x); const auto r1 = PERMLANE32_SWAP(gk.y, gk1.y); u32x4 w; w.x = r0[0]; w.y = r1[0]; w.z = r0[1]; w.w = r1[1]; return w; }
DEV float wave_sum(float v) {
#pragma unroll
    for (int o = 1; o < 64; o <<= 1) v += __shfl_xor(v, o);
    return v;
}

constexpr size_t MiB = 1u << 20;
constexpr size_t WS_CTL = 0, CTL_ZERO_BYTES = 1 * MiB;
constexpr size_t WS_W = 1 * MiB;
constexpr size_t W_F1IN = WS_W, W_F1OUT = W_F1IN + (size_t)2 * DFF * DM * 2, W_F2IN = W_F1OUT + (size_t)DM * DFF * 2, W_F2OUT = W_F2IN + (size_t)2 * DFF * DM * 2;
constexpr size_t W_MIX = W_F2OUT + (size_t)DM * DFF * 2;
constexpr size_t W_ROUT = W_MIX + (size_t)RIN * DM * 2;
constexpr size_t W_XQ = W_ROUT + (size_t)DM * RVW * 2, W_XO = W_XQ + (size_t)DM * DM * 2, W_XK = W_XO + (size_t)DM * DM * 2, W_XV = W_XK + (size_t)DM * DM * 2;
constexpr size_t W_XKV_SET = (size_t)2 * DM * DM * 2;
constexpr size_t W_END = W_XV + (size_t)DM * DM * 2 + W_XKV_SET;
static_assert(W_END <= 65 * MiB, "weight region");
constexpr size_t WS_S5T = 65 * MiB, S5T_STRIDE = 1 * MiB;
constexpr size_t S5T_BBAR = WS_S5T, S5T_CT = S5T_BBAR + (size_t)S5G * 2 * S5P * S5H * 2, S5T_A = S5T_CT + (size_t)S5G * 2 * S5H * S5P * 2, S5T_AL = S5T_A + (size_t)S5G * S5P * 2 * 4;
static_assert(S5T_AL + (size_t)S5G * S5P * 2 * 4 <= WS_S5T + S5T_STRIDE, "s5 tables");
constexpr size_t WS_ROT = 67 * MiB;
static_assert((size_t)ROT_NPOS * 128 * 8 <= 13 * MiB, "rot table");
constexpr size_t WS_MEMN = 80 * MiB, WS_MEMNP = 84 * MiB;
constexpr size_t WS_XK = 88 * MiB, WS_XVT = 96 * MiB, XKV_SET = 4 * MiB;
constexpr size_t WS_SSQ = 104 * MiB;
constexpr size_t WS_XHAT = 105 * MiB;
constexpr size_t WS_BIG = 233 * MiB;
constexpr size_t BIG_H = WS_BIG;
constexpr size_t BIG_YB = WS_BIG, BIG_ES = WS_BIG + 128 * MiB;
constexpr size_t BIG_RQ = WS_BIG, BIG_RK = WS_BIG + 128 * MiB, BIG_RVT = WS_BIG + 256 * MiB, BIG_RO = WS_BIG + 512 * MiB, BIG_RST = WS_BIG + 768 * MiB;
constexpr size_t BIG_XQ = WS_BIG, BIG_XO = WS_BIG + 128 * MiB;
constexpr size_t WS_END = WS_BIG + 784 * MiB;
static_assert(WS_END <= (size_t)1024 * MiB, "workspace map");
#ifndef HOST_EMU
namespace pg8 {
#define PG8_LAS __attribute__((address_space(3)))
typedef unsigned short bf16_t;
typedef short bf16x8 __attribute__((ext_vector_type(8)));
typedef float f32x4 __attribute__((ext_vector_type(4)));
typedef unsigned u32x4 __attribute__((ext_vector_type(4)));
constexpr int BM = 256, BK = 64, HALF = 128, HTB = HALF * BK * 2  , STAGE_BYTES = 8 * HTB, NXCD = 8, WGM = 8;

__host__ __device__ __forceinline__ int lds_byte(int r, int c) { const int st = (r >> 4) * 2 + (c >> 5), rr = r & 15, cc = c & 31, ob = rr * 64 + cc * 2; return st * 1024 + (ob ^ (((ob >> 9) & 1) << 5)); }
__host__ __device__ __forceinline__ void stage_rc(int b, int& R, int& C) { const int st = b / 1024, sb = b % 1024, swz = sb ^ (((sb >> 9) & 1) << 5); R = (st >> 1) * 16 + swz / 64; C = (st & 1) * 32 + (swz % 64) / 2; }
__host__ __device__ __forceinline__ int perm32(int rho) { const int n = rho >> 4, i = rho & 15; return 8 * (i >> 2) + 4 * n + (i & 3); }

struct Unit { int pm, pn; };
struct Gemm { const bf16_t* A; const bf16_t* Bt; int M, N, K; int ld = 0; };

struct StaticOrder {
    int nM, nN, nwg, G, c;
    __host__ __device__ void init(int M, int N, int G_, int c_) { nM = M / BM; nN = N / BM; nwg = nM * nN; G = G_; c = c_; }
    __host__ __device__ bool next(int i, Unit& u) const {
        const long L = (long)i * G + c; if (L >= nwg) return false;
        int wgid = (int)L; { const int q = nwg / NXCD, r = nwg % NXCD, xcd = wgid % NXCD, off = wgid / NXCD; wgid = (xcd < r ? xcd * (q + 1) : r * (q + 1) + (xcd - r) * q) + off; }
        const int nig = WGM * nN, gid = wgid / nig, fm = gid * WGM, gsz = (nM - fm) < WGM ? (nM - fm) : WGM;
        u.pm = fm + ((wgid % nig) % gsz); u.pn = (wgid % nig) / gsz; return true;
    }
    __device__ __forceinline__ void a_ready(const Unit&) const {}
    __device__ __forceinline__ void done(const Unit&) const {}
};
}
#endif
#ifdef HOST_EMU
namespace pg8 { struct Unit { int pm, pn; }; constexpr int BM = 256, HALF = 128; }
#endif
typedef f32x4 AccT[2][2][4][2];
#if !defined(HOST_EMU) && defined(KB_NT_H)
#define NT_STORE16(p, v) __builtin_nontemporal_store((v), (p))
#else
#define NT_STORE16(p, v) (*(p) = (v))
#endif
#ifndef HOST_EMU
#define EPI_OPAQUE(a, b) asm volatile("" : "+v"(a), "+v"(b))
#else
#define EPI_OPAQUE(a, b) do {} while (0)
#endif

typedef unsigned long long ssq_t;
constexpr float SSQ_SCALE = 1048576.0f, SSQ_INV = 1.0f / 1048576.0f;
DEV ssq_t ss_fix(float v) { return (ssq_t)(v * SSQ_SCALE + 0.5f); }
DEV float ss_val(ssq_t v) { return (float)v * SSQ_INV; }
#ifndef HOST_EMU
DEV ssq_t zero64() { unsigned lo = 0u, hi = 0u; asm volatile("" : "+v"(lo), "+v"(hi)); return ((ssq_t)hi << 32) | lo; }
#else
DEV ssq_t zero64() { return 0ull; }
#endif
DEV void row_rstd(const ssq_t* ss, int row0, float (&rs)[2][4]) {
#pragma unroll
    for (int ai = 0; ai < 2; ++ai)
#pragma unroll
        for (int m = 0; m < 4; ++m) rs[ai][m] = frsq(ss_val(ss[row0 + 128 * ai + 16 * m]) * (1.0f / DM) + EPS);
}
#ifndef HOST_EMU
DEV void ss_add(ssq_t* p, float v) { atomicAdd(p, ss_fix(v)); }
#else
#include <mutex>
static std::mutex e_atomic_mtx;
DEV void ss_add(ssq_t* p, float v) { std::lock_guard<std::mutex> g(e_atomic_mtx); *p += ss_fix(v); }
#endif

struct EpiResid {
    static constexpr bool PERM = true, AFTER_DRAIN = false;
    bf16* xh; ssq_t* ss_acc; ssq_t* ss_zero; float scale;
    DEV void operator()(const AccT& acc, const pg8::Unit& u, int wr, int wc, int fr, int fq) const {
        EPI_OPAQUE(fr, fq);
        const int row0 = u.pm * 256 + wr * 64 + fr, col0 = u.pn * 256 + wc * 32 + 8 * fq;
#pragma unroll
        for (int ai = 0; ai < 2; ++ai)
#pragma unroll
            for (int m = 0; m < 4; ++m) { const int row = row0 + 128 * ai + 16 * m; bf16* rowp = xh + (size_t)row * DM + col0; float ss = 0.f;
#pragma unroll
                for (int bj = 0; bj < 2; ++bj) { const u32x4 b = *(const u32x4*)(rowp + 128 * bj); const f32x4 a0 = acc[ai][bj][m][0] * scale, a1 = acc[ai][bj][m][1] * scale;
                    u32x4 w; w.x = pk2(bflo(b.x) + a0[0], bfhi(b.x) + a0[1]); w.y = pk2(bflo(b.y) + a0[2], bfhi(b.y) + a0[3]); w.z = pk2(bflo(b.z) + a1[0], bfhi(b.z) + a1[1]); w.w = pk2(bflo(b.w) + a1[2], bfhi(b.w) + a1[3]);
                    *(u32x4*)(rowp + 128 * bj) = w;
                    const float o0 = bflo(w.x), o1 = bfhi(w.x), o2 = bflo(w.y), o3 = bfhi(w.y), o4 = bflo(w.z), o5 = bfhi(w.z), o6 = bflo(w.w), o7 = bfhi(w.w);
                    ss += ((o0 * o0 + o1 * o1) + (o2 * o2 + o3 * o3)) + ((o4 * o4 + o5 * o5) + (o6 * o6 + o7 * o7)); }
                ss += __shfl_xor(ss, 16); ss += __shfl_xor(ss, 32);
                if (fq == 0) { ss_add(ss_acc + row, ss); ss_zero[row] = zero64(); }
            }
    }
};
struct EpiS5Glu {
    static constexpr bool PERM = true, AFTER_DRAIN = false;
    bf16* xh; ssq_t* ss_acc; ssq_t* ss_zero;
    DEV void operator()(const AccT& acc, const pg8::Unit& u, int wr, int wc, int fr, int fq) const {
        EPI_OPAQUE(fr, fq);
        const int row0 = u.pm * 256 + wr * 64 + fr, col0 = u.pn * 128 + wc * 32 + 8 * fq;
#pragma unroll
        for (int ai = 0; ai < 2; ++ai)
#pragma unroll
            for (int m = 0; m < 4; ++m) { const int row = row0 + 128 * ai + 16 * m; bf16* rowp = xh + (size_t)row * DM + col0;
                const u32x4 b = *(const u32x4*)rowp; const float bb[8] = {bflo(b.x), bfhi(b.x), bflo(b.y), bfhi(b.y), bflo(b.z), bfhi(b.z), bflo(b.w), bfhi(b.w)}; float o[8];
#pragma unroll
                for (int n = 0; n < 2; ++n)
#pragma unroll
                    for (int e = 0; e < 4; ++e) o[4 * n + e] = bb[4 * n + e] + acc[ai][0][m][n][e] * sigmoidf_(acc[ai][1][m][n][e]);
                u32x4 w; w.x = pk2(o[0], o[1]); w.y = pk2(o[2], o[3]); w.z = pk2(o[4], o[5]); w.w = pk2(o[6], o[7]);
                *(u32x4*)rowp = w;
                const float o0 = bflo(w.x), o1 = bfhi(w.x), o2 = bflo(w.y), o3 = bfhi(w.y), o4 = bflo(w.z), o5 = bfhi(w.z), o6 = bflo(w.w), o7 = bfhi(w.w);
                float ss = ((o0 * o0 + o1 * o1) + (o2 * o2 + o3 * o3)) + ((o4 * o4 + o5 * o5) + (o6 * o6 + o7 * o7));
                ss += __shfl_xor(ss, 16); ss += __shfl_xor(ss, 32);
                if (fq == 0) { ss_add(ss_acc + row, ss); ss_zero[row] = zero64(); }
            }
    }
};
struct EpiSwiGLU {
    static constexpr bool PERM = true, AFTER_DRAIN = false;
    bf16* H; const ssq_t* ssq;
    DEV void operator()(const AccT& acc, const pg8::Unit& u, int wr, int wc, int fr, int fq) const {
        EPI_OPAQUE(fr, fq);
        const int row0 = u.pm * 256 + wr * 64 + fr, col0 = u.pn * 128 + wc * 32 + 8 * fq;
        float rs[2][4]; row_rstd(ssq, row0, rs);
#pragma unroll
        for (int ai = 0; ai < 2; ++ai)
#pragma unroll
            for (int m = 0; m < 4; ++m) { const float r = rs[ai][m]; float h[8];
#pragma unroll
                for (int n = 0; n < 2; ++n)
#pragma unroll
                    for (int e = 0; e < 4; ++e) { const float a = acc[ai][0][m][n][e] * r, b = acc[ai][1][m][n][e] * r; h[4 * n + e] = siluf_(a) * b; }
                u32x4 w; w.x = pk2(h[0], h[1]); w.y = pk2(h[2], h[3]); w.z = pk2(h[4], h[5]); w.w = pk2(h[6], h[7]);
                NT_STORE16((u32x4*)(H + (size_t)(row0 + 128 * ai + 16 * m) * DFF + col0), w); }
    }
};
template <int NSLOT> struct EpiBf16 {
    static constexpr bool PERM = true, AFTER_DRAIN = false;
    bf16* O; int ldc; const ssq_t* ssq;
    DEV void operator()(const AccT& acc, const pg8::Unit& u, int wr, int wc, int fr, int fq) const {
        EPI_OPAQUE(fr, fq);
        const int row0 = u.pm * 256 + wr * 64 + fr, col0 = u.pn * 256 + wc * 32 + 8 * fq;
        float rs[2][4];
        if constexpr (NSLOT > 0) row_rstd(ssq, row0, rs);
#pragma unroll
        for (int ai = 0; ai < 2; ++ai)
#pragma unroll
            for (int m = 0; m < 4; ++m) { const float r = NSLOT > 0 ? rs[ai][m] : 1.0f; bf16* rowp = O + (size_t)(row0 + 128 * ai + 16 * m) * ldc + col0;
#pragma unroll
                for (int bj = 0; bj < 2; ++bj) { const f32x4 v0 = acc[ai][bj][m][0] * r, v1 = acc[ai][bj][m][1] * r;
                    u32x4 w; w.x = pk2(v0[0], v0[1]); w.y = pk2(v0[2], v0[3]); w.z = pk2(v1[0], v1[1]); w.w = pk2(v1[2], v1[3]);
                    *(u32x4*)(rowp + 128 * bj) = w; } }
    }
};
struct EpiRetIn {
    static constexpr bool PERM = true, AFTER_DRAIN = false;
    bf16 *Q, *K; const ssq_t* ssq; const float* rot; const int* positions;
    DEV void operator()(const AccT& acc, const pg8::Unit& u, int wr, int wc, int fr, int fq) const {
        EPI_OPAQUE(fr, fq);
        const int row0 = u.pm * 256 + wr * 64 + fr, pn = u.pn;
        float rs[2][4]; row_rstd(ssq, row0, rs);
        {
            const int h = pn & 3; const bool isk = pn >= 4; bf16* dst = isk ? K : Q;
            const float lg = log2f(1.0f - exp2f(-5.0f - (float)h)); const int d0 = wc * 32 + 8 * fq;
#pragma unroll
            for (int ai = 0; ai < 2; ++ai)
#pragma unroll
                for (int m = 0; m < 4; ++m) { const int row = row0 + 128 * ai + 16 * m; const int i256 = row & (RMC - 1);
                    const float sc = rs[ai][m] * (isk ? fexp2(-lg * (float)i256) * 0.0625f : fexp2(lg * (float)i256));
                    const float* rp = rot + ((size_t)positions[row] * 128 + d0) * 2;
                    const f32x4 r0 = *(const f32x4*)rp, r1 = *(const f32x4*)(rp + 4), r2 = *(const f32x4*)(rp + 8), r3 = *(const f32x4*)(rp + 12);
                    const float cs[8] = {r0[0], r0[2], r1[0], r1[2], r2[0], r2[2], r3[0], r3[2]}, sn[8] = {r0[1], r0[3], r1[1], r1[3], r2[1], r2[3], r3[1], r3[3]};
                    float o1[8], o2[8];
#pragma unroll
                    for (int n = 0; n < 2; ++n)
#pragma unroll
                        for (int e = 0; e < 4; ++e) { const float t1 = acc[ai][0][m][n][e] * sc, t2 = acc[ai][1][m][n][e] * sc; const int j = 4 * n + e;
                            o1[j] = t1 * cs[j] - t2 * sn[j]; o2[j] = t1 * sn[j] + t2 * cs[j]; }
                    u32x4 w1, w2; w1.x = pk2(o1[0], o1[1]); w1.y = pk2(o1[2], o1[3]); w1.z = pk2(o1[4], o1[5]); w1.w = pk2(o1[6], o1[7]);
                    w2.x = pk2(o2[0], o2[1]); w2.y = pk2(o2[2], o2[3]); w2.z = pk2(o2[4], o2[5]); w2.w = pk2(o2[6], o2[7]);
                    bf16* p = dst + (size_t)row * DM + 256 * h + d0; *(u32x4*)p = w1; *(u32x4*)(p + 128) = w2; }
        }
    }
};
struct EpiRetGate {
    static constexpr bool PERM = true, AFTER_DRAIN = false;
    bf16* O; const ssq_t* ssq; const float* stat;
    DEV void operator()(const AccT& acc, const pg8::Unit& u, int wr, int wc, int fr, int fq) const {
        EPI_OPAQUE(fr, fq);
        const int row0 = u.pm * 256 + wr * 64 + fr, h = u.pn >> 1, col0 = u.pn * 256 + wc * 32 + 8 * fq;
        float rs[2][4]; row_rstd(ssq, row0, rs);
#pragma unroll
        for (int ai = 0; ai < 2; ++ai)
#pragma unroll
            for (int m = 0; m < 4; ++m) { const int row = row0 + 128 * ai + 16 * m; const float r = rs[ai][m];
                const f32x4 st = *(const f32x4*)(stat + ((size_t)row * RH + h) * 16 + 4 * fq);
                float s1 = st[0] + st[2], s2 = st[1] + st[3];
                s1 += __shfl_xor(s1, 16); s1 += __shfl_xor(s1, 32); s2 += __shfl_xor(s2, 16); s2 += __shfl_xor(s2, 32);
                const float mu = s1 * (1.0f / RDV), var = fmaxf(s2 * (1.0f / RDV) - mu * mu, 0.0f), rg = frsq(var + EPS);
                bf16* rowp = O + (size_t)row * RVW + col0;
#pragma unroll
                for (int bj = 0; bj < 2; ++bj) { const u32x4 ow = *(const u32x4*)(rowp + 128 * bj);
                    const float o[8] = {bflo(ow.x), bfhi(ow.x), bflo(ow.y), bfhi(ow.y), bflo(ow.z), bfhi(ow.z), bflo(ow.w), bfhi(ow.w)}; float y[8];
#pragma unroll
                    for (int n = 0; n < 2; ++n)
#pragma unroll
                        for (int e = 0; e < 4; ++e) { const int j = 4 * n + e; y[j] = siluf_(acc[ai][bj][m][n][e] * r) * ((o[j] - mu) * rg); }
                    u32x4 w; w.x = pk2(y[0], y[1]); w.y = pk2(y[2], y[3]); w.z = pk2(y[4], y[5]); w.w = pk2(y[6], y[7]);
                    *(u32x4*)(rowp + 128 * bj) = w; } }
    }
};

struct EpiNull {
    static constexpr bool PERM = false, AFTER_DRAIN = false;
    DEV void operator()(const AccT& acc, const pg8::Unit& u, int wr, int wc, int fr, int fq) const {
#ifndef HOST_EMU
#pragma unroll
        for (int ai = 0; ai < 2; ++ai)
#pragma unroll
            for (int bj = 0; bj < 2; ++bj)
#pragma unroll
                for (int m = 0; m < 4; ++m)
#pragma unroll
                    for (int n = 0; n < 2; ++n) asm volatile("" :: "v"(acc[ai][bj][m][n]));
#endif
    }
};

struct EpiRetP {
    static constexpr bool PERM = true, AFTER_DRAIN = false;
    bf16* P;
    DEV void operator()(const AccT& acc, const pg8::Unit& u, int wr, int wc, int fr, int fq) const {
        EPI_OPAQUE(fr, fq);
        bf16* blk = P + (size_t)u.pm * 65536;
        const int i0 = wr * 64 + fr, j0 = wc * 32 + 8 * fq;
#pragma unroll
        for (int ai = 0; ai < 2; ++ai)
#pragma unroll
            for (int m = 0; m < 4; ++m) { const int i = i0 + 128 * ai + 16 * m;
#pragma unroll
                for (int bj = 0; bj < 2; ++bj) { const int jb = j0 + 128 * bj;
                    const int g16 = jb & ~15, f = (jb >> 3) & 1;
#pragma unroll
                    for (int n = 0; n < 2; ++n) { float v[4];
#pragma unroll
                        for (int e_ = 0; e_ < 4; ++e_) v[e_] = (jb + 4 * n + e_ <= i) ? acc[ai][bj][m][n][e_] : 0.f;
                        u32x2 w; w.x = pk2(v[0], v[1]); w.y = pk2(v[2], v[3]);
                        *(u32x2*)(blk + (size_t)i * 256 + g16 + 8 * n + 4 * f) = w; } } }
    }
};

struct EpiRetVT {
    static constexpr bool PERM = true, AFTER_DRAIN = false;
    bf16* VT; const ssq_t* ssq;
    DEV void operator()(const AccT& acc, const pg8::Unit& u, int wr, int wc, int fr, int fq) const {
        EPI_OPAQUE(fr, fq);
        const int row0 = u.pm * 256 + wr * 64 + fr, t0 = u.pn * 256 + wc * 32 + 8 * fq;
        float rs[2][8];
#pragma unroll
        for (int bj = 0; bj < 2; ++bj)
#pragma unroll
            for (int j = 0; j < 8; ++j) rs[bj][j] = frsq(ss_val(ssq[t0 + 128 * bj + j]) * (1.0f / DM) + EPS);
        const int f = fq & 1;
#pragma unroll
        for (int ai = 0; ai < 2; ++ai)
#pragma unroll
            for (int m = 0; m < 4; ++m) { bf16* rowp = VT + (size_t)(row0 + 128 * ai + 16 * m) * M;
#pragma unroll
                for (int bj = 0; bj < 2; ++bj) { const int g16 = (t0 + 128 * bj) & ~15;
#pragma unroll
                    for (int n = 0; n < 2; ++n) { const f32x4 a = acc[ai][bj][m][n]; u32x2 w; w.x = pk2(a[0] * rs[bj][4 * n], a[1] * rs[bj][4 * n + 1]); w.y = pk2(a[2] * rs[bj][4 * n + 2], a[3] * rs[bj][4 * n + 3]);
                        *(u32x2*)(rowp + g16 + 8 * n + 4 * f) = w; } } }
    }
};
#ifndef HOST_EMU
namespace pg8 {
__device__ __forceinline__ int pg8_lane_id_fresh() { unsigned m = ~0u; asm volatile("" : "+s"(m)); return (int)__builtin_amdgcn_mbcnt_hi(m, __builtin_amdgcn_mbcnt_lo(m, 0u)); }
template <class Epi, class Sched, bool ALIGN_EPI = false, bool SP2 = false>
__device__ __forceinline__ void gemm_phase(PG8_LAS unsigned char* lds, const Gemm g, const Sched& S, const Epi& E, int wave_id) {
    int tid_l = wave_id * 64 + pg8_lane_id_fresh(); asm volatile("" : "+v"(tid_l));
    const int tid = tid_l, wid = __builtin_amdgcn_readfirstlane(tid >> 6), lane = tid & 63, wr = wid >> 2, wc = wid & 3, fr = lane & 15, fq = lane >> 4;
    const int K = g.K, nt = K / BK, ldk = g.ld ? g.ld : g.K;
    unsigned voffA[2], voffB[2];
#pragma unroll
    for (int i = 0; i < 2; ++i) { int R, C; stage_rc(tid * 16 + i * 8192, R, C); const int Rb = Epi::PERM ? ((R & ~31) + perm32(R & 31)) : R;
        voffA[i] = (unsigned)(R * ldk + C) * 2u; voffB[i] = (unsigned)(Rb * ldk + C) * 2u; }
    const size_t kstep = (size_t)(BK * 2);
    const size_t hstep = (size_t)HALF * ldk * 2;
    const size_t tstep = 2 * hstep;
    const unsigned ldsw = (unsigned)wid * 1024u;
    const int aoff = lds_byte(wr * 64 + fr, fq * 8), boff = lds_byte(wc * 32 + fr, fq * 8);
#define PG8_SA(b, h) (((b) * 2 + (h)) * HTB)
#define PG8_SB(b, h) ((4 + (b) * 2 + (h)) * HTB)
#define PG8_STAGE(bufoff, gbase, voff) do { _Pragma("unroll") for (int _i = 0; _i < 2; ++_i) \
        __builtin_amdgcn_global_load_lds((const unsigned*)((const char*)(gbase) + (voff)[_i]), (PG8_LAS unsigned*)(lds + (bufoff) + ldsw + _i * 8192), 16, 0, 0); } while (0)
#define PG8_LDA(dst, b, h) do { _Pragma("unroll") for (int m = 0; m < 4; ++m) _Pragma("unroll") for (int k = 0; k < 2; ++k) dst[m][k] = *(const PG8_LAS bf16x8*)(lds + PG8_SA(b, h) + aoff + m * 2048 + k * 1024); } while (0)
#define PG8_LDB(dst, b, h) do { _Pragma("unroll") for (int n = 0; n < 2; ++n) _Pragma("unroll") for (int k = 0; k < 2; ++k) dst[n][k] = *(const PG8_LAS bf16x8*)(lds + PG8_SB(b, h) + boff + n * 2048 + k * 1024); } while (0)
#define PG8_MMA(ai, bj, At, Bt) do { __builtin_amdgcn_s_setprio(1); _Pragma("unroll") for (int m = 0; m < 4; ++m) _Pragma("unroll") for (int n = 0; n < 2; ++n) _Pragma("unroll") for (int k = 0; k < 2; ++k) \
        acc[ai][bj][m][n] = __builtin_amdgcn_mfma_f32_16x16x32_bf16(Bt[n][k], At[m][k], acc[ai][bj][m][n], 0, 0, 0); __builtin_amdgcn_s_setprio(0); } while (0)
#define PG8_WAIT_V(n) asm volatile("s_waitcnt vmcnt(" #n ")" ::: "memory")
#define PG8_WAIT_L(n) asm volatile("s_waitcnt lgkmcnt(" #n ")" ::: "memory")
#define PG8_BAR __builtin_amdgcn_s_barrier()
#define PG8_SCHED __builtin_amdgcn_sched_barrier(0)
    Unit cur, nxt; int ui = 0;
    if (!S.next(0, cur)) return;
    f32x4 acc[2][2][4][2];
#pragma unroll
    for (int a = 0; a < 2; ++a)
#pragma unroll
        for (int b = 0; b < 2; ++b)
#pragma unroll
            for (int m = 0; m < 4; ++m)
#pragma unroll
                for (int n = 0; n < 2; ++n) acc[a][b][m][n] = (f32x4){0.f, 0.f, 0.f, 0.f};
    bf16x8 At[4][2], B0[2][2], B1[2][2];
    const char* cA = (const char*)g.A + (size_t)cur.pm * tstep; const char* cB = (const char*)g.Bt + (size_t)cur.pn * tstep;
    S.a_ready(cur);
    if constexpr (SP2) {
        PG8_STAGE(PG8_SB(0, 0), cB, voffB); PG8_STAGE(PG8_SB(0, 1), cB + hstep, voffB); PG8_STAGE(PG8_SA(0, 0), cA, voffA); PG8_STAGE(PG8_SA(0, 1), cA + hstep, voffA);
        if (wr == 1) PG8_BAR;
        PG8_WAIT_V(2); PG8_BAR;
        PG8_STAGE(PG8_SB(1, 0), cB + kstep, voffB); PG8_STAGE(PG8_SA(1, 0), cA + kstep, voffA); PG8_STAGE(PG8_SB(1, 1), cB + hstep + kstep, voffB);
        PG8_WAIT_V(6); PG8_BAR;
    } else {
        PG8_STAGE(PG8_SB(0, 0), cB, voffB); PG8_STAGE(PG8_SA(0, 0), cA, voffA); PG8_STAGE(PG8_SB(0, 1), cB + hstep, voffB); PG8_STAGE(PG8_SA(0, 1), cA + hstep, voffA);
        if (wr == 1) PG8_BAR;
        PG8_WAIT_V(4); PG8_BAR;
        PG8_STAGE(PG8_SB(1, 0), cB + kstep, voffB); PG8_STAGE(PG8_SA(1, 0), cA + kstep, voffA); PG8_STAGE(PG8_SB(1, 1), cB + hstep + kstep, voffB);
        PG8_WAIT_V(6); PG8_BAR;
    }
    for (;;) {
        const bool has_next = S.next(ui + 1, nxt);
        const char* nA = has_next ? (const char*)g.A + (size_t)nxt.pm * tstep : cA; const char* nB = has_next ? (const char*)g.Bt + (size_t)nxt.pn * tstep : cB;
        for (int t = 0; t < nt; t += 2) {
            const bool last = (t == nt - 2);
            const char* a1 = cA + (size_t)(t + 1) * kstep;
            const char* a2 = last ? nA : cA + (size_t)(t + 2) * kstep; const char* b2 = last ? nB : cB + (size_t)(t + 2) * kstep;
            const char* a3 = a2 + kstep; const char* b3 = b2 + kstep;
            if (last && has_next) S.a_ready(nxt);
            if constexpr (SP2) {
            PG8_LDB(B0, 0, 0); PG8_LDB(B1, 0, 1); PG8_SCHED; PG8_LDA(At, 0, 0); PG8_STAGE(PG8_SA(1, 1), a1 + hstep, voffA);
            PG8_WAIT_V(8); PG8_WAIT_L(0); PG8_BAR; PG8_MMA(0, 0, At, B0); PG8_MMA(0, 1, At, B1); PG8_BAR; PG8_SCHED;
            PG8_LDA(At, 0, 1); PG8_STAGE(PG8_SB(0, 0), b2, voffB); PG8_STAGE(PG8_SB(0, 1), b2 + hstep, voffB); PG8_STAGE(PG8_SA(0, 0), a2, voffA);
            PG8_WAIT_V(8); PG8_WAIT_L(0); PG8_BAR; PG8_MMA(1, 0, At, B0); PG8_MMA(1, 1, At, B1); PG8_BAR; PG8_SCHED;
            PG8_LDB(B0, 1, 0); PG8_LDB(B1, 1, 1); PG8_SCHED; PG8_LDA(At, 1, 0); PG8_STAGE(PG8_SA(0, 1), a2 + hstep, voffA);
            PG8_WAIT_V(8); PG8_WAIT_L(0); PG8_BAR; PG8_MMA(0, 0, At, B0); PG8_MMA(0, 1, At, B1); PG8_BAR; PG8_SCHED;
            PG8_LDA(At, 1, 1); PG8_STAGE(PG8_SB(1, 0), b3, voffB); PG8_STAGE(PG8_SB(1, 1), b3 + hstep, voffB); PG8_STAGE(PG8_SA(1, 0), a3, voffA);
            PG8_WAIT_V(8); PG8_WAIT_L(0); PG8_BAR; PG8_MMA(1, 0, At, B0); PG8_MMA(1, 1, At, B1); PG8_BAR; PG8_SCHED;
            } else {
            PG8_LDB(B0, 0, 0); PG8_SCHED; PG8_LDA(At, 0, 0); PG8_STAGE(PG8_SA(1, 1), a1 + hstep, voffA);
            PG8_WAIT_L(8); PG8_BAR; PG8_WAIT_L(0); PG8_MMA(0, 0, At, B0); PG8_BAR; PG8_SCHED;
            PG8_LDB(B1, 0, 1); PG8_STAGE(PG8_SB(0, 0), b2, voffB);
            PG8_BAR; PG8_WAIT_L(0); PG8_MMA(0, 1, At, B1); PG8_BAR;
            PG8_LDA(At, 0, 1); PG8_STAGE(PG8_SA(0, 0), a2, voffA);
            PG8_BAR; PG8_WAIT_L(0); PG8_MMA(1, 0, At, B0); PG8_BAR; PG8_SCHED;
            PG8_STAGE(PG8_SB(0, 1), b2 + hstep, voffB);
            PG8_WAIT_V(6); PG8_BAR; PG8_MMA(1, 1, At, B1); PG8_BAR;
            PG8_LDB(B0, 1, 0); PG8_SCHED; PG8_LDA(At, 1, 0); PG8_STAGE(PG8_SA(0, 1), a2 + hstep, voffA);
            PG8_WAIT_L(8); PG8_BAR; PG8_WAIT_L(0); PG8_MMA(0, 0, At, B0); PG8_BAR; PG8_SCHED;
            PG8_LDB(B1, 1, 1); PG8_STAGE(PG8_SB(1, 0), b3, voffB);
            PG8_BAR; PG8_WAIT_L(0); PG8_MMA(0, 1, At, B1); PG8_BAR;
            PG8_LDA(At, 1, 1); PG8_STAGE(PG8_SA(1, 0), a3, voffA);
            PG8_BAR; PG8_WAIT_L(0); PG8_MMA(1, 0, At, B0); PG8_BAR; PG8_SCHED;
            PG8_STAGE(PG8_SB(1, 1), b3 + hstep, voffB);
            PG8_WAIT_V(6); PG8_BAR; PG8_MMA(1, 1, At, B1); PG8_BAR;
            }
        }
        if constexpr (ALIGN_EPI) { if (wr == 0) PG8_BAR; }
        if constexpr (!Epi::AFTER_DRAIN) { E(acc, cur, wr, wc, fr, fq); S.done(cur); }
        if (!has_next) break;
#pragma unroll
        for (int a = 0; a < 2; ++a)
#pragma unroll
            for (int b = 0; b < 2; ++b)
#pragma unroll
                for (int m = 0; m < 4; ++m)
#pragma unroll
                    for (int n = 0; n < 2; ++n) acc[a][b][m][n] = (f32x4){0.f, 0.f, 0.f, 0.f};
        cur = nxt; cA = nA; cB = nB; ++ui;
        if constexpr (ALIGN_EPI) { if (wr == 1) PG8_BAR; }
    }
    PG8_WAIT_V(0);
    if constexpr (!ALIGN_EPI) { if (wr == 0) PG8_BAR; }
    PG8_BAR;
    if constexpr (Epi::AFTER_DRAIN) { E.fused(acc, cur, wr, wc, fr, fq, lds, wid, lane); S.done(cur); }
#undef PG8_SA
#undef PG8_SB
#undef PG8_STAGE
#undef PG8_LDA
#undef PG8_LDB
#undef PG8_MMA
#undef PG8_WAIT_V
#undef PG8_WAIT_L
#undef PG8_BAR
#undef PG8_SCHED
}
}
#endif
#ifndef HOST_EMU
#define WAVE_LDS_SYNC() do { asm volatile("s_waitcnt lgkmcnt(0)" ::: "memory"); } while (0)
#else
#define WAVE_LDS_SYNC() do { e_wave->bar.arrive_and_wait(); } while (0)
#endif
DEV void conv_tile(const float* W, int ldw, int k0, int n0, const float* gain, bf16* dst, int Kd, LAS float* scr, int lane) {
#pragma unroll 8
    for (int i = 0; i < 32; ++i) { const int kk = 2 * i + (lane >> 5); float v = W[(size_t)(k0 + kk) * ldw + n0 + (lane & 31)]; if (gain) v *= gain[k0 + kk]; scr[kk * 33 + (lane & 31)] = v; }
    WAVE_LDS_SYNC();
    const int c = lane & 7;
#pragma unroll
    for (int j = 0; j < 4; ++j) { const int n = (lane >> 3) + 8 * j; const LAS float* s = scr + (8 * c) * 33 + n;
        u32x4 o; o.x = pk2(s[0 * 33], s[1 * 33]); o.y = pk2(s[2 * 33], s[3 * 33]); o.z = pk2(s[4 * 33], s[5 * 33]); o.w = pk2(s[6 * 33], s[7 * 33]);
        *(u32x4*)(dst + (size_t)n * Kd + k0 + 8 * c) = o; }
    WAVE_LDS_SYNC();
}
DEV int glu_row(int n, int NH) { const int j = n < NH ? n : n - NH; return (j >> 7) * 256 + (n < NH ? 0 : 128) + (j & 127); }

struct LayerW {
    const float *g;
    const float *f1in, *f1out, *f2in, *f2out;
    const float *mixin, *mixout;
    const float *xq, *xkv, *xkv2, *xo;
    int is_ret;
};
DEV void convert_layer(const LayerW& L, unsigned char* ws, LAS float* scr, int gw, int NGW, int lane) {
    constexpr int I_FIN = (DM / 64) * (2 * DFF / 32), I_FOUT = (DFF / 64) * (DM / 32), I_GLU = (DM / 64) * (2 * DM / 32), I_RIN = (DM / 64) * (RIN / 32), I_ROUT = (RVW / 64) * (DM / 32),
                  I_SQ = (DM / 64) * (DM / 32), I_KV = (DM / 64) * (2 * DM / 32);
    const int i_mix = L.is_ret ? I_RIN + I_ROUT : I_GLU;
    const int n_kv = L.is_ret ? 0 : 2 * I_KV;
    const int total = 2 * (I_FIN + I_FOUT) + i_mix + 2 * I_SQ + n_kv;
    for (int it = gw; it < total; it += NGW) {
        int r = it;
        if (r < 2 * I_FIN) { const int f = r >= I_FIN; r -= f * I_FIN; const int nb = r % (2 * DFF / 32), kb = r / (2 * DFF / 32);
            conv_tile(f ? L.f2in : L.f1in, 2 * DFF, 64 * kb, 32 * nb, L.g + (f ? 3 : 0) * DM, (bf16*)(ws + (f ? W_F2IN : W_F1IN)) + (size_t)glu_row(32 * nb, DFF) * DM, DM, scr, lane); continue; }
        r -= 2 * I_FIN;
        if (r < 2 * I_FOUT) { const int f = r >= I_FOUT; r -= f * I_FOUT; const int nb = r % (DM / 32), kb = r / (DM / 32);
            conv_tile(f ? L.f2out : L.f1out, DM, 64 * kb, 32 * nb, nullptr, (bf16*)(ws + (f ? W_F2OUT : W_F1OUT)) + (size_t)(32 * nb) * DFF, DFF, scr, lane); continue; }
        r -= 2 * I_FOUT;
        if (r < i_mix) {
            if (!L.is_ret) { const int nb = r % (2 * DM / 32), kb = r / (2 * DM / 32);
                conv_tile(L.mixin, 2 * DM, 64 * kb, 32 * nb, nullptr, (bf16*)(ws + W_MIX) + (size_t)glu_row(32 * nb, DM) * DM, DM, scr, lane); }
            else if (r < I_RIN) { const int nb = r % (RIN / 32), kb = r / (RIN / 32);
                conv_tile(L.mixin, RIN, 64 * kb, 32 * nb, L.g + 1 * DM, (bf16*)(ws + W_MIX) + (size_t)(32 * nb) * DM, DM, scr, lane); }
            else { r -= I_RIN; const int nb = r % (DM / 32), kb = r / (DM / 32);
                conv_tile(L.mixout, DM, 64 * kb, 32 * nb, nullptr, (bf16*)(ws + W_ROUT) + (size_t)(32 * nb) * RVW, RVW, scr, lane); }
            continue; }
        r -= i_mix;
        if (r < 2 * I_SQ) { const int f = r >= I_SQ; r -= f * I_SQ; const int nb = r % (DM / 32), kb = r / (DM / 32);
            conv_tile(f ? L.xo : L.xq, DM, 64 * kb, 32 * nb, f ? nullptr : L.g + 2 * DM, (bf16*)(ws + (f ? W_XO : W_XQ)) + (size_t)(32 * nb) * DM, DM, scr, lane); continue; }
        r -= 2 * I_SQ;
        { const int set = r >= I_KV; r -= set * I_KV; const int nb = r % (2 * DM / 32), kb = r / (2 * DM / 32); const int n0 = 32 * nb;
          conv_tile(set ? L.xkv2 : L.xkv, 2 * DM, 64 * kb, n0, nullptr, (bf16*)(ws + (n0 < DM ? W_XK : W_XV) + set * W_XKV_SET) + (size_t)(n0 < DM ? n0 : n0 - DM) * DM, DM, scr, lane); }
    }
}
DEV void s5_tables(const float* lam_re, const float* lam_im, const float* log_dt, const float* b_re, const float* b_im, const float* c_re, const float* c_im, unsigned char* ws, int gt, int NGT) {
    bf16* BBAR = (bf16*)(ws + S5T_BBAR); bf16* CT = (bf16*)(ws + S5T_CT); float* A = (float*)(ws + S5T_A); float* AL = (float*)(ws + S5T_AL);
    for (int idx = gt; idx < S5G * S5P; idx += NGT) {
        const int g = idx / S5P, p = idx % S5P;
        const double dt = exp((double)log_dt[g]), lr = (double)lam_re[idx], li = (double)lam_im[idx];
        const double mag = exp(lr * dt), ang = li * dt, ar = mag * cos(ang), ai = mag * sin(ang);
        const double den = lr * lr + li * li, nr = ar - 1.0, zr = (nr * lr + ai * li) / den, zi = (ai * lr - nr * li) / den;
        for (int hi = 0; hi < S5H; ++hi) { const double br = (double)b_re[(size_t)idx * S5H + hi], bi = (double)b_im[(size_t)idx * S5H + hi];
            BBAR[((size_t)(g * 2 + 0) * S5P + p) * S5H + hi] = (bf16)f2bf((float)(zr * br - zi * bi));
            BBAR[((size_t)(g * 2 + 1) * S5P + p) * S5H + hi] = (bf16)f2bf((float)(zr * bi + zi * br)); }
        for (int ho = 0; ho < S5H; ++ho) { const size_t ci = ((size_t)g * S5H + ho) * S5P + p;
            CT[((size_t)(g * 2 + 0) * S5H + ho) * S5P + p] = (bf16)f2bf(c_re[ci]);
            CT[((size_t)(g * 2 + 1) * S5H + ho) * S5P + p] = (bf16)f2bf(-c_im[ci]); }
        A[(size_t)idx * 2] = (float)ar; A[(size_t)idx * 2 + 1] = (float)ai;
        double pr = 1.0, pi = 0.0, qr = ar, qi = ai;
        for (int e = S5_LC; e > 0; e >>= 1) { if (e & 1) { const double t = pr * qr - pi * qi; pi = pr * qi + pi * qr; pr = t; } const double t = qr * qr - qi * qi; qi = 2.0 * qr * qi; qr = t; }
        AL[(size_t)idx * 2] = (float)pr; AL[(size_t)idx * 2 + 1] = (float)pi;
    }
}
DEV void rot_table(float* rot, int gt, int NGT) {
    for (int idx = gt; idx < ROT_NPOS * 128; idx += NGT) { const int pos = idx >> 7, k = idx & 127;
        const double invf = exp(-9.210340371976184 * ((double)k / 127.0)), ang = (double)pos * invf;
        rot[(size_t)idx * 2] = (float)cos(ang); rot[(size_t)idx * 2 + 1] = (float)sin(ang); }
}
DEV void memn_rows(const float* mem, const float* gain, bf16* MEMN, bf16* MEMNP, int gw, int NGW, int lane) {
    for (int row = gw; row < MMEM; row += NGW) {
        const f32x4* xr = (const f32x4*)(mem + (size_t)row * DM) + lane; const f32x4* gr = (const f32x4*)gain + lane;
        f32x4 v[4]; float s = 0.f;
#pragma unroll
        for (int j = 0; j < 4; ++j) { v[j] = xr[64 * j]; s += (v[j][0] * v[j][0] + v[j][1] * v[j][1]) + (v[j][2] * v[j][2] + v[j][3] * v[j][3]); }
        const float r = 1.0f / sqrtf(wave_sum(s) * (1.0f / DM) + EPS);
        const int rowp = (row & ~15) | pos16(row & 15);
#pragma unroll
        for (int j = 0; j < 4; ++j) { const f32x4 g = gr[64 * j]; u32x2 w; w.x = pk2(v[j][0] * r * g[0], v[j][1] * r * g[1]); w.y = pk2(v[j][2] * r * g[2], v[j][3] * r * g[3]);
            *((u32x2*)(MEMN + (size_t)row * DM) + lane + 64 * j) = w; *((u32x2*)(MEMNP + (size_t)rowp * DM) + lane + 64 * j) = w; }
    }
}
DEV void x0_rows(const float* x, bf16* xh, ssq_t* ss0, ssq_t* ss1, int gw, int NGW, int lane) {
    for (int row = gw; row < M; row += NGW) {
        const f32x4* xr = (const f32x4*)(x + (size_t)row * DM) + lane; float s = 0.f;
#pragma unroll
        for (int j = 0; j < 4; ++j) { const f32x4 v = xr[64 * j]; u32x2 w; w.x = pk2(v[0], v[1]); w.y = pk2(v[2], v[3]); *((u32x2*)(xh + (size_t)row * DM) + lane + 64 * j) = w;
            const float q0 = bflo(w.x), q1 = bfhi(w.x), q2 = bflo(w.y), q3 = bfhi(w.y); s += (q0 * q0 + q1 * q1) + (q2 * q2 + q3 * q3); }
        s = wave_sum(s);
        if (lane == 0) { ss0[row] = ss_fix(s); ss1[row] = 0ull; }
    }
}
DEV void final_rows(const bf16* xh, const ssq_t* ssq, const float* gain, float* out, int gw, int NGW, int lane) {
    const f32x4* gr = (const f32x4*)gain + lane; f32x4 g[4];
#pragma unroll
    for (int j = 0; j < 4; ++j) g[j] = gr[64 * j];
    for (int row0 = gw * 4; row0 < M; row0 += NGW * 4) {
        u32x2 v[4][4]; float r[4];
#pragma unroll
        for (int i = 0; i < 4; ++i) { r[i] = 1.0f / sqrtf(ss_val(ssq[row0 + i]) * (1.0f / DM) + EPS); const u32x2* xr = (const u32x2*)(xh + (size_t)(row0 + i) * DM) + lane;
#pragma unroll
            for (int j = 0; j < 4; ++j) v[i][j] = xr[64 * j]; }
#pragma unroll
        for (int i = 0; i < 4; ++i) { f32x4* orow = (f32x4*)(out + (size_t)(row0 + i) * DM) + lane;
#pragma unroll
            for (int j = 0; j < 4; ++j) { f32x4 o; o[0] = bflo(v[i][j].x) * r[i] * g[j][0]; o[1] = bfhi(v[i][j].x) * r[i] * g[j][1]; o[2] = bflo(v[i][j].y) * r[i] * g[j][2]; o[3] = bfhi(v[i][j].y) * r[i] * g[j][3]; orow[64 * j] = o; } }
    }
}
template <int PASS> DEV void s5_pass(const bf16* xh, const ssq_t* ssq, const float* gain, const float* dskip, const unsigned char* ws, float* ES, bf16* YB, LAS unsigned char* lds, int vcu, int G, int tid) {
    const int wave = tid >> 6, lane = tid & 63, fr = lane & 15, fq = lane >> 4;
    const bf16* BBAR = (const bf16*)(ws + S5T_BBAR); const bf16* CT = (const bf16*)(ws + S5T_CT); const float* A = (const float*)(ws + S5T_A);
    LAS float* rtab = (LAS float*)lds;
    constexpr int NT = BATCH * 4 * 8, QLEN = SEQ / 4;
    for (int wt = vcu; wt < NT; wt += G) {
        const int gb = wt & 7, bq = wt >> 3, q4 = bq & 3, b = bq >> 2, g = 8 * gb + wave;
        const int tok0 = b * SEQ + q4 * QLEN;
        __syncthreads();
        for (int t = tid; t < QLEN; t += 512) rtab[t] = frsq(ss_val(ssq[tok0 + t]) * (1.0f / DM) + EPS);
        __syncthreads();
        s16x4 bb[4][2], cc[4][2]; float ar[4][4], ai[4][4];
#pragma unroll
        for (int ct = 0; ct < 4; ++ct) {
#pragma unroll
            for (int part = 0; part < 2; ++part) {
                bb[ct][part] = *(const s16x4*)(BBAR + ((size_t)(g * 2 + part) * S5P + 16 * ct + fr) * S5H + 4 * fq);
                cc[ct][part] = *(const s16x4*)(CT + ((size_t)(g * 2 + part) * S5H + fr) * S5P + 16 * ct + 4 * fq); }
            const f32x4 a0 = *(const f32x4*)(A + ((size_t)g * S5P + 16 * ct + 4 * fq) * 2), a1 = *(const f32x4*)(A + ((size_t)g * S5P + 16 * ct + 4 * fq) * 2 + 4);
            ar[ct][0] = a0[0]; ai[ct][0] = a0[1]; ar[ct][1] = a0[2]; ai[ct][1] = a0[3]; ar[ct][2] = a1[0]; ai[ct][2] = a1[1]; ar[ct][3] = a1[2]; ai[ct][3] = a1[3]; }
        const f32x4 gn = *(const f32x4*)(gain + 16 * g + 4 * fq), dk = *(const f32x4*)(dskip + 16 * g + 4 * fq);
        float xr[4][4], xi[4][4];
        const int bg = b * S5G + g, ch = 16 * q4 + fr;
        float* es = ES + ((size_t)bg * S5_NCH + ch) * 128 + 4 * fq;
#pragma unroll
        for (int ct = 0; ct < 4; ++ct) {
            if (PASS == 3) { const f32x4 r_ = *(const f32x4*)(es + 16 * ct), i_ = *(const f32x4*)(es + 64 + 16 * ct);
#pragma unroll
                for (int i = 0; i < 4; ++i) { xr[ct][i] = r_[i]; xi[ct][i] = i_[i]; } }
            else {
#pragma unroll
                for (int i = 0; i < 4; ++i) { xr[ct][i] = 0.f; xi[ct][i] = 0.f; } } }
        const size_t rowbase = (size_t)(tok0 + S5_LC * fr) * DM + 16 * g + 4 * fq;
        u32x2 nxt = *(const u32x2*)(xh + rowbase);
#pragma unroll 1
        for (int j = 0; j < S5_LC; ++j) {
            const u32x2 cur = nxt; if (j + 1 < S5_LC) nxt = *(const u32x2*)(xh + rowbase + (size_t)(j + 1) * DM);
            const float r = rtab[S5_LC * fr + j];
            const float u0 = bflo(cur.x) * r * gn[0], u1 = bfhi(cur.x) * r * gn[1], u2 = bflo(cur.y) * r * gn[2], u3 = bfhi(cur.y) * r * gn[3];
            const s16x4 ub = pack4(u0, u1, u2, u3);
#pragma unroll
            for (int ct = 0; ct < 4; ++ct) {
                const f32x4 z = {0.f, 0.f, 0.f, 0.f};
                const f32x4 br = MFMA16K16(bb[ct][0], ub, z), bi = MFMA16K16(bb[ct][1], ub, z);
#pragma unroll
                for (int i = 0; i < 4; ++i) { const float nr = br[i] + ar[ct][i] * xr[ct][i] - ai[ct][i] * xi[ct][i], ni = bi[i] + ar[ct][i] * xi[ct][i] + ai[ct][i] * xr[ct][i]; xr[ct][i] = nr; xi[ct][i] = ni; } }
            if (PASS == 3) {
                f32x4 y = {0.f, 0.f, 0.f, 0.f};
#pragma unroll
                for (int ct = 0; ct < 4; ++ct) { y = MFMA16K16(cc[ct][0], pack4(xr[ct][0], xr[ct][1], xr[ct][2], xr[ct][3]), y); y = MFMA16K16(cc[ct][1], pack4(xi[ct][0], xi[ct][1], xi[ct][2], xi[ct][3]), y); }
                u32x2 w; w.x = pk2(gelu_tanh(y[0] + dk[0] * u0), gelu_tanh(y[1] + dk[1] * u1)); w.y = pk2(gelu_tanh(y[2] + dk[2] * u2), gelu_tanh(y[3] + dk[3] * u3));
                *(u32x2*)(YB + rowbase + (size_t)j * DM) = w; }
        }
        if (PASS == 1) {
#pragma unroll
            for (int ct = 0; ct < 4; ++ct) { const f32x4 r_ = {xr[ct][0], xr[ct][1], xr[ct][2], xr[ct][3]}, i_ = {xi[ct][0], xi[ct][1], xi[ct][2], xi[ct][3]};
                *(f32x4*)(es + 16 * ct) = r_; *(f32x4*)(es + 64 + 16 * ct) = i_; } }
    }
}
DEV void s5_carry(float* ES, const unsigned char* ws, int gt, int NGT) {
    const float* AL = (const float*)(ws + S5T_AL);
    for (int idx = gt; idx < BATCH * S5G * S5P; idx += NGT) { const int bg = idx / S5P, k = idx % S5P, g = bg % S5G;
        const float alr = AL[((size_t)g * S5P + k) * 2], ali = AL[((size_t)g * S5P + k) * 2 + 1]; float sr = 0.f, si = 0.f;
        float* p = ES + (size_t)bg * S5_NCH * 128 + k;
        for (int c = 0; c < S5_NCH; ++c) { const float er = p[(size_t)c * 128], ei = p[(size_t)c * 128 + 64]; p[(size_t)c * 128] = sr; p[(size_t)c * 128 + 64] = si;
            const float nr = alr * sr - ali * si + er, ni = alr * si + ali * sr + ei; sr = nr; si = ni; } }
}

#ifndef HOST_EMU
#define LDS_BARRIER() do { asm volatile("s_waitcnt lgkmcnt(0)" ::: "memory"); __builtin_amdgcn_s_barrier(); asm volatile("" ::: "memory"); } while (0)
#else
#define LDS_BARRIER() __syncthreads()
#endif
constexpr int KTS = 264;
#ifndef HOST_EMU
#define FRAG_PIN() __builtin_amdgcn_sched_barrier(0)
#else
#define FRAG_PIN() do {} while (0)
#endif
#define TILE_MFMA16(acc, rowp, bfrag) do { _Pragma("unroll") for (int s4_ = 0; s4_ < 4; ++s4_) { bf16x8 fr_[4]; \
    _Pragma("unroll") for (int q_ = 0; q_ < 4; ++q_) fr_[q_] = *(const LAS bf16x8*)((rowp) + 16 * (4 * s4_ + q_)); FRAG_PIN(); \
    _Pragma("unroll") for (int q_ = 0; q_ < 4; ++q_) acc = MFMA32(fr_[q_], bfrag[4 * s4_ + q_], acc); FRAG_PIN(); } } while (0)
constexpr int RET_LDS = (2 * 32 + 64) * KTS * 2;
DEV void stage_tile_ld(const bf16* src, size_t ld, int tid, u32x4 (&rg)[2]) {
#pragma unroll
    for (int i = 0; i < 2; ++i) { const int q = tid + 512 * i, row = q >> 5, chk = q & 31; rg[i] = *(const u32x4*)((const char*)src + (size_t)(unsigned)((row * (int)ld + 8 * chk) * 2)); }
}
DEV void stage_tile_st(LAS bf16* dst, int tid, const u32x4 (&rg)[2]) {
#pragma unroll
    for (int i = 0; i < 2; ++i) { const int q = tid + 512 * i, row = q >> 5, chk = q & 31; *(LAS u32x4*)(dst + row * KTS + 8 * chk) = rg[i]; }
}
#define RET_STAGE_LD(...) do { if (!(SKIP & 16)) stage_tile_ld(__VA_ARGS__); } while (0)
template <int SKIP = 0>
DEV void ret_core(const bf16* Q, const bf16* K, const bf16* VT, bf16* O, float* STAT, LAS unsigned char* lds, int vcu, int G, int tid) {
    const int w = tid >> 6, lane = tid & 63, c = lane & 31, hh = lane >> 5;
    LAS bf16* KT0 = (LAS bf16*)lds; LAS bf16* KT1 = KT0 + 32 * KTS; LAS bf16* SB = KT1 + 32 * KTS;
    constexpr int NT = BATCH * RH * 8, NMC = SEQ / RMC;
    bf16x8 idf[2];
#pragma unroll
    for (int sg = 0; sg < 2; ++sg)
#pragma unroll
        for (int e = 0; e < 8; ++e) idf[sg][e] = (16 * sg + 8 * hh + e == c) ? (short)0x3F80 : (short)0;
    for (int tsk = vcu; tsk < NT; tsk += G) {
        const int b = tsk >> 5, h = (tsk >> 3) & 3, vs = tsk & 7;
        const float lg = log2f(1.0f - exp2f(-5.0f - (float)h)), g256 = exp2f(lg * (float)RMC);
        f32x16 sacc[2];
#pragma unroll
        for (int vt = 0; vt < 2; ++vt)
#pragma unroll
            for (int r = 0; r < 16; ++r) sacc[vt][r] = 0.f;
        LDS_BARRIER();
        for (int i = tid; i < 64 * KTS / 2; i += 512) ((LAS unsigned*)SB)[i] = 0u;
        LDS_BARRIER();
        const unsigned vtoff = (unsigned)(((RDV * h + 64 * vs + c) * M + 8 * hh) * 2);
        bf16x8 qf[16];
        { const bf16* qrow = Q + (size_t)(b * SEQ + 32 * w + c) * DM + 256 * h + 8 * hh;
#pragma unroll
          for (int s = 0; s < 16; ++s) qf[s] = (SKIP & 32) ? idf[s & 1] : *(const bf16x8*)(qrow + 16 * s); }
        for (int mc = 0; mc < NMC; ++mc) {
            const int T0 = b * SEQ + RMC * mc;
            const bf16* ksrc = K + (size_t)T0 * DM + 256 * h;
            u32x4 rg0[2], rg1[2];
            RET_STAGE_LD(ksrc, DM, tid, rg0);
            f32x16 oacc[2];
#pragma unroll
            for (int vt = 0; vt < 2; ++vt) {
#pragma unroll
                for (int r = 0; r < 16; ++r) oacc[vt][r] = 0.f;
#pragma unroll
                for (int s = 0; s < 16; ++s) if (!(SKIP & 4)) oacc[vt] = MFMA32(*(const LAS bf16x8*)(SB + (32 * vt + c) * KTS + 16 * s + 8 * hh), qf[s], oacc[vt]);
#pragma unroll
                for (int r = 0; r < 16; ++r) { oacc[vt][r] *= g256; sacc[vt][r] *= g256; } }
            stage_tile_st(KT0, tid, rg0);
            RET_STAGE_LD(ksrc + (size_t)32 * DM, DM, tid, rg1);
            LDS_BARRIER();
#pragma unroll
            for (int jt = 0; jt < 8; ++jt) {
                LAS bf16* cur = (jt & 1) ? KT1 : KT0; LAS bf16* nx = (jt & 1) ? KT0 : KT1;
                bf16x8 vf[2][2];
#pragma unroll
                for (int vt = 0; vt < 2; ++vt)
#pragma unroll
                    for (int s2 = 0; s2 < 2; ++s2) vf[vt][s2] = (SKIP & 8) ? idf[s2] : *(const bf16x8*)((const char*)VT + (size_t)(vtoff + (unsigned)(((32 * vt) * M + T0 + 32 * jt + 16 * s2) * 2)));
                FRAG_PIN();
                if (jt < 6) { if (jt & 1) RET_STAGE_LD(ksrc + (size_t)(32 * (jt + 2)) * DM, DM, tid, rg1); else RET_STAGE_LD(ksrc + (size_t)(32 * (jt + 2)) * DM, DM, tid, rg0); }
                FRAG_PIN();
                if (!(SKIP & 1) && w >= jt) {
                    f32x16 X;
#pragma unroll
                    for (int r = 0; r < 16; ++r) X[r] = 0.f;
                    TILE_MFMA16(X, cur + c * KTS + 8 * hh, qf);
                    if (w == jt) {
#pragma unroll
                        for (int r = 0; r < 16; ++r) if (rowmap32(r, hh) > c) X[r] = 0.f; }
#pragma unroll
                    for (int s2 = 0; s2 < 2; ++s2) { const bf16x8 pf = pack8(X[8 * s2], X[8 * s2 + 1], X[8 * s2 + 2], X[8 * s2 + 3], X[8 * s2 + 4], X[8 * s2 + 5], X[8 * s2 + 6], X[8 * s2 + 7]);
#pragma unroll
                        for (int vt = 0; vt < 2; ++vt) oacc[vt] = MFMA32(vf[vt][s2], pf, oacc[vt]); }
                }
                if (jt == 7 && mc + 1 < NMC) { const bf16* qrow = Q + (size_t)(T0 + RMC + 32 * w + c) * DM + 256 * h + 8 * hh;
#pragma unroll
                    for (int s = 0; s < 16; ++s) qf[s] = (SKIP & 32) ? idf[s & 1] : *(const bf16x8*)(qrow + 16 * s); }
                if (!(SKIP & 2)) {
                    f32x16 Xk;
#pragma unroll
                    for (int r = 0; r < 16; ++r) Xk[r] = 0.f;
                    Xk = MFMA32(*(const LAS bf16x8*)(cur + c * KTS + 32 * w + 8 * hh), idf[0], Xk);
                    Xk = MFMA32(*(const LAS bf16x8*)(cur + c * KTS + 32 * w + 16 + 8 * hh), idf[1], Xk);
#pragma unroll
                    for (int s2 = 0; s2 < 2; ++s2) { const bf16x8 kf = pack8(Xk[8 * s2], Xk[8 * s2 + 1], Xk[8 * s2 + 2], Xk[8 * s2 + 3], Xk[8 * s2 + 4], Xk[8 * s2 + 5], Xk[8 * s2 + 6], Xk[8 * s2 + 7]);
#pragma unroll
                        for (int vt = 0; vt < 2; ++vt) sacc[vt] = MFMA32(kf, vf[vt][s2], sacc[vt]); }
                }
                if (jt < 7) { if (jt & 1) stage_tile_st(nx, tid, rg0); else stage_tile_st(nx, tid, rg1); }
                LDS_BARRIER();
            }
            float s1 = 0.f, s2_ = 0.f;
            bf16* orow = O + (size_t)(T0 + 32 * w + c) * RVW + RDV * h + 64 * vs + 8 * hh;
#pragma unroll
            for (int vt = 0; vt < 2; ++vt)
#pragma unroll
                for (int pr = 0; pr < 2; ++pr) { u32x2 g[2];
#pragma unroll
                    for (int k = 0; k < 2; ++k) { const int q = 2 * pr + k; const float a0 = oacc[vt][4 * q], a1 = oacc[vt][4 * q + 1], a2 = oacc[vt][4 * q + 2], a3 = oacc[vt][4 * q + 3];
                        s1 += (a0 + a1) + (a2 + a3); s2_ += (a0 * a0 + a1 * a1) + (a2 * a2 + a3 * a3); g[k].x = pk2(a0, a1); g[k].y = pk2(a2, a3); }
                    *(u32x4*)(orow + 32 * vt + 16 * pr) = widen_pair(g[0], g[1]); }
            s1 += __shfl_xor(s1, 32); s2_ += __shfl_xor(s2_, 32);
            if (hh == 0) { f32x2 sv; sv[0] = s1; sv[1] = s2_; *(f32x2*)(STAT + ((size_t)(T0 + 32 * w + c) * RH + h) * 16 + 2 * vs) = sv; }
#pragma unroll
            for (int vt = 0; vt < 2; ++vt)
#pragma unroll
                for (int q = 0; q < 4; ++q) { u32x2 wv; wv.x = pk2(sacc[vt][4 * q], sacc[vt][4 * q + 1]); wv.y = pk2(sacc[vt][4 * q + 2], sacc[vt][4 * q + 3]);
                    *(LAS u32x2*)(SB + (32 * vt + c) * KTS + 32 * w + 8 * q + 4 * hh) = wv; }
            LDS_BARRIER();
        }
    }
}

#undef RET_STAGE_LD
struct DiagOrder {
    int nblk, G, c;
    DEV bool next(int i, pg8::Unit& u) const { const int k = i * G + c; if (k >= nblk) return false; u.pm = k; u.pn = k; return true; }
    DEV void a_ready(const pg8::Unit&) const {}
    DEV void done(const pg8::Unit&) const {}
};

DEV void stage_pair_ld(const bf16* src, size_t ld, int tid, u32x4 (&rg)[4]) {
#pragma unroll
    for (int i = 0; i < 4; ++i) { const int q = tid + 512 * i, row = q >> 5, chk = q & 31; rg[i] = *(const u32x4*)((const char*)src + (size_t)(unsigned)((row * (int)ld + 8 * chk) * 2)); }
}
DEV void stage_pair_st(LAS bf16* dst, int tid, const u32x4 (&rg)[4]) {
#pragma unroll
    for (int i = 0; i < 4; ++i) { const int q = tid + 512 * i, row = q >> 5, chk = q & 31; *(LAS u32x4*)(dst + row * KTS + 8 * chk) = rg[i]; }
}
DEV void xattn_core(const bf16* QX, const bf16* XK, const bf16* XVT, bf16* OX, LAS unsigned char* lds, int vcu, int G, int tid) {
    const int w = tid >> 6, lane = tid & 63, c = lane & 31, hh = lane >> 5;
    LAS bf16* T0_ = (LAS bf16*)lds; LAS bf16* T1_ = T0_ + 64 * KTS;
    constexpr int NQB = SEQ / 256, NU = BATCH * XH * NQB;
    for (int un = vcu; un < NU; un += G) {
        const int qb = un % NQB, bh = un / NQB, h = bh & 3, b = bh >> 2;
        const size_t R0 = (size_t)b * SEQ + 256 * qb + 32 * w + c;
        const bf16* ksrc = XK + (size_t)(b * NMEM) * DM + 256 * h;
        const bf16* vsrc = XVT + (size_t)(256 * h) * MMEM + b * NMEM;
#define XA_LD(p, rg) do { if ((p) < 4) stage_pair_ld(ksrc + (size_t)(64 * (p)) * DM, DM, tid, rg); else stage_pair_ld(vsrc + (size_t)(64 * ((p) - 4)) * MMEM, MMEM, tid, rg); } while (0)
        u32x4 rg0[4];
        f32x16 st[8];
        XA_LD(0, rg0);
        bf16x8 qf[16];
#pragma unroll
        for (int s = 0; s < 16; ++s) qf[s] = *(const bf16x8*)(QX + R0 * DM + 256 * h + 16 * s + 8 * hh);
        LDS_BARRIER();
        stage_pair_st(T0_, tid, rg0);
        LDS_BARRIER();
#pragma unroll
        for (int kp = 0; kp < 4; ++kp) {
            LAS bf16* cur = (kp & 1) ? T1_ : T0_; LAS bf16* nx = (kp & 1) ? T0_ : T1_;
            XA_LD(kp + 1, rg0);
#pragma unroll
            for (int t2 = 0; t2 < 2; ++t2) {
#pragma unroll
                for (int r = 0; r < 16; ++r) st[2 * kp + t2][r] = 0.f;
                TILE_MFMA16(st[2 * kp + t2], cur + (32 * t2 + c) * KTS + 8 * hh, qf); }
            stage_pair_st(nx, tid, rg0);
            LDS_BARRIER();
        }
        float mx = st[0][0];
#pragma unroll
        for (int kt = 0; kt < 8; ++kt)
#pragma unroll
            for (int r = 0; r < 16; ++r) mx = fmaxf(mx, st[kt][r]);
        mx = fmaxf(mx, __shfl_xor(mx, 32));
        const float c2 = 1.4426950408889634f * 0.0625f, mc2 = -mx * c2; float l = 0.f;
        bf16x8 pf[16];
#pragma unroll
        for (int kt = 0; kt < 8; ++kt) {
#pragma unroll
            for (int r = 0; r < 16; ++r) { const float p = fexp2(st[kt][r] * c2 + mc2); st[kt][r] = p; l += p; }
#pragma unroll
            for (int s2 = 0; s2 < 2; ++s2) pf[2 * kt + s2] = pack8(st[kt][8 * s2], st[kt][8 * s2 + 1], st[kt][8 * s2 + 2], st[kt][8 * s2 + 3], st[kt][8 * s2 + 4], st[kt][8 * s2 + 5], st[kt][8 * s2 + 6], st[kt][8 * s2 + 7]); }
        l += __shfl_xor(l, 32);
        const float il = 1.0f / l;
        bf16* orow = OX + R0 * DM + 256 * h + 8 * hh;
#pragma unroll
        for (int dp = 0; dp < 4; ++dp) {
            LAS bf16* cur = (dp & 1) ? T1_ : T0_; LAS bf16* nx = (dp & 1) ? T0_ : T1_;
            if (dp < 3) XA_LD(dp + 5, rg0);
#pragma unroll
            for (int t2 = 0; t2 < 2; ++t2) { const int dt = 2 * dp + t2;
                f32x16 ot;
#pragma unroll
                for (int r = 0; r < 16; ++r) ot[r] = 0.f;
                TILE_MFMA16(ot, cur + (32 * t2 + c) * KTS + 8 * hh, pf);
#pragma unroll
                for (int pr = 0; pr < 2; ++pr) { u32x2 g0, g1; g0.x = pk2(ot[8 * pr] * il, ot[8 * pr + 1] * il); g0.y = pk2(ot[8 * pr + 2] * il, ot[8 * pr + 3] * il); g1.x = pk2(ot[8 * pr + 4] * il, ot[8 * pr + 5] * il); g1.y = pk2(ot[8 * pr + 6] * il, ot[8 * pr + 7] * il);
                    *(u32x4*)(orow + 32 * dt + 16 * pr) = widen_pair(g0, g1); } }
            if (dp < 3) stage_pair_st(nx, tid, rg0);
            LDS_BARRIER();
        }
#undef XA_LD
    }
}
#ifndef HOST_EMU
#define RLX_AGENT __ATOMIC_RELAXED, __HIP_MEMORY_SCOPE_AGENT
#define XB_TMO      128
#define XB_XCNT(j)  (256  + 64 * (j))
#define XB_XSUB(j)  (1280 + 64 * (j))
#define XB_XGEN(j)  (2304 + 64 * (j))
#define XB_TOP      3328
#define XB_TOPGEN   3392
#define XCD_BAR_WORDS 3456
#define XB_SPIN_CAP (1u << 18)

__device__ __forceinline__ unsigned xb_ld(unsigned* p)              { return __hip_atomic_load(p, __ATOMIC_RELAXED, __HIP_MEMORY_SCOPE_AGENT); }
__device__ __forceinline__ unsigned xb_add(unsigned* p, unsigned v) { return __hip_atomic_fetch_add(p, v, __ATOMIC_RELAXED, __HIP_MEMORY_SCOPE_AGENT); }
__device__ __forceinline__ unsigned xb_xcc_id() { return (unsigned)__builtin_amdgcn_s_getreg((3 << 11) | 20) & 0xFu; }
#define XB_SPIN(cond, bar) do { unsigned _sp = 0; while (cond) { __builtin_amdgcn_s_sleep(1); \
    if ((++_sp & 255u) == 0u) { if (xb_ld(&(bar)[XB_TMO])) break; if (_sp > XB_SPIN_CAP) { atomicAdd(&(bar)[XB_TMO], 1u); break; } } } } while (0)

struct XcdBarrier {
    unsigned* bar; unsigned x;
    volatile LAS unsigned* st;
};

__device__ __forceinline__ XcdBarrier xcd_barrier_post(unsigned* bar, volatile LAS unsigned* st) {
    XcdBarrier b; b.bar = bar; b.x = xb_xcc_id(); b.st = st;
    if (threadIdx.x == 0) (void)xb_add(&bar[XB_XCNT(b.x)], 1u);
    return b;
}
__device__ __forceinline__ void xcd_barrier_complete(unsigned* bar, unsigned x, unsigned& nloc, unsigned& nx) {
    const unsigned G = gridDim.x * gridDim.y * gridDim.z;
    unsigned sum, cnt, mine, sp = 0u;
    for (;;) {
        sum = 0u; cnt = 0u; mine = 0u;
#pragma unroll
        for (unsigned j = 0; j < 16; ++j) { const unsigned c = xb_ld(&bar[XB_XCNT(j)]); sum += c; cnt += (c > 0u) ? 1u : 0u; mine = (j == x) ? c : mine; }
        if (sum == G) break;
        __builtin_amdgcn_s_sleep(1);
        if ((++sp & 255u) == 0u) { if (xb_ld(&bar[XB_TMO])) break; if (sp > XB_SPIN_CAP) { atomicAdd(&bar[XB_TMO], 1u); break; } }
    }
    nloc = mine > 0u ? mine : 1u; nx = cnt > 0u ? cnt : 1u;
}

__device__ __forceinline__ void xcd_barrier(const XcdBarrier& b) {
    asm volatile("s_waitcnt vmcnt(0)" ::: "memory");
    __syncthreads();
    if (threadIdx.x == 0) {
        unsigned* bar = b.bar;
        __builtin_amdgcn_s_waitcnt(0);
        unsigned nloc = b.st[0], nx = b.st[1];
        if (nloc == 0u) { xcd_barrier_complete(bar, b.x, nloc, nx); b.st[0] = nloc; b.st[1] = nx; }
        const unsigned old = xb_add(&bar[XB_XSUB(b.x)], 1u);
        const unsigned gen = old / nloc;
        if (old + 1u == (gen + 1u) * nloc) {
            __builtin_amdgcn_fence(__ATOMIC_RELEASE, "agent");
            asm volatile("s_waitcnt vmcnt(0)" ::: "memory");
            const unsigned og = xb_add(&bar[XB_TOP], 1u);
            const unsigned tg = og / nx;
            if (og + 1u == (tg + 1u) * nx) xb_add(&bar[XB_TOPGEN], 1u);
            else XB_SPIN(xb_ld(&bar[XB_TOPGEN]) == tg, bar);
            __builtin_amdgcn_fence(__ATOMIC_ACQUIRE, "agent");
            xb_add(&bar[XB_XGEN(b.x)], 1u);
            asm volatile("s_waitcnt vmcnt(0)" ::: "memory");
        } else {
            XB_SPIN(xb_ld(&bar[XB_XGEN(b.x)]) == gen, bar);
            __builtin_amdgcn_fence(__ATOMIC_ACQUIRE, "agent");
            asm volatile("s_waitcnt vmcnt(0)" ::: "memory");
        }
    }
    __syncthreads();
}
#endif
#ifndef HOST_EMU
constexpr int NWAVES = 8;
constexpr int RING_BYTES = 131072, LDSCTL_OFF = RING_BYTES, MISC_OFF = LDSCTL_OFF + 320, LDS_BYTES = 147456;
constexpr int PTAB_OFF = LDSCTL_OFF + 1024;
constexpr int CW_BAR = 4096;
#ifndef MK_PER_PHASE
#define MK_PER_PHASE 0
#endif
constexpr int PH_PER_LAYER = 12, PH_FINAL = 1 + PH_PER_LAYER * DEPTH, N_PHASES = PH_FINAL + 1;
static_assert(RET_LDS <= RING_BYTES, "lds");

DEV volatile LAS unsigned long long* ptab_base(LAS unsigned char* lds) { unsigned o = PTAB_OFF; asm volatile("" : "+v"(o)); return (volatile LAS unsigned long long*)(lds + o); }
DEV unsigned long long ldptr(volatile LAS unsigned long long* pt, int k) { const unsigned long long v = pt[k];
    const unsigned lo = __builtin_amdgcn_readfirstlane((unsigned)v), hi = __builtin_amdgcn_readfirstlane((unsigned)(v >> 32)); return ((unsigned long long)hi << 32) | lo; }
#ifndef KB_REP
#define KB_REP 0
#endif
#define REPS(k) (1 + ((KB_REP >> (k)) & 1))
#ifndef KB_FFN_SPLIT
#define KB_FFN_SPLIT 1
#endif
#ifndef KB_FFN_MERGE
#define KB_FFN_MERGE 0
#endif
#define FFN_NBLK (KB_FFN_MERGE ? 2 : KB_FFN_SPLIT)
#ifndef KB_STAGGER
#define KB_STAGGER 0
#endif
#ifndef KB_RSTAG
#define KB_RSTAG 0
#endif
#define RSTAG() do { if (KB_RSTAG) { if ((LG(bx) >> 3) & 1) { for (int i_ = 0; i_ < KB_RSTAG; ++i_) __builtin_amdgcn_s_sleep(127); } } } while (0)
#ifndef KB_PHMASK1
#define KB_PHMASK1 0xFFF
#endif
#ifndef KB_FINAL_SS
#define KB_FINAL_SS 0
#endif
#ifndef KB_LAYERS
#define KB_LAYERS 4
#endif
#ifndef KB_PHMASK
#define KB_PHMASK 0xFFF
#endif
DEV bool ph_enabled(int k) { if (k == 0 || k >= 1 + PH_PER_LAYER * DEPTH) return true; const int L = (k - 1) / PH_PER_LAYER, s = (k - 1) % PH_PER_LAYER; return L < KB_LAYERS && ((((L & 1) ? KB_PHMASK1 : KB_PHMASK) >> s) & 1); }
DEV int lane_id_fresh() { unsigned m = ~0u; asm volatile("" : "+s"(m)); return (int)__builtin_amdgcn_mbcnt_hi(m, __builtin_amdgcn_mbcnt_lo(m, 0u)); }
DEV XcdBarrier mk_bar(unsigned* p, volatile LAS unsigned* st) { XcdBarrier b; b.bar = p; b.x = xb_xcc_id(); b.st = st; return b; }
struct Args { const void* in[24]; float* out; unsigned char* ws; int ph_lo, ph_hi, li, pad; };

__global__ void __launch_bounds__(NWAVES * 64, 2) hybrid_fwd(Args args) {
    extern __shared__ __attribute__((aligned(16))) unsigned char lds_raw[];
    LAS unsigned char* lds = (LAS unsigned char*)lds_raw;
    volatile LAS unsigned* MISC = (volatile LAS unsigned*)(lds + MISC_OFF);
    const int tid0 = threadIdx.x; const int wave0 = __builtin_amdgcn_readfirstlane(tid0 >> 6);
    const int G = gridDim.x, bx = blockIdx.x, vcu = (G % 8 == 0) ? (bx % 8) * (G / 8) + bx / 8 : bx;
    const int NGW = G * NWAVES, NGT = G * NWAVES * 64;
#define LG(v) ({ int v_ = (v); asm volatile("" : "+s"(v_)); v_; })
#define PH_IDS int tid = LG(wave0) * 64 + lane_id_fresh(); asm volatile("" : "+v"(tid)); const int lane = tid & 63, wave = __builtin_amdgcn_readfirstlane(tid >> 6), gw = LG(vcu) * NWAVES + wave, gt = LG(vcu) * (NWAVES * 64) + tid; (void)lane; (void)gw; (void)gt;
    for (int u = tid0; u < (LDS_BYTES - LDSCTL_OFF) / 4; u += NWAVES * 64) ((LAS unsigned*)(lds + LDSCTL_OFF))[u] = 0u;
    __syncthreads();
    volatile LAS unsigned long long* PT = (volatile LAS unsigned long long*)(lds + PTAB_OFF);
    if (tid0 < 24) PT[tid0] = (unsigned long long)args.in[tid0];
    if (tid0 == 24) PT[24] = (unsigned long long)args.out;
    if (tid0 == 25) PT[25] = (unsigned long long)args.ws;
    __syncthreads();
#define PTR(k) ((const void*)(GAS const void*)ldptr(ptab_base(lds), (k)))
    (void)xcd_barrier_post((unsigned*)(args.ws + WS_CTL) + CW_BAR + args.li * XCD_BAR_WORDS, MISC + 8);
    const int li_ = args.li;
#define bar mk_bar((unsigned*)((unsigned char*)PTR(25) + WS_CTL) + CW_BAR + LG(li_) * XCD_BAR_WORDS, (volatile LAS unsigned*)(lds + MISC_OFF) + 8)
    const int lo = args.ph_lo, hi = args.ph_hi;
#if MK_PER_PHASE || defined(KB_DEBUG)
#define RUN(k) (lo <= (k) && (k) < hi && ph_enabled(k))
#define SEAM(k) do { if (RUN(k) && RUN((k) + 1)) xcd_barrier(bar); } while (0)
#else
#define RUN(k) true
#define SEAM(k) xcd_barrier(bar)
#endif
#define WSP ((unsigned char*)PTR(25))
#define OUTP ((float*)PTR(24))
#define INF(k) ((const float*)PTR(k))
    LAS unsigned char* ring = lds;

    for (int rep_ = 0; rep_ < REPS(11); ++rep_) { if (rep_) xcd_barrier(bar);
    if (RUN(0)) { PH_IDS unsigned char* ws = WSP; ssq_t* SS0 = (ssq_t*)(ws + WS_SSQ);
        rot_table((float*)(ws + WS_ROT), gt, NGT);
        for (int j = 0; j < DEPTH / 2; ++j) s5_tables(INF(10) + (size_t)j * S5G * S5P, INF(11) + (size_t)j * S5G * S5P, INF(12) + (size_t)j * S5G, INF(13) + (size_t)j * S5G * S5P * S5H, INF(14) + (size_t)j * S5G * S5P * S5H,
                                                      INF(15) + (size_t)j * S5G * S5H * S5P, INF(16) + (size_t)j * S5G * S5H * S5P, ws + (size_t)j * S5T_STRIDE, gt, NGT); memn_rows(INF(1), INF(4), (bf16*)(ws + WS_MEMN), (bf16*)(ws + WS_MEMNP), gw, NGW, lane); x0_rows(INF(0), (bf16*)(ws + WS_XHAT), SS0, SS0 + M, gw, NGW, lane); }
    }
    for (int L = 0; L < DEPTH; ++L) {
        const int pb = 1 + PH_PER_LAYER * L; const bool isret = (L & 1) != 0; const int j = L >> 1;
for (int rep_ = 0; rep_ < REPS(0); ++rep_) { if (rep_) xcd_barrier(bar);
        if (RUN(pb + 0)) { PH_IDS unsigned char* ws = WSP;
            LayerW lw;
            lw.g = INF(3) + (size_t)L * 4 * DM;
            lw.f1in = INF(6) + (size_t)L * DM * 2 * DFF; lw.f1out = INF(7) + (size_t)L * DFF * DM;
            lw.f2in = INF(8) + (size_t)L * DM * 2 * DFF; lw.f2out = INF(9) + (size_t)L * DFF * DM;
            lw.mixin = isret ? INF(19) + (size_t)j * DM * RIN : INF(18) + (size_t)j * DM * 2 * DM;
            lw.mixout = isret ? INF(20) + (size_t)j * RVW * DM : nullptr;
            lw.xq = INF(21) + (size_t)L * DM * DM; lw.xkv = INF(22) + (size_t)L * DM * 2 * DM; lw.xkv2 = INF(22) + (size_t)(L + 1 < DEPTH ? L + 1 : L) * DM * 2 * DM; lw.xo = INF(23) + (size_t)L * DM * DM;
            lw.is_ret = isret ? 1 : 0;
            convert_layer(lw, ws, (LAS float*)(ring + wave * 16384), gw, NGW, lane);
        }
}
        SEAM(pb + 0);
for (int rep_ = 0; rep_ < REPS(1); ++rep_) { if (rep_) xcd_barrier(bar);
        if (RUN(pb + 1)) { unsigned char* ws = WSP; ssq_t* SS0 = (ssq_t*)(ws + WS_SSQ);
#if KB_FFN_MERGE
            { pg8::Gemm g{(const bf16*)(ws + WS_XHAT), (const bf16*)(ws + W_F1IN), M / 2, 2 * DFF, DM}; pg8::StaticOrder S; S.init(M / 2, 2 * DFF, LG(G), LG(bx)); EpiSwiGLU E{(bf16*)(ws + BIG_H), SS0};
              pg8::gemm_phase<EpiSwiGLU, pg8::StaticOrder, true, true>(ring, g, S, E, LG(wave0)); }
            xcd_barrier(bar);
            { const int par_ = (LG(bx) >> 3) & 1; const size_t r1 = (size_t)(M / 2);
              for (int i_ = 0; i_ < 2; ++i_) {
                if ((i_ ^ par_) == 0) { pg8::Gemm g{(const bf16*)(ws + BIG_H), (const bf16*)(ws + W_F1OUT), M / 2, DM, DFF}; pg8::StaticOrder S; S.init(M / 2, DM, LG(G), LG(bx)); EpiResid E{(bf16*)(ws + WS_XHAT), (SS0 + M), SS0, 0.5f};
                    pg8::gemm_phase<EpiResid, pg8::StaticOrder, true, true>(ring, g, S, E, LG(wave0)); }
                else { pg8::Gemm g{(const bf16*)(ws + WS_XHAT) + r1 * DM, (const bf16*)(ws + W_F1IN), M / 2, 2 * DFF, DM}; pg8::StaticOrder S; S.init(M / 2, 2 * DFF, LG(G), LG(bx)); EpiSwiGLU E{(bf16*)(ws + BIG_H) + r1 * DFF, SS0 + r1};
                    pg8::gemm_phase<EpiSwiGLU, pg8::StaticOrder, true, true>(ring, g, S, E, LG(wave0)); } } }
#else
            for (int hb = 0; hb < KB_FFN_SPLIT; ++hb) { const size_t r0 = (size_t)hb * (M / KB_FFN_SPLIT);
                { pg8::Gemm g{(const bf16*)(ws + WS_XHAT) + r0 * DM, (const bf16*)(ws + W_F1IN), M / KB_FFN_SPLIT, 2 * DFF, DM}; pg8::StaticOrder S; S.init(M / KB_FFN_SPLIT, 2 * DFF, LG(G), LG(bx)); EpiSwiGLU E{(bf16*)(ws + BIG_H) + r0 * DFF, SS0 + r0};
                  pg8::gemm_phase<EpiSwiGLU, pg8::StaticOrder, true, true>(ring, g, S, E, LG(wave0)); }
                if (hb + 1 < KB_FFN_SPLIT) { xcd_barrier(bar);
                    pg8::Gemm g{(const bf16*)(ws + BIG_H) + r0 * DFF, (const bf16*)(ws + W_F1OUT), M / KB_FFN_SPLIT, DM, DFF}; pg8::StaticOrder S; S.init(M / KB_FFN_SPLIT, DM, LG(G), LG(bx)); EpiResid E{(bf16*)(ws + WS_XHAT) + r0 * DM, (SS0 + M) + r0, SS0 + r0, 0.5f};
                    pg8::gemm_phase<EpiResid, pg8::StaticOrder, true, true>(ring, g, S, E, LG(wave0)); xcd_barrier(bar); } }
#endif
        }
}
        SEAM(pb + 1);
        if (RUN(pb + 2)) { unsigned char* ws = WSP; ssq_t* SS0 = (ssq_t*)(ws + WS_SSQ); const size_t r0 = (size_t)(FFN_NBLK - 1) * (M / FFN_NBLK);
            pg8::Gemm g{(const bf16*)(ws + BIG_H) + r0 * DFF, (const bf16*)(ws + W_F1OUT), M / FFN_NBLK, DM, DFF}; pg8::StaticOrder S; S.init(M / FFN_NBLK, DM, LG(G), LG(bx)); EpiResid E{(bf16*)(ws + WS_XHAT) + r0 * DM, (SS0 + M) + r0, SS0 + r0, 0.5f};
            pg8::gemm_phase<EpiResid, pg8::StaticOrder, true, true>(ring, g, S, E, LG(wave0)); }
        SEAM(pb + 2);
        if ((KB_REP >> 8) & 1) { unsigned char* ws = WSP; pg8::Gemm g{(const bf16*)(ws + WS_XHAT), (const bf16*)(ws + W_F1IN), M, 2 * DFF, DM}; pg8::StaticOrder S; S.init(M, 2 * DFF, LG(G), LG(bx)); EpiNull E{};
            pg8::gemm_phase<EpiNull, pg8::StaticOrder, true, true>(ring, g, S, E, LG(wave0)); xcd_barrier(bar); }
        if ((KB_REP >> 9) & 1) { unsigned char* ws = WSP; pg8::Gemm g{(const bf16*)(ws + BIG_H), (const bf16*)(ws + W_F1OUT), M, DM, DFF}; pg8::StaticOrder S; S.init(M, DM, LG(G), LG(bx)); EpiNull E{};
            pg8::gemm_phase<EpiNull, pg8::StaticOrder, true, true>(ring, g, S, E, LG(wave0)); xcd_barrier(bar); }
        if ((KB_REP >> 10) & 1) { unsigned char* ws = WSP; pg8::Gemm g{(const bf16*)(ws + BIG_H), (const bf16*)(ws + W_F1OUT), M, DM, DFF}; pg8::StaticOrder S; S.init(M, DM, LG(G), LG(bx));
            EpiResid E{(bf16*)(ws + WS_BIG + 384 * MiB), (ssq_t*)(ws + WS_BIG + 770 * MiB), (ssq_t*)(ws + WS_BIG + 771 * MiB), 0.5f};
            pg8::gemm_phase<EpiResid, pg8::StaticOrder, true, true>(ring, g, S, E, LG(wave0)); xcd_barrier(bar); }
        if (!isret) {
for (int rep_ = 0; rep_ < REPS(2); ++rep_) { if (rep_) xcd_barrier(bar);
            if (RUN(pb + 3)) { PH_IDS unsigned char* ws = WSP; s5_pass<1>((const bf16*)(ws + WS_XHAT), (const ssq_t*)(ws + WS_SSQ) + M, INF(3) + ((size_t)L * 4 + 1) * DM, INF(17) + (size_t)j * DM, ws + (size_t)j * S5T_STRIDE, (float*)(ws + BIG_ES), (bf16*)(ws + BIG_YB), ring, LG(vcu), LG(G), tid); }
            SEAM(pb + 3);
            if (RUN(pb + 4)) { PH_IDS unsigned char* ws = WSP; s5_carry((float*)(ws + BIG_ES), ws + (size_t)j * S5T_STRIDE, gt, NGT);
                for (int set = 0; set < 2; ++set) {
                    { pg8::Gemm g{(const bf16*)(ws + WS_MEMN), (const bf16*)(ws + W_XK + set * W_XKV_SET), MMEM, DM, DM}; pg8::StaticOrder S; S.init(MMEM, DM, LG(G), (LG(bx) + (2 * set) * (LG(G) / 4)) % LG(G)); EpiBf16<0> E{(bf16*)(ws + WS_XK + set * XKV_SET), DM, nullptr};
                      pg8::gemm_phase<EpiBf16<0>, pg8::StaticOrder, true, true>(ring, g, S, E, LG(wave0)); }
                    { pg8::Gemm g{(const bf16*)(ws + W_XV + set * W_XKV_SET), (const bf16*)(ws + WS_MEMNP), DM, MMEM, DM}; pg8::StaticOrder S; S.init(DM, MMEM, LG(G), (LG(bx) + (2 * set + 1) * (LG(G) / 4)) % LG(G)); EpiBf16<0> E{(bf16*)(ws + WS_XVT + set * XKV_SET), MMEM, nullptr};
                      pg8::gemm_phase<EpiBf16<0>, pg8::StaticOrder, true, true>(ring, g, S, E, LG(wave0)); } } }
            SEAM(pb + 4);
            if (RUN(pb + 5)) { PH_IDS unsigned char* ws = WSP; s5_pass<3>((const bf16*)(ws + WS_XHAT), (const ssq_t*)(ws + WS_SSQ) + M, INF(3) + ((size_t)L * 4 + 1) * DM, INF(17) + (size_t)j * DM, ws + (size_t)j * S5T_STRIDE, (float*)(ws + BIG_ES), (bf16*)(ws + BIG_YB), ring, LG(vcu), LG(G), tid); }
}
            SEAM(pb + 5);
            if (RUN(pb + 6)) { unsigned char* ws = WSP; ssq_t* SS0 = (ssq_t*)(ws + WS_SSQ);
                RSTAG(); pg8::Gemm g{(const bf16*)(ws + BIG_YB), (const bf16*)(ws + W_MIX), M, 2 * DM, DM}; pg8::StaticOrder S; S.init(M, 2 * DM, LG(G), LG(bx)); EpiS5Glu E{(bf16*)(ws + WS_XHAT), SS0, SS0 + M};
                pg8::gemm_phase<EpiS5Glu, pg8::StaticOrder, true, true>(ring, g, S, E, LG(wave0)); }
            SEAM(pb + 6);
        } else {
for (int rep_ = 0; rep_ < REPS(3); ++rep_) { if (rep_) xcd_barrier(bar);
            if (RUN(pb + 3)) { unsigned char* ws = WSP;
                { pg8::Gemm g{(const bf16*)(ws + WS_XHAT), (const bf16*)(ws + W_MIX), M, 2 * DM, DM}; pg8::StaticOrder S; S.init(M, 2 * DM, LG(G), LG(bx));
                  EpiRetIn E{(bf16*)(ws + BIG_RQ), (bf16*)(ws + BIG_RK), (const ssq_t*)(ws + WS_SSQ) + M, (const float*)(ws + WS_ROT), (const int*)PTR(2)};
                  pg8::gemm_phase<EpiRetIn, pg8::StaticOrder, true, true>(ring, g, S, E, LG(wave0)); }
                { pg8::Gemm g{(const bf16*)(ws + W_MIX) + (size_t)(2 * DM) * DM, (const bf16*)(ws + WS_XHAT), RVW, M, DM}; pg8::StaticOrder S; S.init(RVW, M, LG(G), LG(bx));
                  EpiRetVT E{(bf16*)(ws + BIG_RVT), (const ssq_t*)(ws + WS_SSQ) + M};
                  pg8::gemm_phase<EpiRetVT, pg8::StaticOrder, true, true>(ring, g, S, E, LG(wave0)); } }
}
            SEAM(pb + 3);
            for (int rep_ = 0; rep_ < REPS(4); ++rep_) { if (rep_) xcd_barrier(bar);
#if defined(KB_RET_STUB)
            if (RUN(pb + 4)) { PH_IDS unsigned char* ws = WSP; bf16* ro = (bf16*)(ws + BIG_RO); const bf16* rq = (const bf16*)(ws + (KB_RET_STUB == 1 ? BIG_RQ : BIG_RK)); float* rst = (float*)(ws + BIG_RST);
                for (size_t i = gt; i < (size_t)M * RVW / 8; i += NGT) { const size_t row = i / (RVW / 8), c8 = i % (RVW / 8); u32x4 v;
                    if (KB_RET_STUB == 3) v = *(const u32x4*)((const bf16*)(ws + BIG_RVT) + (c8 * 8) * (size_t)M / 8 * 8 + row / 8 * 8 + 0) ; else v = *(const u32x4*)(rq + row * DM + (c8 & 127) * 8);
                    *(u32x4*)(ro + i * 8) = v; }
                for (size_t i = gt; i < (size_t)M * RH * 8; i += NGT) { rst[2 * i] = 0.f; rst[2 * i + 1] = 64.f; } }
#else
            if (RUN(pb + 4)) { PH_IDS unsigned char* ws = WSP;

                ret_core((const bf16*)(ws + BIG_RQ), (const bf16*)(ws + BIG_RK), (const bf16*)(ws + BIG_RVT), (bf16*)(ws + BIG_RO), (float*)(ws + BIG_RST), ring, LG(vcu), LG(G), tid); }
#endif
}
#ifdef KB_PROBE_SKIP
            { xcd_barrier(bar); PH_IDS unsigned char* ws = WSP; ret_core<KB_PROBE_SKIP>((const bf16*)(ws + BIG_RQ), (const bf16*)(ws + BIG_RK), (const bf16*)(ws + BIG_RVT), (bf16*)OUTP, (float*)((char*)OUTP + 0), ring, LG(vcu), LG(G), tid); }
#endif
            SEAM(pb + 4);
            if (RUN(pb + 5)) { unsigned char* ws = WSP;
                pg8::Gemm g{(const bf16*)(ws + WS_XHAT), (const bf16*)(ws + W_MIX) + (size_t)(2 * DM + RVW) * DM, M, RVW, DM}; pg8::StaticOrder S; S.init(M, RVW, LG(G), LG(bx));
                EpiRetGate E{(bf16*)(ws + BIG_RO), (const ssq_t*)(ws + WS_SSQ) + M, (const float*)(ws + BIG_RST)};
                pg8::gemm_phase<EpiRetGate, pg8::StaticOrder, true, true>(ring, g, S, E, LG(wave0)); }
            SEAM(pb + 5);
            if (RUN(pb + 6)) { unsigned char* ws = WSP; ssq_t* SS0 = (ssq_t*)(ws + WS_SSQ);
                RSTAG(); pg8::Gemm g{(const bf16*)(ws + BIG_RO), (const bf16*)(ws + W_ROUT), M, DM, RVW}; pg8::StaticOrder S; S.init(M, DM, LG(G), LG(bx)); EpiResid E{(bf16*)(ws + WS_XHAT), SS0, SS0 + M, 1.0f};
                pg8::gemm_phase<EpiResid, pg8::StaticOrder, true, true>(ring, g, S, E, LG(wave0)); }
            SEAM(pb + 6);
        }
for (int rep_ = 0; rep_ < REPS(5); ++rep_) { if (rep_) xcd_barrier(bar);
        if (RUN(pb + 7)) { unsigned char* ws = WSP;
            pg8::Gemm g{(const bf16*)(ws + WS_XHAT), (const bf16*)(ws + W_XQ), M, DM, DM}; pg8::StaticOrder S; S.init(M, DM, LG(G), LG(bx));
            EpiBf16<1> E{(bf16*)(ws + BIG_XQ), DM, (const ssq_t*)(ws + WS_SSQ)}; pg8::gemm_phase<EpiBf16<1>, pg8::StaticOrder, true, true>(ring, g, S, E, LG(wave0)); }
}
        SEAM(pb + 7);
for (int rep_ = 0; rep_ < REPS(6); ++rep_) { if (rep_) xcd_barrier(bar);
        if (RUN(pb + 8)) { PH_IDS unsigned char* ws = WSP; xattn_core((const bf16*)(ws + BIG_XQ), (const bf16*)(ws + WS_XK + (L & 1) * XKV_SET), (const bf16*)(ws + WS_XVT + (L & 1) * XKV_SET), (bf16*)(ws + BIG_XO), ring, LG(vcu), LG(G), tid); }
}
        SEAM(pb + 8);
        if (RUN(pb + 9)) { unsigned char* ws = WSP; ssq_t* SS0 = (ssq_t*)(ws + WS_SSQ);
            RSTAG(); pg8::Gemm g{(const bf16*)(ws + BIG_XO), (const bf16*)(ws + W_XO), M, DM, DM}; pg8::StaticOrder S; S.init(M, DM, LG(G), LG(bx)); EpiResid E{(bf16*)(ws + WS_XHAT), SS0 + M, SS0, 1.0f};
            pg8::gemm_phase<EpiResid, pg8::StaticOrder, true, true>(ring, g, S, E, LG(wave0)); }
        SEAM(pb + 9);
for (int rep_ = 0; rep_ < REPS(7); ++rep_) { if (rep_) xcd_barrier(bar);
        if (RUN(pb + 10)) { unsigned char* ws = WSP; ssq_t* SS0 = (ssq_t*)(ws + WS_SSQ);
#if KB_FFN_MERGE
            { pg8::Gemm g{(const bf16*)(ws + WS_XHAT), (const bf16*)(ws + W_F2IN), M / 2, 2 * DFF, DM}; pg8::StaticOrder S; S.init(M / 2, 2 * DFF, LG(G), LG(bx)); EpiSwiGLU E{(bf16*)(ws + BIG_H), (SS0 + M)};
              pg8::gemm_phase<EpiSwiGLU, pg8::StaticOrder, true, true>(ring, g, S, E, LG(wave0)); }
            xcd_barrier(bar);
            { const int par_ = (LG(bx) >> 3) & 1; const size_t r1 = (size_t)(M / 2);
              for (int i_ = 0; i_ < 2; ++i_) {
                if ((i_ ^ par_) == 0) { pg8::Gemm g{(const bf16*)(ws + BIG_H), (const bf16*)(ws + W_F2OUT), M / 2, DM, DFF}; pg8::StaticOrder S; S.init(M / 2, DM, LG(G), LG(bx)); EpiResid E{(bf16*)(ws + WS_XHAT), SS0, (SS0 + M), 0.5f};
                    pg8::gemm_phase<EpiResid, pg8::StaticOrder, true, true>(ring, g, S, E, LG(wave0)); }
                else { pg8::Gemm g{(const bf16*)(ws + WS_XHAT) + r1 * DM, (const bf16*)(ws + W_F2IN), M / 2, 2 * DFF, DM}; pg8::StaticOrder S; S.init(M / 2, 2 * DFF, LG(G), LG(bx)); EpiSwiGLU E{(bf16*)(ws + BIG_H) + r1 * DFF, (SS0 + M) + r1};
                    pg8::gemm_phase<EpiSwiGLU, pg8::StaticOrder, true, true>(ring, g, S, E, LG(wave0)); } } }
#else
            for (int hb = 0; hb < KB_FFN_SPLIT; ++hb) { const size_t r0 = (size_t)hb * (M / KB_FFN_SPLIT);
                { pg8::Gemm g{(const bf16*)(ws + WS_XHAT) + r0 * DM, (const bf16*)(ws + W_F2IN), M / KB_FFN_SPLIT, 2 * DFF, DM}; pg8::StaticOrder S; S.init(M / KB_FFN_SPLIT, 2 * DFF, LG(G), LG(bx)); EpiSwiGLU E{(bf16*)(ws + BIG_H) + r0 * DFF, (SS0 + M) + r0};
                  pg8::gemm_phase<EpiSwiGLU, pg8::StaticOrder, true, true>(ring, g, S, E, LG(wave0)); }
                if (hb + 1 < KB_FFN_SPLIT) { xcd_barrier(bar);
                    pg8::Gemm g{(const bf16*)(ws + BIG_H) + r0 * DFF, (const bf16*)(ws + W_F2OUT), M / KB_FFN_SPLIT, DM, DFF}; pg8::StaticOrder S; S.init(M / KB_FFN_SPLIT, DM, LG(G), LG(bx)); EpiResid E{(bf16*)(ws + WS_XHAT) + r0 * DM, SS0 + r0, (SS0 + M) + r0, 0.5f};
                    pg8::gemm_phase<EpiResid, pg8::StaticOrder, true, true>(ring, g, S, E, LG(wave0)); xcd_barrier(bar); } }
#endif
        }
}
        SEAM(pb + 10);
        if (RUN(pb + 11)) { unsigned char* ws = WSP; ssq_t* SS0 = (ssq_t*)(ws + WS_SSQ); const size_t r0 = (size_t)(FFN_NBLK - 1) * (M / FFN_NBLK);
            pg8::Gemm g{(const bf16*)(ws + BIG_H) + r0 * DFF, (const bf16*)(ws + W_F2OUT), M / FFN_NBLK, DM, DFF}; pg8::StaticOrder S; S.init(M / FFN_NBLK, DM, LG(G), LG(bx)); EpiResid E{(bf16*)(ws + WS_XHAT) + r0 * DM, SS0 + r0, (SS0 + M) + r0, 0.5f};
            pg8::gemm_phase<EpiResid, pg8::StaticOrder, true, true>(ring, g, S, E, LG(wave0)); }
        SEAM(pb + 11);
    }
    for (int rep_ = 0; rep_ < REPS(12); ++rep_) { if (rep_) xcd_barrier(bar);
    if (RUN(PH_FINAL)) { PH_IDS unsigned char* ws = WSP; float* out = OUTP; final_rows((const bf16*)(ws + WS_XHAT), (const ssq_t*)(ws + WS_SSQ) + KB_FINAL_SS * M, INF(5), out, gw, NGW, lane); }
    }
#undef RUN
#undef SEAM
#undef bar
}

extern "C" void kernel_launch(void* const* d_in, const int* in_sizes, int n_in, void* d_out, int out_size, void* d_ws, size_t ws_size, hipStream_t stream) {
    static int grid = 0;
    if (grid == 0) {
        if (n_in != 24 || in_sizes[0] != M * DM || out_size != M * DM || ws_size < WS_END) { fprintf(stderr, "kernel_launch: unexpected shapes / workspace (n_in %d, ws %zu, need %zu)\n", n_in, ws_size, (size_t)WS_END); grid = -1; return; }
        int dev = 0, cus = 0, per_cu = 0;
        if (hipGetDevice(&dev) != hipSuccess || hipDeviceGetAttribute(&cus, hipDeviceAttributeMultiprocessorCount, dev) != hipSuccess) { grid = -1; return; }
        if (hipFuncSetAttribute((const void*)hybrid_fwd, hipFuncAttributeMaxDynamicSharedMemorySize, LDS_BYTES) != hipSuccess) { fprintf(stderr, "kernel_launch: hipFuncSetAttribute failed\n"); grid = -1; return; }
        if (hipOccupancyMaxActiveBlocksPerMultiprocessor(&per_cu, (const void*)hybrid_fwd, NWAVES * 64, LDS_BYTES) != hipSuccess || per_cu < 1) { fprintf(stderr, "kernel_launch: occupancy query says %d blocks per CU\n", per_cu); }
        (void)hipGetLastError();
        grid = cus;
    }
    if (grid < 0) return;
    if (hipMemsetAsync((char*)d_ws + WS_CTL, 0, CTL_ZERO_BYTES, stream) != hipSuccess) return;
    Args a{};
    for (int i = 0; i < 24; ++i) a.in[i] = d_in[i];
    a.out = (float*)d_out; a.ws = (unsigned char*)d_ws; a.pad = 0;
#if MK_PER_PHASE
    for (int p = 0; p < N_PHASES; ++p) { a.ph_lo = p; a.ph_hi = p + 1; a.li = 0; hipLaunchKernelGGL(hybrid_fwd, dim3(grid), dim3(NWAVES * 64), LDS_BYTES, stream, a); }
#else
    a.ph_lo = 0; a.ph_hi = N_PHASES; a.li = 0;
    hipLaunchKernelGGL(hybrid_fwd, dim3(grid), dim3(NWAVES * 64), LDS_BYTES, stream, a);
#endif
}
#endif
```

```cpp
#ifndef HOST_EMU
#include <hip/hip_runtime.h>
#include <cstdio>
#include <cstdint>
#define LAS __attribute__((address_space(3)))
#define GAS __attribute__((address_space(1)))
#define DEV __device__ __forceinline__
#else
#include "emu.h"
#define LAS
#define GAS
#define DEV inline
#endif

#ifndef KB_BATCH
#define KB_BATCH 8
#endif
#ifndef KB_SEQ
#define KB_SEQ 8192
#endif
constexpr int BATCH = KB_BATCH, SEQ = KB_SEQ, DM = 1024, DEPTH = 4, NMEM = 256, DFF = 2816;
constexpr int M = BATCH * SEQ;
constexpr int MMEM = BATCH * NMEM;
constexpr int S5G = 64, S5P = 64, S5H = 16;
constexpr int S5_NCH = 64;
constexpr int S5_LC = SEQ / S5_NCH;
constexpr int RH = 4, RDK = 256, RDV = 512, RVW = RH * RDV, RIN = 2 * DM + 2 * RVW;
constexpr int RMC = 256;
constexpr int XH = 4, XD = 256;
constexpr int ROT_NPOS = 12288;
constexpr float EPS = 1e-6f;
constexpr int SSQW = 32;

typedef unsigned short bf16;
typedef short bf16x8 __attribute__((ext_vector_type(8)));
typedef short s16x4 __attribute__((ext_vector_type(4)));
typedef float f32x4 __attribute__((ext_vector_type(4)));
typedef float f32x2 __attribute__((ext_vector_type(2)));
typedef float f32x16 __attribute__((ext_vector_type(16)));
typedef unsigned u32x4 __attribute__((ext_vector_type(4)));
typedef unsigned u32x2 __attribute__((ext_vector_type(2)));

DEV unsigned f2bf(float f) { unsigned u = __builtin_bit_cast(unsigned, f); return (u + 0x7fffu + ((u >> 16) & 1u)) >> 16; }
DEV float bf2f(unsigned h) { return __builtin_bit_cast(float, (h & 0xffffu) << 16); }
DEV float bflo(unsigned w) { return __builtin_bit_cast(float, w << 16); }
DEV float bfhi(unsigned w) { return __builtin_bit_cast(float, w & 0xffff0000u); }
#ifndef HOST_EMU
typedef __bf16 bf16v2_t __attribute__((ext_vector_type(2)));
DEV unsigned pk2(float lo, float hi) { const f32x2 v = {lo, hi}; const bf16v2_t b = __builtin_convertvector(v, bf16v2_t); return __builtin_bit_cast(unsigned, b); }
DEV float fexp2(float x) { return __builtin_amdgcn_exp2f(x); }
DEV float frcp(float x) { return __builtin_amdgcn_rcpf(x); }
DEV float frsq(float x) { return __builtin_amdgcn_rsqf(x); }
#define MFMA32(a, b, c) __builtin_amdgcn_mfma_f32_32x32x16_bf16(a, b, c, 0, 0, 0)
#define PERMLANE32_SWAP(a, b) __builtin_amdgcn_permlane32_swap(a, b, false, false)
#define MFMA16K16(a, b, c) __builtin_amdgcn_mfma_f32_16x16x16bf16_1k(a, b, c, 0, 0, 0)
#else
DEV unsigned pk2(float lo, float hi) { return f2bf(lo) | (f2bf(hi) << 16); }
DEV float fexp2(float x) { return exp2f(x); }
DEV float frcp(float x) { return 1.0f / x; }
DEV float frsq(float x) { return 1.0f / sqrtf(x); }
#define MFMA32(a, b, c) emu_mfma32(a, b, c)
#define PERMLANE32_SWAP(a, b) emu_permlane32_swap(a, b)
#define MFMA16K16(a, b, c) emu_mfma16k16(a, b, c)
#endif
DEV float sigmoidf_(float x) { return frcp(1.0f + fexp2(-1.4426950408889634f * x)); }
DEV float siluf_(float x) { return x * sigmoidf_(x); }
DEV float gelu_tanh(float x) { const float u = 0.7978845608028654f * (x + 0.044715f * x * x * x); return x * sigmoidf_(2.0f * u); }
DEV int pos16(int n) { return (n & 3) | ((n & 4) << 1) | ((n & 8) >> 1); }
DEV int rowmap32(int reg, int hh) { return (reg & 3) + 8 * (reg >> 2) + 4 * hh; }
DEV bf16x8 pack8(float a0, float a1, float a2, float a3, float a4, float a5, float a6, float a7) {
    u32x4 w; w.x = pk2(a0, a1); w.y = pk2(a2, a3); w.z = pk2(a4, a5); w.w = pk2(a6, a7); return __builtin_bit_cast(bf16x8, w); }
DEV s16x4 pack4(float a0, float a1, float a2, float a3) { u32x2 w; w.x = pk2(a0, a1); w.y = pk2(a2, a3); return __builtin_bit_cast(s16x4, w); }
DEV u32x4 widen_pair(u32x2 gk, u32x2 gk1) { const auto r0 = PERMLANE32_SWAP(gk.x, gk1.x); const auto r1 = PERMLANE32_SWAP(gk.y, gk1.y); u32x4 w; w.x = r0[0]; w.y = r1[0]; w.z = r0[1]; w.w = r1[1]; return w; }
DEV float wave_sum(float v) {
#pragma unroll
    for (int o = 1; o < 64; o <<= 1) v += __shfl_xor(v, o);
    return v;
}

constexpr size_t MiB = 1u << 20;
constexpr size_t WS_CTL = 0, CTL_ZERO_BYTES = 1 * MiB;
constexpr size_t WS_W = 1 * MiB;
constexpr size_t W_F1IN = WS_W, W_F1OUT = W_F1IN + (size_t)2 * DFF * DM * 2, W_F2IN = W_F1OUT + (size_t)DM * DFF * 2, W_F2OUT = W_F2IN + (size_t)2 * DFF * DM * 2;
constexpr size_t W_MIX = W_F2OUT + (size_t)DM * DFF * 2;
constexpr size_t W_ROUT = W_MIX + (size_t)RIN * DM * 2;
constexpr size_t W_XQ = W_ROUT + (size_t)DM * RVW * 2, W_XO = W_XQ + (size_t)DM * DM * 2, W_XK = W_XO + (size_t)DM * DM * 2, W_XV = W_XK + (size_t)DM * DM * 2;
constexpr size_t W_XKV_SET = (size_t)2 * DM * DM * 2;
constexpr size_t W_END = W_XV + (size_t)DM * DM * 2 + W_XKV_SET;
static_assert(W_END <= 65 * MiB, "weight region");
constexpr size_t WS_S5T = 65 * MiB, S5T_STRIDE = 1 * MiB;
constexpr size_t S5T_BBAR = WS_S5T, S5T_CT = S5T_BBAR + (size_t)S5G * 2 * S5P * S5H * 2, S5T_A = S5T_CT + (size_t)S5G * 2 * S5H * S5P * 2, S5T_AL = S5T_A + (size_t)S5G * S5P * 2 * 4;
static_assert(S5T_AL + (size_t)S5G * S5P * 2 * 4 <= WS_S5T + S5T_STRIDE, "s5 tables");
constexpr size_t WS_ROT = 67 * MiB;
static_assert((size_t)ROT_NPOS * 128 * 8 <= 13 * MiB, "rot table");
constexpr size_t WS_MEMN = 80 * MiB, WS_MEMNP = 84 * MiB;
constexpr size_t WS_XK = 88 * MiB, WS_XVT = 96 * MiB, XKV_SET = 4 * MiB;
constexpr size_t WS_SSQ = 104 * MiB;
constexpr size_t WS_XHAT = 105 * MiB;
constexpr size_t WS_BIG = 233 * MiB;
constexpr size_t BIG_H = WS_BIG;
constexpr size_t BIG_YB = WS_BIG, BIG_ES = WS_BIG + 128 * MiB;
constexpr size_t BIG_RQ = WS_BIG, BIG_RK = WS_BIG + 128 * MiB, BIG_RVT = WS_BIG + 256 * MiB, BIG_RO = WS_BIG + 512 * MiB, BIG_RST = WS_BIG + 768 * MiB;
constexpr size_t BIG_XQ = WS_BIG, BIG_XO = WS_BIG + 128 * MiB;
constexpr size_t WS_END = WS_BIG + 784 * MiB;
static_assert(WS_END <= (size_t)1024 * MiB, "workspace map");
#ifndef HOST_EMU
namespace pg8 {
#define PG8_LAS __attribute__((address_space(3)))
typedef unsigned short bf16_t;
typedef short bf16x8 __attribute__((ext_vector_type(8)));
typedef float f32x4 __attribute__((ext_vector_type(4)));
typedef unsigned u32x4 __attribute__((ext_vector_type(4)));
constexpr int BM = 256, BK = 64, HALF = 128, HTB = HALF * BK * 2  , STAGE_BYTES = 8 * HTB, NXCD = 8, WGM = 8;

__host__ __device__ __forceinline__ int lds_byte(int r, int c) { const int st = (r >> 4) * 2 + (c >> 5), rr = r & 15, cc = c & 31, ob = rr * 64 + cc * 2; return st * 1024 + (ob ^ (((ob >> 9) & 1) << 5)); }
__host__ __device__ __forceinline__ void stage_rc(int b, int& R, int& C) { const int st = b / 1024, sb = b % 1024, swz = sb ^ (((sb >> 9) & 1) << 5); R = (st >> 1) * 16 + swz / 64; C = (st & 1) * 32 + (swz % 64) / 2; }
__host__ __device__ __forceinline__ int perm32(int rho) { const int n = rho >> 4, i = rho & 15; return 8 * (i >> 2) + 4 * n + (i & 3); }

struct Unit { int pm, pn; };
struct Gemm { const bf16_t* A; const bf16_t* Bt; int M, N, K; int ld = 0; };

struct StaticOrder {
    int nM, nN, nwg, G, c;
    __host__ __device__ void init(int M, int N, int G_, int c_) { nM = M / BM; nN = N / BM; nwg = nM * nN; G = G_; c = c_; }
    __host__ __device__ bool next(int i, Unit& u) const {
        const long L = (long)i * G + c; if (L >= nwg) return false;
        int wgid = (int)L; { const int q = nwg / NXCD, r = nwg % NXCD, xcd = wgid % NXCD, off = wgid / NXCD; wgid = (xcd < r ? xcd * (q + 1) : r * (q + 1) + (xcd - r) * q) + off; }
        const int nig = WGM * nN, gid = wgid / nig, fm = gid * WGM, gsz = (nM - fm) < WGM ? (nM - fm) : WGM;
        u.pm = fm + ((wgid % nig) % gsz); u.pn = (wgid % nig) / gsz; return true;
    }
    __device__ __forceinline__ void a_ready(const Unit&) const {}
    __device__ __forceinline__ void done(const Unit&) const {}
};
}
#endif
#ifdef HOST_EMU
namespace pg8 { struct Unit { int pm, pn; }; constexpr int BM = 256, HALF = 128; }
#endif
typedef f32x4 AccT[2][2][4][2];
#ifndef HOST_EMU
#define EPI_STAGE() __builtin_amdgcn_sched_barrier(0)
#else
#define EPI_STAGE() do {} while (0)
#endif
#if !defined(HOST_EMU) && defined(KB_NT_H)
#define NT_STORE16(p, v) __builtin_nontemporal_store((v), (p))
#else
#define NT_STORE16(p, v) (*(p) = (v))
#endif
#ifndef HOST_EMU
#define EPI_OPAQUE(a, b) asm volatile("" : "+v"(a), "+v"(b))
#else
#define EPI_OPAQUE(a, b) do {} while (0)
#endif

typedef unsigned long long ssq_t;
constexpr float SSQ_SCALE = 1048576.0f, SSQ_INV = 1.0f / 1048576.0f;
DEV ssq_t ss_fix(float v) { return (ssq_t)(v * SSQ_SCALE + 0.5f); }
DEV float ss_val(ssq_t v) { return (float)v * SSQ_INV; }
#ifndef HOST_EMU
DEV ssq_t zero64() { unsigned lo = 0u, hi = 0u; asm volatile("" : "+v"(lo), "+v"(hi)); return ((ssq_t)hi << 32) | lo; }
#else
DEV ssq_t zero64() { return 0ull; }
#endif
DEV void row_rstd(const ssq_t* ss, int row0, float (&rs)[2][4]) {
#pragma unroll
    for (int ai = 0; ai < 2; ++ai)
#pragma unroll
        for (int m = 0; m < 4; ++m) rs[ai][m] = frsq(ss_val(ss[row0 + 128 * ai + 16 * m]) * (1.0f / DM) + EPS);
}
#ifndef HOST_EMU
DEV void ss_add(ssq_t* p, float v) { atomicAdd(p, ss_fix(v)); }
#else
#include <mutex>
static std::mutex e_atomic_mtx;
DEV void ss_add(ssq_t* p, float v) { std::lock_guard<std::mutex> g(e_atomic_mtx); *p += ss_fix(v); }
#endif

struct EpiResid {
    static constexpr bool PERM = true, AFTER_DRAIN = false;
    bf16* xh; ssq_t* ss_acc; ssq_t* ss_zero; float scale;
    DEV void operator()(const AccT& acc, const pg8::Unit& u, int wr, int wc, int fr, int fq) const {
        EPI_OPAQUE(fr, fq);
        const int row0 = u.pm * 256 + wr * 64 + fr, col0 = u.pn * 256 + wc * 32 + 8 * fq;
#pragma unroll
        for (int ai = 0; ai < 2; ++ai)
#pragma unroll
            for (int m = 0; m < 4; ++m) { const int row = row0 + 128 * ai + 16 * m; bf16* rowp = xh + (size_t)row * DM + col0; float ss = 0.f;
#pragma unroll
                for (int bj = 0; bj < 2; ++bj) { const u32x4 b = *(const u32x4*)(rowp + 128 * bj); const f32x4 a0 = acc[ai][bj][m][0] * scale, a1 = acc[ai][bj][m][1] * scale;
                    u32x4 w; w.x = pk2(bflo(b.x) + a0[0], bfhi(b.x) + a0[1]); w.y = pk2(bflo(b.y) + a0[2], bfhi(b.y) + a0[3]); w.z = pk2(bflo(b.z) + a1[0], bfhi(b.z) + a1[1]); w.w = pk2(bflo(b.w) + a1[2], bfhi(b.w) + a1[3]);
                    *(u32x4*)(rowp + 128 * bj) = w;
                    const float o0 = bflo(w.x), o1 = bfhi(w.x), o2 = bflo(w.y), o3 = bfhi(w.y), o4 = bflo(w.z), o5 = bfhi(w.z), o6 = bflo(w.w), o7 = bfhi(w.w);
                    ss += ((o0 * o0 + o1 * o1) + (o2 * o2 + o3 * o3)) + ((o4 * o4 + o5 * o5) + (o6 * o6 + o7 * o7)); }
                ss += __shfl_xor(ss, 16); ss += __shfl_xor(ss, 32);
                if (fq == 0) { ss_add(ss_acc + row, ss); ss_zero[row] = zero64(); }
            }
    }
};
struct EpiS5Glu {
    static constexpr bool PERM = true, AFTER_DRAIN = false;
    bf16* xh; ssq_t* ss_acc; ssq_t* ss_zero;
    DEV void operator()(const AccT& acc, const pg8::Unit& u, int wr, int wc, int fr, int fq) const {
        EPI_OPAQUE(fr, fq);
        const int row0 = u.pm * 256 + wr * 64 + fr, col0 = u.pn * 128 + wc * 32 + 8 * fq;
#pragma unroll
        for (int ai = 0; ai < 2; ++ai)
#pragma unroll
            for (int m = 0; m < 4; ++m) { const int row = row0 + 128 * ai + 16 * m; bf16* rowp = xh + (size_t)row * DM + col0;
                const u32x4 b = *(const u32x4*)rowp; const float bb[8] = {bflo(b.x), bfhi(b.x), bflo(b.y), bfhi(b.y), bflo(b.z), bfhi(b.z), bflo(b.w), bfhi(b.w)}; float o[8];
#pragma unroll
                for (int n = 0; n < 2; ++n)
#pragma unroll
                    for (int e = 0; e < 4; ++e) o[4 * n + e] = bb[4 * n + e] + acc[ai][0][m][n][e] * sigmoidf_(acc[ai][1][m][n][e]);
                u32x4 w; w.x = pk2(o[0], o[1]); w.y = pk2(o[2], o[3]); w.z = pk2(o[4], o[5]); w.w = pk2(o[6], o[7]);
                *(u32x4*)rowp = w;
                const float o0 = bflo(w.x), o1 = bfhi(w.x), o2 = bflo(w.y), o3 = bfhi(w.y), o4 = bflo(w.z), o5 = bfhi(w.z), o6 = bflo(w.w), o7 = bfhi(w.w);
                float ss = ((o0 * o0 + o1 * o1) + (o2 * o2 + o3 * o3)) + ((o4 * o4 + o5 * o5) + (o6 * o6 + o7 * o7));
                ss += __shfl_xor(ss, 16); ss += __shfl_xor(ss, 32);
                if (fq == 0) { ss_add(ss_acc + row, ss); ss_zero[row] = zero64(); }
            }
    }
};
struct EpiSwiGLU {
    static constexpr bool PERM = true, AFTER_DRAIN = false;
    bf16* H; const ssq_t* ssq;
    DEV void operator()(const AccT& acc, const pg8::Unit& u, int wr, int wc, int fr, int fq) const {
        EPI_OPAQUE(fr, fq);
        const int row0 = u.pm * 256 + wr * 64 + fr, col0 = u.pn * 128 + wc * 32 + 8 * fq;
        float rs[2][4]; row_rstd(ssq, row0, rs);
#pragma unroll
        for (int ai = 0; ai < 2; ++ai)
#pragma unroll
            for (int m = 0; m < 4; ++m) { const float r = rs[ai][m]; float h[8];
#pragma unroll
                for (int n = 0; n < 2; ++n)
#pragma unroll
                    for (int e = 0; e < 4; ++e) { const float a = acc[ai][0][m][n][e] * r, b = acc[ai][1][m][n][e] * r; h[4 * n + e] = siluf_(a) * b; }
                u32x4 w; w.x = pk2(h[0], h[1]); w.y = pk2(h[2], h[3]); w.z = pk2(h[4], h[5]); w.w = pk2(h[6], h[7]);
                NT_STORE16((u32x4*)(H + (size_t)(row0 + 128 * ai + 16 * m) * DFF + col0), w); }
    }
};
template <int NSLOT> struct EpiBf16 {
    static constexpr bool PERM = true, AFTER_DRAIN = false;
    bf16* O; int ldc; const ssq_t* ssq;
    DEV void operator()(const AccT& acc, const pg8::Unit& u, int wr, int wc, int fr, int fq) const {
        EPI_OPAQUE(fr, fq);
        const int row0 = u.pm * 256 + wr * 64 + fr, col0 = u.pn * 256 + wc * 32 + 8 * fq;
        float rs[2][4];
        if constexpr (NSLOT > 0) row_rstd(ssq, row0, rs);
#pragma unroll
        for (int ai = 0; ai < 2; ++ai)
#pragma unroll
            for (int m = 0; m < 4; ++m) { const float r = NSLOT > 0 ? rs[ai][m] : 1.0f; bf16* rowp = O + (size_t)(row0 + 128 * ai + 16 * m) * ldc + col0;
#pragma unroll
                for (int bj = 0; bj < 2; ++bj) { const f32x4 v0 = acc[ai][bj][m][0] * r, v1 = acc[ai][bj][m][1] * r;
                    u32x4 w; w.x = pk2(v0[0], v0[1]); w.y = pk2(v0[2], v0[3]); w.z = pk2(v1[0], v1[1]); w.w = pk2(v1[2], v1[3]);
                    *(u32x4*)(rowp + 128 * bj) = w; } }
    }
};
struct EpiRetIn {
    static constexpr bool PERM = true, AFTER_DRAIN = false;
    bf16 *Q, *K; const ssq_t* ssq; const float* rot; const int* positions;
    DEV void operator()(const AccT& acc, const pg8::Unit& u, int wr, int wc, int fr, int fq) const {
        EPI_OPAQUE(fr, fq);
        const int row0 = u.pm * 256 + wr * 64 + fr, pn = u.pn;
        float rs[2][4]; row_rstd(ssq, row0, rs);
        {
            const int h = pn & 3; const bool isk = pn >= 4; bf16* dst = isk ? K : Q;
            const float lg = log2f(1.0f - exp2f(-5.0f - (float)h)); const int d0 = wc * 32 + 8 * fq;
#pragma unroll
            for (int ai = 0; ai < 2; ++ai)
#pragma unroll
                for (int m = 0; m < 4; ++m) { const int row = row0 + 128 * ai + 16 * m; const int i256 = row & (RMC - 1);
                    const float sc = rs[ai][m] * (isk ? fexp2(-lg * (float)i256) * 0.0625f : fexp2(lg * (float)i256));
                    const float* rp = rot + ((size_t)positions[row] * 128 + d0) * 2;
                    const f32x4 r0 = *(const f32x4*)rp, r1 = *(const f32x4*)(rp + 4), r2 = *(const f32x4*)(rp + 8), r3 = *(const f32x4*)(rp + 12);
                    const float cs[8] = {r0[0], r0[2], r1[0], r1[2], r2[0], r2[2], r3[0], r3[2]}, sn[8] = {r0[1], r0[3], r1[1], r1[3], r2[1], r2[3], r3[1], r3[3]};
                    float o1[8], o2[8];
#pragma unroll
                    for (int n = 0; n < 2; ++n)
#pragma unroll
                        for (int e = 0; e < 4; ++e) { const float t1 = acc[ai][0][m][n][e] * sc, t2 = acc[ai][1][m][n][e] * sc; const int j = 4 * n + e;
                            o1[j] = t1 * cs[j] - t2 * sn[j]; o2[j] = t1 * sn[j] + t2 * cs[j]; }
                    u32x4 w1, w2; w1.x = pk2(o1[0], o1[1]); w1.y = pk2(o1[2], o1[3]); w1.z = pk2(o1[4], o1[5]); w1.w = pk2(o1[6], o1[7]);
                    w2.x = pk2(o2[0], o2[1]); w2.y = pk2(o2[2], o2[3]); w2.z = pk2(o2[4], o2[5]); w2.w = pk2(o2[6], o2[7]);
                    bf16* p = dst + (size_t)row * DM + 256 * h + d0; *(u32x4*)p = w1; *(u32x4*)(p + 128) = w2; }
        }
    }
};
struct EpiRetGate {
    static constexpr bool PERM = true, AFTER_DRAIN = false;
    bf16* O; const ssq_t* ssq; const float* stat;
    DEV void operator()(const AccT& acc, const pg8::Unit& u, int wr, int wc, int fr, int fq) const {
        EPI_OPAQUE(fr, fq);
        const int row0 = u.pm * 256 + wr * 64 + fr, h = u.pn >> 1, col0 = u.pn * 256 + wc * 32 + 8 * fq;
        float rs[2][4]; row_rstd(ssq, row0, rs);
#pragma unroll
        for (int ai = 0; ai < 2; ++ai)
#pragma unroll
            for (int m = 0; m < 4; ++m) { const int row = row0 + 128 * ai + 16 * m; const float r = rs[ai][m];
                const f32x4 st = *(const f32x4*)(stat + ((size_t)row * RH + h) * 16 + 4 * fq);
                float s1 = st[0] + st[2], s2 = st[1] + st[3];
                s1 += __shfl_xor(s1, 16); s1 += __shfl_xor(s1, 32); s2 += __shfl_xor(s2, 16); s2 += __shfl_xor(s2, 32);
                const float mu = s1 * (1.0f / RDV), var = fmaxf(s2 * (1.0f / RDV) - mu * mu, 0.0f), rg = frsq(var + EPS);
                bf16* rowp = O + (size_t)row * RVW + col0;
#pragma unroll
                for (int bj = 0; bj < 2; ++bj) { const u32x4 ow = *(const u32x4*)(rowp + 128 * bj);
                    const float o[8] = {bflo(ow.x), bfhi(ow.x), bflo(ow.y), bfhi(ow.y), bflo(ow.z), bfhi(ow.z), bflo(ow.w), bfhi(ow.w)}; float y[8];
#pragma unroll
                    for (int n = 0; n < 2; ++n)
#pragma unroll
                        for (int e = 0; e < 4; ++e) { const int j = 4 * n + e; y[j] = siluf_(acc[ai][bj][m][n][e] * r) * ((o[j] - mu) * rg); }
                    u32x4 w; w.x = pk2(y[0], y[1]); w.y = pk2(y[2], y[3]); w.z = pk2(y[4], y[5]); w.w = pk2(y[6], y[7]);
                    *(u32x4*)(rowp + 128 * bj) = w; } }
    }
};

struct EpiNull {
    static constexpr bool PERM = false, AFTER_DRAIN = false;
    DEV void operator()(const AccT& acc, const pg8::Unit& u, int wr, int wc, int fr, int fq) const {
#ifndef HOST_EMU
#pragma unroll
        for (int ai = 0; ai < 2; ++ai)
#pragma unroll
            for (int bj = 0; bj < 2; ++bj)
#pragma unroll
                for (int m = 0; m < 4; ++m)
#pragma unroll
                    for (int n = 0; n < 2; ++n) asm volatile("" :: "v"(acc[ai][bj][m][n]));
#endif
    }
};

struct EpiRetP {
    static constexpr bool PERM = true, AFTER_DRAIN = false;
    bf16* P;
    DEV void operator()(const AccT& acc, const pg8::Unit& u, int wr, int wc, int fr, int fq) const {
        EPI_OPAQUE(fr, fq);
        bf16* blk = P + (size_t)u.pm * 65536;
        const int i0 = wr * 64 + fr, j0 = wc * 32 + 8 * fq;
#pragma unroll
        for (int ai = 0; ai < 2; ++ai)
#pragma unroll
            for (int m = 0; m < 4; ++m) { const int i = i0 + 128 * ai + 16 * m;
#pragma unroll
                for (int bj = 0; bj < 2; ++bj) { const int jb = j0 + 128 * bj;
                    const int g16 = jb & ~15, f = (jb >> 3) & 1;
#pragma unroll
                    for (int n = 0; n < 2; ++n) { float v[4];
#pragma unroll
                        for (int e_ = 0; e_ < 4; ++e_) v[e_] = (jb + 4 * n + e_ <= i) ? acc[ai][bj][m][n][e_] : 0.f;
                        u32x2 w; w.x = pk2(v[0], v[1]); w.y = pk2(v[2], v[3]);
                        *(u32x2*)(blk + (size_t)i * 256 + g16 + 8 * n + 4 * f) = w; } } }
    }
};

struct EpiRetVT {
    static constexpr bool PERM = true, AFTER_DRAIN = false;
    bf16* VT; const ssq_t* ssq;
    DEV void operator()(const AccT& acc, const pg8::Unit& u, int wr, int wc, int fr, int fq) const {
        EPI_OPAQUE(fr, fq);
        const int row0 = u.pm * 256 + wr * 64 + fr, t0 = u.pn * 256 + wc * 32 + 8 * fq;
        float rs[2][8];
#pragma unroll
        for (int bj = 0; bj < 2; ++bj)
#pragma unroll
            for (int j = 0; j < 8; ++j) rs[bj][j] = frsq(ss_val(ssq[t0 + 128 * bj + j]) * (1.0f / DM) + EPS);
        const int f = fq & 1;
#pragma unroll
        for (int ai = 0; ai < 2; ++ai)
#pragma unroll
            for (int m = 0; m < 4; ++m) { bf16* rowp = VT + (size_t)(row0 + 128 * ai + 16 * m) * M;
#pragma unroll
                for (int bj = 0; bj < 2; ++bj) { const int g16 = (t0 + 128 * bj) & ~15;
#pragma unroll
                    for (int n = 0; n < 2; ++n) { const f32x4 a = acc[ai][bj][m][n]; u32x2 w; w.x = pk2(a[0] * rs[bj][4 * n], a[1] * rs[bj][4 * n + 1]); w.y = pk2(a[2] * rs[bj][4 * n + 2], a[3] * rs[bj][4 * n + 3]);
                        *(u32x2*)(rowp + g16 + 8 * n + 4 * f) = w; } } }
    }
};
#ifndef HOST_EMU
namespace pg8 {
__device__ __forceinline__ int pg8_lane_id_fresh() { unsigned m = ~0u; asm volatile("" : "+s"(m)); return (int)__builtin_amdgcn_mbcnt_hi(m, __builtin_amdgcn_mbcnt_lo(m, 0u)); }
template <class Epi, class Sched, bool ALIGN_EPI = false, bool SP2 = false>
__device__ __forceinline__ void gemm_phase(PG8_LAS unsigned char* lds, const Gemm g, const Sched& S, const Epi& E, int wave_id) {
    int tid_l = wave_id * 64 + pg8_lane_id_fresh(); asm volatile("" : "+v"(tid_l));
    const int tid = tid_l, wid = __builtin_amdgcn_readfirstlane(tid >> 6), lane = tid & 63, wr = wid >> 2, wc = wid & 3, fr = lane & 15, fq = lane >> 4;
    const int K = g.K, nt = K / BK, ldk = g.ld ? g.ld : g.K;
    unsigned voffA[2], voffB[2];
#pragma unroll
    for (int i = 0; i < 2; ++i) { int R, C; stage_rc(tid * 16 + i * 8192, R, C); const int Rb = Epi::PERM ? ((R & ~31) + perm32(R & 31)) : R;
        voffA[i] = (unsigned)(R * ldk + C) * 2u; voffB[i] = (unsigned)(Rb * ldk + C) * 2u; }
    const size_t kstep = (size_t)(BK * 2);
    const size_t hstep = (size_t)HALF * ldk * 2;
    const size_t tstep = 2 * hstep;
    const unsigned ldsw = (unsigned)wid * 1024u;
    const int aoff = lds_byte(wr * 64 + fr, fq * 8), boff = lds_byte(wc * 32 + fr, fq * 8);
#define PG8_SA(b, h) (((b) * 2 + (h)) * HTB)
#define PG8_SB(b, h) ((4 + (b) * 2 + (h)) * HTB)
#define PG8_STAGE(bufoff, gbase, voff) do { _Pragma("unroll") for (int _i = 0; _i < 2; ++_i) \
        __builtin_amdgcn_global_load_lds((const unsigned*)((const char*)(gbase) + (voff)[_i]), (PG8_LAS unsigned*)(lds + (bufoff) + ldsw + _i * 8192), 16, 0, 0); } while (0)
#define PG8_LDA(dst, b, h) do { _Pragma("unroll") for (int m = 0; m < 4; ++m) _Pragma("unroll") for (int k = 0; k < 2; ++k) dst[m][k] = *(const PG8_LAS bf16x8*)(lds + PG8_SA(b, h) + aoff + m * 2048 + k * 1024); } while (0)
#define PG8_LDB(dst, b, h) do { _Pragma("unroll") for (int n = 0; n < 2; ++n) _Pragma("unroll") for (int k = 0; k < 2; ++k) dst[n][k] = *(const PG8_LAS bf16x8*)(lds + PG8_SB(b, h) + boff + n * 2048 + k * 1024); } while (0)
#define PG8_MMA(ai, bj, At, Bt) do { __builtin_amdgcn_s_setprio(1); _Pragma("unroll") for (int m = 0; m < 4; ++m) _Pragma("unroll") for (int n = 0; n < 2; ++n) _Pragma("unroll") for (int k = 0; k < 2; ++k) \
        acc[ai][bj][m][n] = __builtin_amdgcn_mfma_f32_16x16x32_bf16(Bt[n][k], At[m][k], acc[ai][bj][m][n], 0, 0, 0); __builtin_amdgcn_s_setprio(0); } while (0)
#define PG8_WAIT_V(n) asm volatile("s_waitcnt vmcnt(" #n ")" ::: "memory")
#define PG8_WAIT_L(n) asm volatile("s_waitcnt lgkmcnt(" #n ")" ::: "memory")
#define PG8_BAR __builtin_amdgcn_s_barrier()
#define PG8_SCHED __builtin_amdgcn_sched_barrier(0)
    Unit cur, nxt; int ui = 0;
    if (!S.next(0, cur)) return;
    f32x4 acc[2][2][4][2];
#pragma unroll
    for (int a = 0; a < 2; ++a)
#pragma unroll
        for (int b = 0; b < 2; ++b)
#pragma unroll
            for (int m = 0; m < 4; ++m)
#pragma unroll
                for (int n = 0; n < 2; ++n) acc[a][b][m][n] = (f32x4){0.f, 0.f, 0.f, 0.f};
    bf16x8 At[4][2], B0[2][2], B1[2][2];
    const char* cA = (const char*)g.A + (size_t)cur.pm * tstep; const char* cB = (const char*)g.Bt + (size_t)cur.pn * tstep;
    S.a_ready(cur);
    if constexpr (SP2) {
        PG8_STAGE(PG8_SB(0, 0), cB, voffB); PG8_STAGE(PG8_SB(0, 1), cB + hstep, voffB); PG8_STAGE(PG8_SA(0, 0), cA, voffA); PG8_STAGE(PG8_SA(0, 1), cA + hstep, voffA);
        if (wr == 1) PG8_BAR;
        PG8_WAIT_V(2); PG8_BAR;
        PG8_STAGE(PG8_SB(1, 0), cB + kstep, voffB); PG8_STAGE(PG8_SA(1, 0), cA + kstep, voffA); PG8_STAGE(PG8_SB(1, 1), cB + hstep + kstep, voffB);
        PG8_WAIT_V(6); PG8_BAR;
    } else {
        PG8_STAGE(PG8_SB(0, 0), cB, voffB); PG8_STAGE(PG8_SA(0, 0), cA, voffA); PG8_STAGE(PG8_SB(0, 1), cB + hstep, voffB); PG8_STAGE(PG8_SA(0, 1), cA + hstep, voffA);
        if (wr == 1) PG8_BAR;
        PG8_WAIT_V(4); PG8_BAR;
        PG8_STAGE(PG8_SB(1, 0), cB + kstep, voffB); PG8_STAGE(PG8_SA(1, 0), cA + kstep, voffA); PG8_STAGE(PG8_SB(1, 1), cB + hstep + kstep, voffB);
        PG8_WAIT_V(6); PG8_BAR;
    }
    for (;;) {
        const bool has_next = S.next(ui + 1, nxt);
        const char* nA = has_next ? (const char*)g.A + (size_t)nxt.pm * tstep : cA; const char* nB = has_next ? (const char*)g.Bt + (size_t)nxt.pn * tstep : cB;
        for (int t = 0; t < nt; t += 2) {
            const bool last = (t == nt - 2);
            const char* a1 = cA + (size_t)(t + 1) * kstep;
            const char* a2 = last ? nA : cA + (size_t)(t + 2) * kstep; const char* b2 = last ? nB : cB + (size_t)(t + 2) * kstep;
            const char* a3 = a2 + kstep; const char* b3 = b2 + kstep;
            if (last && has_next) S.a_ready(nxt);
            if constexpr (SP2) {
            PG8_LDB(B0, 0, 0); PG8_LDB(B1, 0, 1); PG8_SCHED; PG8_LDA(At, 0, 0); PG8_STAGE(PG8_SA(1, 1), a1 + hstep, voffA);
            PG8_WAIT_V(8); PG8_WAIT_L(0); PG8_BAR; PG8_MMA(0, 0, At, B0); PG8_MMA(0, 1, At, B1); PG8_BAR; PG8_SCHED;
            PG8_LDA(At, 0, 1); PG8_STAGE(PG8_SB(0, 0), b2, voffB); PG8_STAGE(PG8_SB(0, 1), b2 + hstep, voffB); PG8_STAGE(PG8_SA(0, 0), a2, voffA);
            PG8_WAIT_V(8); PG8_WAIT_L(0); PG8_BAR; PG8_MMA(1, 0, At, B0); PG8_MMA(1, 1, At, B1); PG8_BAR; PG8_SCHED;
            PG8_LDB(B0, 1, 0); PG8_LDB(B1, 1, 1); PG8_SCHED; PG8_LDA(At, 1, 0); PG8_STAGE(PG8_SA(0, 1), a2 + hstep, voffA);
            PG8_WAIT_V(8); PG8_WAIT_L(0); PG8_BAR; PG8_MMA(0, 0, At, B0); PG8_MMA(0, 1, At, B1); PG8_BAR; PG8_SCHED;
            PG8_LDA(At, 1, 1); PG8_STAGE(PG8_SB(1, 0), b3, voffB); PG8_STAGE(PG8_SB(1, 1), b3 + hstep, voffB); PG8_STAGE(PG8_SA(1, 0), a3, voffA);
            PG8_WAIT_V(8); PG8_WAIT_L(0); PG8_BAR; PG8_MMA(1, 0, At, B0); PG8_MMA(1, 1, At, B1); PG8_BAR; PG8_SCHED;
            } else {
            PG8_LDB(B0, 0, 0); PG8_SCHED; PG8_LDA(At, 0, 0); PG8_STAGE(PG8_SA(1, 1), a1 + hstep, voffA);
            PG8_WAIT_L(8); PG8_BAR; PG8_WAIT_L(0); PG8_MMA(0, 0, At, B0); PG8_BAR; PG8_SCHED;
            PG8_LDB(B1, 0, 1); PG8_STAGE(PG8_SB(0, 0), b2, voffB);
            PG8_BAR; PG8_WAIT_L(0); PG8_MMA(0, 1, At, B1); PG8_BAR;
            PG8_LDA(At, 0, 1); PG8_STAGE(PG8_SA(0, 0), a2, voffA);
            PG8_BAR; PG8_WAIT_L(0); PG8_MMA(1, 0, At, B0); PG8_BAR; PG8_SCHED;
            PG8_STAGE(PG8_SB(0, 1), b2 + hstep, voffB);
            PG8_WAIT_V(6); PG8_BAR; PG8_MMA(1, 1, At, B1); PG8_BAR;
            PG8_LDB(B0, 1, 0); PG8_SCHED; PG8_LDA(At, 1, 0); PG8_STAGE(PG8_SA(0, 1), a2 + hstep, voffA);
            PG8_WAIT_L(8); PG8_BAR; PG8_WAIT_L(0); PG8_MMA(0, 0, At, B0); PG8_BAR; PG8_SCHED;
            PG8_LDB(B1, 1, 1); PG8_STAGE(PG8_SB(1, 0), b3, voffB);
            PG8_BAR; PG8_WAIT_L(0); PG8_MMA(0, 1, At, B1); PG8_BAR;
            PG8_LDA(At, 1, 1); PG8_STAGE(PG8_SA(1, 0), a3, voffA);
            PG8_BAR; PG8_WAIT_L(0); PG8_MMA(1, 0, At, B0); PG8_BAR; PG8_SCHED;
            PG8_STAGE(PG8_SB(1, 1), b3 + hstep, voffB);
            PG8_WAIT_V(6); PG8_BAR; PG8_MMA(1, 1, At, B1); PG8_BAR;
            }
        }
        if constexpr (ALIGN_EPI) { if (wr == 0) PG8_BAR; }
        if constexpr (!Epi::AFTER_DRAIN) { E(acc, cur, wr, wc, fr, fq); S.done(cur); }
        if (!has_next) break;
#pragma unroll
        for (int a = 0; a < 2; ++a)
#pragma unroll
            for (int b = 0; b < 2; ++b)
#pragma unroll
                for (int m = 0; m < 4; ++m)
#pragma unroll
                    for (int n = 0; n < 2; ++n) acc[a][b][m][n] = (f32x4){0.f, 0.f, 0.f, 0.f};
        cur = nxt; cA = nA; cB = nB; ++ui;
        if constexpr (ALIGN_EPI) { if (wr == 1) PG8_BAR; }
    }
    PG8_WAIT_V(0);
    if constexpr (!ALIGN_EPI) { if (wr == 0) PG8_BAR; }
    PG8_BAR;
    if constexpr (Epi::AFTER_DRAIN) { E.fused(acc, cur, wr, wc, fr, fq, lds, wid, lane); S.done(cur); }
#undef PG8_SA
#undef PG8_SB
#undef PG8_STAGE
#undef PG8_LDA
#undef PG8_LDB
#undef PG8_MMA
#undef PG8_WAIT_V
#undef PG8_WAIT_L
#undef PG8_BAR
#undef PG8_SCHED
}
}
#endif
#ifndef HOST_EMU
#define WAVE_LDS_SYNC() do { asm volatile("s_waitcnt lgkmcnt(0)" ::: "memory"); } while (0)
#else
#define WAVE_LDS_SYNC() do { e_wave->bar.arrive_and_wait(); } while (0)
#endif
DEV void conv_tile(const float* W, int ldw, int k0, int n0, const float* gain, bf16* dst, int Kd, LAS float* scr, int lane) {
#pragma unroll 8
    for (int i = 0; i < 32; ++i) { const int kk = 2 * i + (lane >> 5); float v = W[(size_t)(k0 + kk) * ldw + n0 + (lane & 31)]; if (gain) v *= gain[k0 + kk]; scr[kk * 33 + (lane & 31)] = v; }
    WAVE_LDS_SYNC();
    const int c = lane & 7;
#pragma unroll
    for (int j = 0; j < 4; ++j) { const int n = (lane >> 3) + 8 * j; const LAS float* s = scr + (8 * c) * 33 + n;
        u32x4 o; o.x = pk2(s[0 * 33], s[1 * 33]); o.y = pk2(s[2 * 33], s[3 * 33]); o.z = pk2(s[4 * 33], s[5 * 33]); o.w = pk2(s[6 * 33], s[7 * 33]);
        *(u32x4*)(dst + (size_t)n * Kd + k0 + 8 * c) = o; }
    WAVE_LDS_SYNC();
}
DEV int glu_row(int n, int NH) { const int j = n < NH ? n : n - NH; return (j >> 7) * 256 + (n < NH ? 0 : 128) + (j & 127); }

struct LayerW {
    const float *g;
    const float *f1in, *f1out, *f2in, *f2out;
    const float *mixin, *mixout;
    const float *xq, *xkv, *xkv2, *xo;
    int is_ret;
};
DEV void convert_layer(const LayerW& L, unsigned char* ws, LAS float* scr, int gw, int NGW, int lane) {
    constexpr int I_FIN = (DM / 64) * (2 * DFF / 32), I_FOUT = (DFF / 64) * (DM / 32), I_GLU = (DM / 64) * (2 * DM / 32), I_RIN = (DM / 64) * (RIN / 32), I_ROUT = (RVW / 64) * (DM / 32),
                  I_SQ = (DM / 64) * (DM / 32), I_KV = (DM / 64) * (2 * DM / 32);
    const int i_mix = L.is_ret ? I_RIN + I_ROUT : I_GLU;
    const int n_kv = L.is_ret ? 0 : 2 * I_KV;
    const int total = 2 * (I_FIN + I_FOUT) + i_mix + 2 * I_SQ + n_kv;
    for (int it = gw; it < total; it += NGW) {
        int r = it;
        if (r < 2 * I_FIN) { const int f = r >= I_FIN; r -= f * I_FIN; const int nb = r % (2 * DFF / 32), kb = r / (2 * DFF / 32);
            conv_tile(f ? L.f2in : L.f1in, 2 * DFF, 64 * kb, 32 * nb, L.g + (f ? 3 : 0) * DM, (bf16*)(ws + (f ? W_F2IN : W_F1IN)) + (size_t)glu_row(32 * nb, DFF) * DM, DM, scr, lane); continue; }
        r -= 2 * I_FIN;
        if (r < 2 * I_FOUT) { const int f = r >= I_FOUT; r -= f * I_FOUT; const int nb = r % (DM / 32), kb = r / (DM / 32);
            conv_tile(f ? L.f2out : L.f1out, DM, 64 * kb, 32 * nb, nullptr, (bf16*)(ws + (f ? W_F2OUT : W_F1OUT)) + (size_t)(32 * nb) * DFF, DFF, scr, lane); continue; }
        r -= 2 * I_FOUT;
        if (r < i_mix) {
            if (!L.is_ret) { const int nb = r % (2 * DM / 32), kb = r / (2 * DM / 32);
                conv_tile(L.mixin, 2 * DM, 64 * kb, 32 * nb, nullptr, (bf16*)(ws + W_MIX) + (size_t)glu_row(32 * nb, DM) * DM, DM, scr, lane); }
            else if (r < I_RIN) { const int nb = r % (RIN / 32), kb = r / (RIN / 32);
                conv_tile(L.mixin, RIN, 64 * kb, 32 * nb, L.g + 1 * DM, (bf16*)(ws + W_MIX) + (size_t)(32 * nb) * DM, DM, scr, lane); }
            else { r -= I_RIN; const int nb = r % (DM / 32), kb = r / (DM / 32);
                conv_tile(L.mixout, DM, 64 * kb, 32 * nb, nullptr, (bf16*)(ws + W_ROUT) + (size_t)(32 * nb) * RVW, RVW, scr, lane); }
            continue; }
        r -= i_mix;
        if (r < 2 * I_SQ) { const int f = r >= I_SQ; r -= f * I_SQ; const int nb = r % (DM / 32), kb = r / (DM / 32);
            conv_tile(f ? L.xo : L.xq, DM, 64 * kb, 32 * nb, f ? nullptr : L.g + 2 * DM, (bf16*)(ws + (f ? W_XO : W_XQ)) + (size_t)(32 * nb) * DM, DM, scr, lane); continue; }
        r -= 2 * I_SQ;
        { const int set = r >= I_KV; r -= set * I_KV; const int nb = r % (2 * DM / 32), kb = r / (2 * DM / 32); const int n0 = 32 * nb;
          conv_tile(set ? L.xkv2 : L.xkv, 2 * DM, 64 * kb, n0, nullptr, (bf16*)(ws + (n0 < DM ? W_XK : W_XV) + set * W_XKV_SET) + (size_t)(n0 < DM ? n0 : n0 - DM) * DM, DM, scr, lane); }
    }
}
DEV void s5_tables(const float* lam_re, const float* lam_im, const float* log_dt, const float* b_re, const float* b_im, const float* c_re, const float* c_im, unsigned char* ws, int gt, int NGT) {
    bf16* BBAR = (bf16*)(ws + S5T_BBAR); bf16* CT = (bf16*)(ws + S5T_CT); float* A = (float*)(ws + S5T_A); float* AL = (float*)(ws + S5T_AL);
    for (int idx = gt; idx < S5G * S5P; idx += NGT) {
        const int g = idx / S5P, p = idx % S5P;
        const double dt = exp((double)log_dt[g]), lr = (double)lam_re[idx], li = (double)lam_im[idx];
        const double mag = exp(lr * dt), ang = li * dt, ar = mag * cos(ang), ai = mag * sin(ang);
        const double den = lr * lr + li * li, nr = ar - 1.0, zr = (nr * lr + ai * li) / den, zi = (ai * lr - nr * li) / den;
        for (int hi = 0; hi < S5H; ++hi) { const double br = (double)b_re[(size_t)idx * S5H + hi], bi = (double)b_im[(size_t)idx * S5H + hi];
            BBAR[((size_t)(g * 2 + 0) * S5P + p) * S5H + hi] = (bf16)f2bf((float)(zr * br - zi * bi));
            BBAR[((size_t)(g * 2 + 1) * S5P + p) * S5H + hi] = (bf16)f2bf((float)(zr * bi + zi * br)); }
        for (int ho = 0; ho < S5H; ++ho) { const size_t ci = ((size_t)g * S5H + ho) * S5P + p;
            CT[((size_t)(g * 2 + 0) * S5H + ho) * S5P + p] = (bf16)f2bf(c_re[ci]);
            CT[((size_t)(g * 2 + 1) * S5H + ho) * S5P + p] = (bf16)f2bf(-c_im[ci]); }
        A[(size_t)idx * 2] = (float)ar; A[(size_t)idx * 2 + 1] = (float)ai;
        double pr = 1.0, pi = 0.0, qr = ar, qi = ai;
        for (int e = S5_LC; e > 0; e >>= 1) { if (e & 1) { const double t = pr * qr - pi * qi; pi = pr * qi + pi * qr; pr = t; } const double t = qr * qr - qi * qi; qi = 2.0 * qr * qi; qr = t; }
        AL[(size_t)idx * 2] = (float)pr; AL[(size_t)idx * 2 + 1] = (float)pi;
    }
}
DEV void rot_table(float* rot, int gt, int NGT) {
    for (int idx = gt; idx < ROT_NPOS * 128; idx += NGT) { const int pos = idx >> 7, k = idx & 127;
        const double invf = exp(-9.210340371976184 * ((double)k / 127.0)), ang = (double)pos * invf;
        rot[(size_t)idx * 2] = (float)cos(ang); rot[(size_t)idx * 2 + 1] = (float)sin(ang); }
}
DEV void memn_rows(const float* mem, const float* gain, bf16* MEMN, bf16* MEMNP, int gw, int NGW, int lane) {
    for (int row = gw; row < MMEM; row += NGW) {
        const f32x4* xr = (const f32x4*)(mem + (size_t)row * DM) + lane; const f32x4* gr = (const f32x4*)gain + lane;
        f32x4 v[4]; float s = 0.f;
#pragma unroll
        for (int j = 0; j < 4; ++j) { v[j] = xr[64 * j]; s += (v[j][0] * v[j][0] + v[j][1] * v[j][1]) + (v[j][2] * v[j][2] + v[j][3] * v[j][3]); }
        const float r = 1.0f / sqrtf(wave_sum(s) * (1.0f / DM) + EPS);
        const int rowp = (row & ~15) | pos16(row & 15);
#pragma unroll
        for (int j = 0; j < 4; ++j) { const f32x4 g = gr[64 * j]; u32x2 w; w.x = pk2(v[j][0] * r * g[0], v[j][1] * r * g[1]); w.y = pk2(v[j][2] * r * g[2], v[j][3] * r * g[3]);
            *((u32x2*)(MEMN + (size_t)row * DM) + lane + 64 * j) = w; *((u32x2*)(MEMNP + (size_t)rowp * DM) + lane + 64 * j) = w; }
    }
}
DEV void x0_rows(const float* x, bf16* xh, ssq_t* ss0, ssq_t* ss1, int gw, int NGW, int lane) {
    for (int row = gw; row < M; row += NGW) {
        const f32x4* xr = (const f32x4*)(x + (size_t)row * DM) + lane; float s = 0.f;
#pragma unroll
        for (int j = 0; j < 4; ++j) { const f32x4 v = xr[64 * j]; u32x2 w; w.x = pk2(v[0], v[1]); w.y = pk2(v[2], v[3]); *((u32x2*)(xh + (size_t)row * DM) + lane + 64 * j) = w;
            const float q0 = bflo(w.x), q1 = bfhi(w.x), q2 = bflo(w.y), q3 = bfhi(w.y); s += (q0 * q0 + q1 * q1) + (q2 * q2 + q3 * q3); }
        s = wave_sum(s);
        if (lane == 0) { ss0[row] = ss_fix(s); ss1[row] = 0ull; }
    }
}
DEV void final_rows(const bf16* xh, const ssq_t* ssq, const float* gain, float* out, int gw, int NGW, int lane) {
    const f32x4* gr = (const f32x4*)gain + lane; f32x4 g[4];
#pragma unroll
    for (int j = 0; j < 4; ++j) g[j] = gr[64 * j];
    for (int row0 = gw * 4; row0 < M; row0 += NGW * 4) {
        u32x2 v[4][4]; float r[4];
#pragma unroll
        for (int i = 0; i < 4; ++i) { r[i] = 1.0f / sqrtf(ss_val(ssq[row0 + i]) * (1.0f / DM) + EPS); const u32x2* xr = (const u32x2*)(xh + (size_t)(row0 + i) * DM) + lane;
#pragma unroll
            for (int j = 0; j < 4; ++j) v[i][j] = xr[64 * j]; }
#pragma unroll
        for (int i = 0; i < 4; ++i) { f32x4* orow = (f32x4*)(out + (size_t)(row0 + i) * DM) + lane;
#pragma unroll
            for (int j = 0; j < 4; ++j) { f32x4 o; o[0] = bflo(v[i][j].x) * r[i] * g[j][0]; o[1] = bfhi(v[i][j].x) * r[i] * g[j][1]; o[2] = bflo(v[i][j].y) * r[i] * g[j][2]; o[3] = bfhi(v[i][j].y) * r[i] * g[j][3]; orow[64 * j] = o; } }
    }
}
template <int PASS> DEV void s5_pass(const bf16* xh, const ssq_t* ssq, const float* gain, const float* dskip, const unsigned char* ws, float* ES, bf16* YB, LAS unsigned char* lds, int vcu, int G, int tid) {
    const int wave = tid >> 6, lane = tid & 63, fr = lane & 15, fq = lane >> 4;
    const bf16* BBAR = (const bf16*)(ws + S5T_BBAR); const bf16* CT = (const bf16*)(ws + S5T_CT); const float* A = (const float*)(ws + S5T_A);
    LAS float* rtab = (LAS float*)lds;
    constexpr int NT = BATCH * 4 * 8, QLEN = SEQ / 4;
    for (int wt = vcu; wt < NT; wt += G) {
        const int gb = wt & 7, bq = wt >> 3, q4 = bq & 3, b = bq >> 2, g = 8 * gb + wave;
        const int tok0 = b * SEQ + q4 * QLEN;
        __syncthreads();
        for (int t = tid; t < QLEN; t += 512) rtab[t] = frsq(ss_val(ssq[tok0 + t]) * (1.0f / DM) + EPS);
        __syncthreads();
        s16x4 bb[4][2], cc[4][2]; float ar[4][4], ai[4][4];
#pragma unroll
        for (int ct = 0; ct < 4; ++ct) {
#pragma unroll
            for (int part = 0; part < 2; ++part) {
                bb[ct][part] = *(const s16x4*)(BBAR + ((size_t)(g * 2 + part) * S5P + 16 * ct + fr) * S5H + 4 * fq);
                cc[ct][part] = *(const s16x4*)(CT + ((size_t)(g * 2 + part) * S5H + fr) * S5P + 16 * ct + 4 * fq); }
            const f32x4 a0 = *(const f32x4*)(A + ((size_t)g * S5P + 16 * ct + 4 * fq) * 2), a1 = *(const f32x4*)(A + ((size_t)g * S5P + 16 * ct + 4 * fq) * 2 + 4);
            ar[ct][0] = a0[0]; ai[ct][0] = a0[1]; ar[ct][1] = a0[2]; ai[ct][1] = a0[3]; ar[ct][2] = a1[0]; ai[ct][2] = a1[1]; ar[ct][3] = a1[2]; ai[ct][3] = a1[3]; }
        const f32x4 gn = *(const f32x4*)(gain + 16 * g + 4 * fq), dk = *(const f32x4*)(dskip + 16 * g + 4 * fq);
        float xr[4][4], xi[4][4];
        const int bg = b * S5G + g, ch = 16 * q4 + fr;
        float* es = ES + ((size_t)bg * S5_NCH + ch) * 128 + 4 * fq;
#pragma unroll
        for (int ct = 0; ct < 4; ++ct) {
            if (PASS == 3) { const f32x4 r_ = *(const f32x4*)(es + 16 * ct), i_ = *(const f32x4*)(es + 64 + 16 * ct);
#pragma unroll
                for (int i = 0; i < 4; ++i) { xr[ct][i] = r_[i]; xi[ct][i] = i_[i]; } }
            else {
#pragma unroll
                for (int i = 0; i < 4; ++i) { xr[ct][i] = 0.f; xi[ct][i] = 0.f; } } }
        const size_t rowbase = (size_t)(tok0 + S5_LC * fr) * DM + 16 * g + 4 * fq;
        u32x2 nxt = *(const u32x2*)(xh + rowbase);
#pragma unroll 1
        for (int j = 0; j < S5_LC; ++j) {
            const u32x2 cur = nxt; if (j + 1 < S5_LC) nxt = *(const u32x2*)(xh + rowbase + (size_t)(j + 1) * DM);
            const float r = rtab[S5_LC * fr + j];
            const float u0 = bflo(cur.x) * r * gn[0], u1 = bfhi(cur.x) * r * gn[1], u2 = bflo(cur.y) * r * gn[2], u3 = bfhi(cur.y) * r * gn[3];
            const s16x4 ub = pack4(u0, u1, u2, u3);
#pragma unroll
            for (int ct = 0; ct < 4; ++ct) {
                const f32x4 z = {0.f, 0.f, 0.f, 0.f};
                const f32x4 br = MFMA16K16(bb[ct][0], ub, z), bi = MFMA16K16(bb[ct][1], ub, z);
#pragma unroll
                for (int i = 0; i < 4; ++i) { const float nr = br[i] + ar[ct][i] * xr[ct][i] - ai[ct][i] * xi[ct][i], ni = bi[i] + ar[ct][i] * xi[ct][i] + ai[ct][i] * xr[ct][i]; xr[ct][i] = nr; xi[ct][i] = ni; } }
            if (PASS == 3) {
                f32x4 y = {0.f, 0.f, 0.f, 0.f};
#pragma unroll
                for (int ct = 0; ct < 4; ++ct) { y = MFMA16K16(cc[ct][0], pack4(xr[ct][0], xr[ct][1], xr[ct][2], xr[ct][3]), y); y = MFMA16K16(cc[ct][1], pack4(xi[ct][0], xi[ct][1], xi[ct][2], xi[ct][3]), y); }
                u32x2 w; w.x = pk2(gelu_tanh(y[0] + dk[0] * u0), gelu_tanh(y[1] + dk[1] * u1)); w.y = pk2(gelu_tanh(y[2] + dk[2] * u2), gelu_tanh(y[3] + dk[3] * u3));
                *(u32x2*)(YB + rowbase + (size_t)j * DM) = w; }
        }
        if (PASS == 1) {
#pragma unroll
            for (int ct = 0; ct < 4; ++ct) { const f32x4 r_ = {xr[ct][0], xr[ct][1], xr[ct][2], xr[ct][3]}, i_ = {xi[ct][0], xi[ct][1], xi[ct][2], xi[ct][3]};
                *(f32x4*)(es + 16 * ct) = r_; *(f32x4*)(es + 64 + 16 * ct) = i_; } }
    }
}
DEV void s5_carry(float* ES, const unsigned char* ws, int gt, int NGT) {
    const float* AL = (const float*)(ws + S5T_AL);
    for (int idx = gt; idx < BATCH * S5G * S5P; idx += NGT) { const int bg = idx / S5P, k = idx % S5P, g = bg % S5G;
        const float alr = AL[((size_t)g * S5P + k) * 2], ali = AL[((size_t)g * S5P + k) * 2 + 1]; float sr = 0.f, si = 0.f;
        float* p = ES + (size_t)bg * S5_NCH * 128 + k;
        for (int c = 0; c < S5_NCH; ++c) { const float er = p[(size_t)c * 128], ei = p[(size_t)c * 128 + 64]; p[(size_t)c * 128] = sr; p[(size_t)c * 128 + 64] = si;
            const float nr = alr * sr - ali * si + er, ni = alr * si + ali * sr + ei; sr = nr; si = ni; } }
}

#ifndef HOST_EMU
#define LDS_BARRIER() do { asm volatile("s_waitcnt lgkmcnt(0)" ::: "memory"); __builtin_amdgcn_s_barrier(); asm volatile("" ::: "memory"); } while (0)
#else
#define LDS_BARRIER() __syncthreads()
#endif
#ifndef HOST_EMU
#define CORE_PRIO(tid_) do { if (__builtin_amdgcn_readfirstlane((tid_) >> 6) >= 4) __builtin_amdgcn_s_setprio(1); } while (0)
#define CORE_PRIO_END() __builtin_amdgcn_s_setprio(0)
#else
#define CORE_PRIO(cond) do {} while (0)
#define CORE_PRIO_END() do {} while (0)
#endif
constexpr int KTS = 264;
#ifndef HOST_EMU
#define FRAG_PIN() __builtin_amdgcn_sched_barrier(0)
#else
#define FRAG_PIN() do {} while (0)
#endif
#define TILE_MFMA16(acc, rowp, bfrag) do { _Pragma("unroll") for (int s4_ = 0; s4_ < 4; ++s4_) { bf16x8 fr_[4]; \
    _Pragma("unroll") for (int q_ = 0; q_ < 4; ++q_) fr_[q_] = *(const LAS bf16x8*)((rowp) + 16 * (4 * s4_ + q_)); FRAG_PIN(); \
    _Pragma("unroll") for (int q_ = 0; q_ < 4; ++q_) acc = MFMA32(fr_[q_], bfrag[4 * s4_ + q_], acc); FRAG_PIN(); } } while (0)
constexpr int RET_LDS = (2 * 32 + 64) * KTS * 2;
DEV void stage_tile_ld(const bf16* src, size_t ld, int tid, u32x4 (&rg)[2]) {
#pragma unroll
    for (int i = 0; i < 2; ++i) { const int q = tid + 512 * i, row = q >> 5, chk = q & 31; rg[i] = *(const u32x4*)((const char*)src + (size_t)(unsigned)((row * (int)ld + 8 * chk) * 2)); }
}
DEV void stage_tile_st(LAS bf16* dst, int tid, const u32x4 (&rg)[2]) {
#pragma unroll
    for (int i = 0; i < 2; ++i) { const int q = tid + 512 * i, row = q >> 5, chk = q & 31; *(LAS u32x4*)(dst + row * KTS + 8 * chk) = rg[i]; }
}
#define RET_STAGE_LD(...) do { if (!(SKIP & 16)) stage_tile_ld(__VA_ARGS__); } while (0)
template <int SKIP = 0>
DEV void ret_core(const bf16* Q, const bf16* K, const bf16* VT, bf16* O, float* STAT, LAS unsigned char* lds, int vcu, int G, int tid) {
    const int w = tid >> 6, lane = tid & 63, c = lane & 31, hh = lane >> 5;
    LAS bf16* KT0 = (LAS bf16*)lds; LAS bf16* KT1 = KT0 + 32 * KTS; LAS bf16* SB = KT1 + 32 * KTS;
    constexpr int NT = BATCH * RH * 8, NMC = SEQ / RMC;
    bf16x8 idf[2];
#pragma unroll
    for (int sg = 0; sg < 2; ++sg)
#pragma unroll
        for (int e = 0; e < 8; ++e) idf[sg][e] = (16 * sg + 8 * hh + e == c) ? (short)0x3F80 : (short)0;
    CORE_PRIO(tid);
    for (int tsk = vcu; tsk < NT; tsk += G) {
        const int b = tsk >> 5, h = (tsk >> 3) & 3, vs = tsk & 7;
        const float lg = log2f(1.0f - exp2f(-5.0f - (float)h)), g256 = exp2f(lg * (float)RMC);
        f32x16 sacc[2];
#pragma unroll
        for (int vt = 0; vt < 2; ++vt)
#pragma unroll
            for (int r = 0; r < 16; ++r) sacc[vt][r] = 0.f;
        LDS_BARRIER();
        for (int i = tid; i < 64 * KTS / 2; i += 512) ((LAS unsigned*)SB)[i] = 0u;
        LDS_BARRIER();
        const unsigned vtoff = (unsigned)(((RDV * h + 64 * vs + c) * M + 8 * hh) * 2);
        bf16x8 qf[16];
        { const bf16* qrow = Q + (size_t)(b * SEQ + 32 * w + c) * DM + 256 * h + 8 * hh;
#pragma unroll
          for (int s = 0; s < 16; ++s) qf[s] = (SKIP & 32) ? idf[s & 1] : *(const bf16x8*)(qrow + 16 * s); }
        for (int mc = 0; mc < NMC; ++mc) {
            const int T0 = b * SEQ + RMC * mc;
            const bf16* ksrc = K + (size_t)T0 * DM + 256 * h;
            u32x4 rg0[2], rg1[2];
            RET_STAGE_LD(ksrc, DM, tid, rg0);
            f32x16 oacc[2];
#pragma unroll
            for (int vt = 0; vt < 2; ++vt) {
#pragma unroll
                for (int r = 0; r < 16; ++r) oacc[vt][r] = 0.f;
#pragma unroll
                for (int s = 0; s < 16; ++s) if (!(SKIP & 4)) oacc[vt] = MFMA32(*(const LAS bf16x8*)(SB + (32 * vt + c) * KTS + 16 * s + 8 * hh), qf[s], oacc[vt]);
#pragma unroll
                for (int r = 0; r < 16; ++r) { oacc[vt][r] *= g256; sacc[vt][r] *= g256; } }
            stage_tile_st(KT0, tid, rg0);
            RET_STAGE_LD(ksrc + (size_t)32 * DM, DM, tid, rg1);
            LDS_BARRIER();
#pragma unroll
            for (int jt = 0; jt < 8; ++jt) {
                LAS bf16* cur = (jt & 1) ? KT1 : KT0; LAS bf16* nx = (jt & 1) ? KT0 : KT1;
                bf16x8 vf[2][2];
#pragma unroll
                for (int vt = 0; vt < 2; ++vt)
#pragma unroll
                    for (int s2 = 0; s2 < 2; ++s2) vf[vt][s2] = (SKIP & 8) ? idf[s2] : *(const bf16x8*)((const char*)VT + (size_t)(vtoff + (unsigned)(((32 * vt) * M + T0 + 32 * jt + 16 * s2) * 2)));
                FRAG_PIN();
                if (jt < 6) { if (jt & 1) RET_STAGE_LD(ksrc + (size_t)(32 * (jt + 2)) * DM, DM, tid, rg1); else RET_STAGE_LD(ksrc + (size_t)(32 * (jt + 2)) * DM, DM, tid, rg0); }
                FRAG_PIN();
                if (!(SKIP & 1) && w >= jt) {
                    f32x16 X;
#pragma unroll
                    for (int r = 0; r < 16; ++r) X[r] = 0.f;
                    TILE_MFMA16(X, cur + c * KTS + 8 * hh, qf);
                    if (w == jt) {
#pragma unroll
                        for (int r = 0; r < 16; ++r) if (rowmap32(r, hh) > c) X[r] = 0.f; }
#pragma unroll
                    for (int s2 = 0; s2 < 2; ++s2) { const bf16x8 pf = pack8(X[8 * s2], X[8 * s2 + 1], X[8 * s2 + 2], X[8 * s2 + 3], X[8 * s2 + 4], X[8 * s2 + 5], X[8 * s2 + 6], X[8 * s2 + 7]);
#pragma unroll
                        for (int vt = 0; vt < 2; ++vt) oacc[vt] = MFMA32(vf[vt][s2], pf, oacc[vt]); }
                }
                if (jt == 7 && mc + 1 < NMC) { const bf16* qrow = Q + (size_t)(T0 + RMC + 32 * w + c) * DM + 256 * h + 8 * hh;
#pragma unroll
                    for (int s = 0; s < 16; ++s) qf[s] = (SKIP & 32) ? idf[s & 1] : *(const bf16x8*)(qrow + 16 * s); }
                if (!(SKIP & 2)) {
                    f32x16 Xk;
#pragma unroll
                    for (int r = 0; r < 16; ++r) Xk[r] = 0.f;
                    Xk = MFMA32(*(const LAS bf16x8*)(cur + c * KTS + 32 * w + 8 * hh), idf[0], Xk);
                    Xk = MFMA32(*(const LAS bf16x8*)(cur + c * KTS + 32 * w + 16 + 8 * hh), idf[1], Xk);
#pragma unroll
                    for (int s2 = 0; s2 < 2; ++s2) { const bf16x8 kf = pack8(Xk[8 * s2], Xk[8 * s2 + 1], Xk[8 * s2 + 2], Xk[8 * s2 + 3], Xk[8 * s2 + 4], Xk[8 * s2 + 5], Xk[8 * s2 + 6], Xk[8 * s2 + 7]);
#pragma unroll
                        for (int vt = 0; vt < 2; ++vt) sacc[vt] = MFMA32(kf, vf[vt][s2], sacc[vt]); }
                }
                if (jt < 7) { if (jt & 1) stage_tile_st(nx, tid, rg0); else stage_tile_st(nx, tid, rg1); }
                LDS_BARRIER();
            }
            float s1 = 0.f, s2_ = 0.f;
            bf16* orow = O + (size_t)(T0 + 32 * w + c) * RVW + RDV * h + 64 * vs + 8 * hh;
#pragma unroll
            for (int vt = 0; vt < 2; ++vt)
#pragma unroll
                for (int pr = 0; pr < 2; ++pr) { u32x2 g[2];
#pragma unroll
                    for (int k = 0; k < 2; ++k) { const int q = 2 * pr + k; const float a0 = oacc[vt][4 * q], a1 = oacc[vt][4 * q + 1], a2 = oacc[vt][4 * q + 2], a3 = oacc[vt][4 * q + 3];
                        s1 += (a0 + a1) + (a2 + a3); s2_ += (a0 * a0 + a1 * a1) + (a2 * a2 + a3 * a3); g[k].x = pk2(a0, a1); g[k].y = pk2(a2, a3); }
                    *(u32x4*)(orow + 32 * vt + 16 * pr) = widen_pair(g[0], g[1]); }
            s1 += __shfl_xor(s1, 32); s2_ += __shfl_xor(s2_, 32);
            if (hh == 0) { f32x2 sv; sv[0] = s1; sv[1] = s2_; *(f32x2*)(STAT + ((size_t)(T0 + 32 * w + c) * RH + h) * 16 + 2 * vs) = sv; }
#pragma unroll
            for (int vt = 0; vt < 2; ++vt)
#pragma unroll
                for (int q = 0; q < 4; ++q) { u32x2 wv; wv.x = pk2(sacc[vt][4 * q], sacc[vt][4 * q + 1]); wv.y = pk2(sacc[vt][4 * q + 2], sacc[vt][4 * q + 3]);
                    *(LAS u32x2*)(SB + (32 * vt + c) * KTS + 32 * w + 8 * q + 4 * hh) = wv; }
            LDS_BARRIER();
        }
    }
    CORE_PRIO_END();
}

#undef RET_STAGE_LD
struct DiagOrder {
    int nblk, G, c;
    DEV bool next(int i, pg8::Unit& u) const { const int k = i * G + c; if (k >= nblk) return false; u.pm = k; u.pn = k; return true; }
    DEV void a_ready(const pg8::Unit&) const {}
    DEV void done(const pg8::Unit&) const {}
};

DEV void stage_pair_ld(const bf16* src, size_t ld, int tid, u32x4 (&rg)[4]) {
#pragma unroll
    for (int i = 0; i < 4; ++i) { const int q = tid + 512 * i, row = q >> 5, chk = q & 31; rg[i] = *(const u32x4*)((const char*)src + (size_t)(unsigned)((row * (int)ld + 8 * chk) * 2)); }
}
DEV void stage_pair_st(LAS bf16* dst, int tid, const u32x4 (&rg)[4]) {
#pragma unroll
    for (int i = 0; i < 4; ++i) { const int q = tid + 512 * i, row = q >> 5, chk = q & 31; *(LAS u32x4*)(dst + row * KTS + 8 * chk) = rg[i]; }
}
DEV void xattn_core(const bf16* QX, const bf16* XK, const bf16* XVT, bf16* OX, LAS unsigned char* lds, int vcu, int G, int tid) {
    const int w = tid >> 6, lane = tid & 63, c = lane & 31, hh = lane >> 5;
    LAS bf16* T0_ = (LAS bf16*)lds; LAS bf16* T1_ = T0_ + 64 * KTS;
    constexpr int NQB = SEQ / 256, NU = BATCH * XH * NQB;
    for (int un = vcu; un < NU; un += G) {
        const int qb = un % NQB, bh = un / NQB, h = bh & 3, b = bh >> 2;
        const size_t R0 = (size_t)b * SEQ + 256 * qb + 32 * w + c;
        const bf16* ksrc = XK + (size_t)(b * NMEM) * DM + 256 * h;
        const bf16* vsrc = XVT + (size_t)(256 * h) * MMEM + b * NMEM;
#define XA_LD(p, rg) do { if ((p) < 4) stage_pair_ld(ksrc + (size_t)(64 * (p)) * DM, DM, tid, rg); else stage_pair_ld(vsrc + (size_t)(64 * ((p) - 4)) * MMEM, MMEM, tid, rg); } while (0)
        u32x4 rg0[4];
        f32x16 st[8];
        XA_LD(0, rg0);
        bf16x8 qf[16];
#pragma unroll
        for (int s = 0; s < 16; ++s) qf[s] = *(const bf16x8*)(QX + R0 * DM + 256 * h + 16 * s + 8 * hh);
        LDS_BARRIER();
        stage_pair_st(T0_, tid, rg0);
        LDS_BARRIER();
#pragma unroll
        for (int kp = 0; kp < 4; ++kp) {
            LAS bf16* cur = (kp & 1) ? T1_ : T0_; LAS bf16* nx = (kp & 1) ? T0_ : T1_;
            XA_LD(kp + 1, rg0);
#pragma unroll
            for (int t2 = 0; t2 < 2; ++t2) {
#pragma unroll
                for (int r = 0; r < 16; ++r) st[2 * kp + t2][r] = 0.f;
                TILE_MFMA16(st[2 * kp + t2], cur + (32 * t2 + c) * KTS + 8 * hh, qf); }
            stage_pair_st(nx, tid, rg0);
            LDS_BARRIER();
        }
        float mx = st[0][0];
#pragma unroll
        for (int kt = 0; kt < 8; ++kt)
#pragma unroll
            for (int r = 0; r < 16; ++r) mx = fmaxf(mx, st[kt][r]);
        mx = fmaxf(mx, __shfl_xor(mx, 32));
        const float c2 = 1.4426950408889634f * 0.0625f, mc2 = -mx * c2; float l = 0.f;
        bf16x8 pf[16];
#pragma unroll
        for (int kt = 0; kt < 8; ++kt) {
#pragma unroll
            for (int r = 0; r < 16; ++r) { const float p = fexp2(st[kt][r] * c2 + mc2); st[kt][r] = p; l += p; }
#pragma unroll
            for (int s2 = 0; s2 < 2; ++s2) pf[2 * kt + s2] = pack8(st[kt][8 * s2], st[kt][8 * s2 + 1], st[kt][8 * s2 + 2], st[kt][8 * s2 + 3], st[kt][8 * s2 + 4], st[kt][8 * s2 + 5], st[kt][8 * s2 + 6], st[kt][8 * s2 + 7]); }
        l += __shfl_xor(l, 32);
        const float il = 1.0f / l;
        bf16* orow = OX + R0 * DM + 256 * h + 8 * hh;
#pragma unroll
        for (int dp = 0; dp < 4; ++dp) {
            LAS bf16* cur = (dp & 1) ? T1_ : T0_; LAS bf16* nx = (dp & 1) ? T0_ : T1_;
            if (dp < 3) XA_LD(dp + 5, rg0);
#pragma unroll
            for (int t2 = 0; t2 < 2; ++t2) { const int dt = 2 * dp + t2;
                f32x16 ot;
#pragma unroll
                for (int r = 0; r < 16; ++r) ot[r] = 0.f;
                TILE_MFMA16(ot, cur + (32 * t2 + c) * KTS + 8 * hh, pf);
#pragma unroll
                for (int pr = 0; pr < 2; ++pr) { u32x2 g0, g1; g0.x = pk2(ot[8 * pr] * il, ot[8 * pr + 1] * il); g0.y = pk2(ot[8 * pr + 2] * il, ot[8 * pr + 3] * il); g1.x = pk2(ot[8 * pr + 4] * il, ot[8 * pr + 5] * il); g1.y = pk2(ot[8 * pr + 6] * il, ot[8 * pr + 7] * il);
                    *(u32x4*)(orow + 32 * dt + 16 * pr) = widen_pair(g0, g1); } }
            if (dp < 3) stage_pair_st(nx, tid, rg0);
            LDS_BARRIER();
        }
#undef XA_LD
    }
}
#ifndef HOST_EMU
#define RLX_AGENT __ATOMIC_RELAXED, __HIP_MEMORY_SCOPE_AGENT
#define XB_TMO      128
#define XB_XCNT(j)  (256  + 64 * (j))
#define XB_XSUB(j)  (1280 + 64 * (j))
#define XB_XGEN(j)  (2304 + 64 * (j))
#define XB_TOP      3328
#define XB_TOPGEN   3392
#define XCD_BAR_WORDS 3456
#define XB_SPIN_CAP (1u << 18)

__device__ __forceinline__ unsigned xb_ld(unsigned* p)              { return __hip_atomic_load(p, __ATOMIC_RELAXED, __HIP_MEMORY_SCOPE_AGENT); }
__device__ __forceinline__ unsigned xb_add(unsigned* p, unsigned v) { return __hip_atomic_fetch_add(p, v, __ATOMIC_RELAXED, __HIP_MEMORY_SCOPE_AGENT); }
__device__ __forceinline__ unsigned xb_xcc_id() { return (unsigned)__builtin_amdgcn_s_getreg((3 << 11) | 20) & 0xFu; }
#define XB_SPIN(cond, bar) do { unsigned _sp = 0; while (cond) { __builtin_amdgcn_s_sleep(1); \
    if ((++_sp & 255u) == 0u) { if (xb_ld(&(bar)[XB_TMO])) break; if (_sp > XB_SPIN_CAP) { atomicAdd(&(bar)[XB_TMO], 1u); break; } } } } while (0)

struct XcdBarrier {
    unsigned* bar; unsigned x;
    volatile LAS unsigned* st;
};

__device__ __forceinline__ XcdBarrier xcd_barrier_post(unsigned* bar, volatile LAS unsigned* st) {
    XcdBarrier b; b.bar = bar; b.x = xb_xcc_id(); b.st = st;
    if (threadIdx.x == 0) (void)xb_add(&bar[XB_XCNT(b.x)], 1u);
    return b;
}
__device__ __forceinline__ void xcd_barrier_complete(unsigned* bar, unsigned x, unsigned& nloc, unsigned& nx) {
    const unsigned G = gridDim.x * gridDim.y * gridDim.z;
    unsigned sum, cnt, mine, sp = 0u;
    for (;;) {
        sum = 0u; cnt = 0u; mine = 0u;
#pragma unroll
        for (unsigned j = 0; j < 16; ++j) { const unsigned c = xb_ld(&bar[XB_XCNT(j)]); sum += c; cnt += (c > 0u) ? 1u : 0u; mine = (j == x) ? c : mine; }
        if (sum == G) break;
        __builtin_amdgcn_s_sleep(1);
        if ((++sp & 255u) == 0u) { if (xb_ld(&bar[XB_TMO])) break; if (sp > XB_SPIN_CAP) { atomicAdd(&bar[XB_TMO], 1u); break; } }
    }
    nloc = mine > 0u ? mine : 1u; nx = cnt > 0u ? cnt : 1u;
}

__device__ __forceinline__ void xcd_barrier(const XcdBarrier& b) {
    asm volatile("s_waitcnt vmcnt(0)" ::: "memory");
    __syncthreads();
    if (threadIdx.x == 0) {
        unsigned* bar = b.bar;
        __builtin_amdgcn_s_waitcnt(0);
        unsigned nloc = b.st[0], nx = b.st[1];
        if (nloc == 0u) { xcd_barrier_complete(bar, b.x, nloc, nx); b.st[0] = nloc; b.st[1] = nx; }
        const unsigned old = xb_add(&bar[XB_XSUB(b.x)], 1u);
        const unsigned gen = old / nloc;
        if (old + 1u == (gen + 1u) * nloc) {
            __builtin_amdgcn_fence(__ATOMIC_RELEASE, "agent");
            asm volatile("s_waitcnt vmcnt(0)" ::: "memory");
            const unsigned og = xb_add(&bar[XB_TOP], 1u);
            const unsigned tg = og / nx;
            if (og + 1u == (tg + 1u) * nx) xb_add(&bar[XB_TOPGEN], 1u);
            else XB_SPIN(xb_ld(&bar[XB_TOPGEN]) == tg, bar);
            __builtin_amdgcn_fence(__ATOMIC_ACQUIRE, "agent");
            xb_add(&bar[XB_XGEN(b.x)], 1u);
            asm volatile("s_waitcnt vmcnt(0)" ::: "memory");
        } else {
            XB_SPIN(xb_ld(&bar[XB_XGEN(b.x)]) == gen, bar);
            __builtin_amdgcn_fence(__ATOMIC_ACQUIRE, "agent");
            asm volatile("s_waitcnt vmcnt(0)" ::: "memory");
        }
    }
    __syncthreads();
}
#endif
#ifndef HOST_EMU
constexpr int NWAVES = 8;
constexpr int RING_BYTES = 131072, LDSCTL_OFF = RING_BYTES, MISC_OFF = LDSCTL_OFF + 320, LDS_BYTES = 147456;
constexpr int PTAB_OFF = LDSCTL_OFF + 1024;
constexpr int CW_BAR = 4096;
#ifndef MK_PER_PHASE
#define MK_PER_PHASE 0
#endif
constexpr int PH_PER_LAYER = 12, PH_FINAL = 1 + PH_PER_LAYER * DEPTH, N_PHASES = PH_FINAL + 1;
static_assert(RET_LDS <= RING_BYTES, "lds");

DEV volatile LAS unsigned long long* ptab_base(LAS unsigned char* lds) { unsigned o = PTAB_OFF; asm volatile("" : "+v"(o)); return (volatile LAS unsigned long long*)(lds + o); }
DEV unsigned long long ldptr(volatile LAS unsigned long long* pt, int k) { const unsigned long long v = pt[k];
    const unsigned lo = __builtin_amdgcn_readfirstlane((unsigned)v), hi = __builtin_amdgcn_readfirstlane((unsigned)(v >> 32)); return ((unsigned long long)hi << 32) | lo; }
#ifndef KB_REP
#define KB_REP 0
#endif
#define REPS(k) (1 + ((KB_REP >> (k)) & 1))
#ifndef KB_FFN_SPLIT
#define KB_FFN_SPLIT 1
#endif
#ifndef KB_FFN_MERGE
#define KB_FFN_MERGE 0
#endif
#define FFN_NBLK (KB_FFN_MERGE ? 2 : KB_FFN_SPLIT)
#ifndef KB_STAGGER
#define KB_STAGGER 0
#endif
#ifndef KB_RSTAG
#define KB_RSTAG 0
#endif
#define RSTAG() do { if (KB_RSTAG) { if ((LG(bx) >> 3) & 1) { for (int i_ = 0; i_ < KB_RSTAG; ++i_) __builtin_amdgcn_s_sleep(127); } } } while (0)
#ifndef KB_PHMASK1
#define KB_PHMASK1 0xFFF
#endif
#ifndef KB_FINAL_SS
#define KB_FINAL_SS 0
#endif
#ifndef KB_LAYERS
#define KB_LAYERS 4
#endif
#ifndef KB_PHMASK
#define KB_PHMASK 0xFFF
#endif
DEV bool ph_enabled(int k) { if (k == 0 || k >= 1 + PH_PER_LAYER * DEPTH) return true; const int L = (k - 1) / PH_PER_LAYER, s = (k - 1) % PH_PER_LAYER; return L < KB_LAYERS && ((((L & 1) ? KB_PHMASK1 : KB_PHMASK) >> s) & 1); }
DEV int lane_id_fresh() { unsigned m = ~0u; asm volatile("" : "+s"(m)); return (int)__builtin_amdgcn_mbcnt_hi(m, __builtin_amdgcn_mbcnt_lo(m, 0u)); }
DEV XcdBarrier mk_bar(unsigned* p, volatile LAS unsigned* st) { XcdBarrier b; b.bar = p; b.x = xb_xcc_id(); b.st = st; return b; }
struct Args { const void* in[24]; float* out; unsigned char* ws; int ph_lo, ph_hi, li, pad; };

__global__ void __launch_bounds__(NWAVES * 64, 2) hybrid_fwd(Args args) {
    extern __shared__ __attribute__((aligned(16))) unsigned char lds_raw[];
    LAS unsigned char* lds = (LAS unsigned char*)lds_raw;
    volatile LAS unsigned* MISC = (volatile LAS unsigned*)(lds + MISC_OFF);
    const int tid0 = threadIdx.x; const int wave0 = __builtin_amdgcn_readfirstlane(tid0 >> 6);
    const int G = gridDim.x, bx = blockIdx.x, vcu = (G % 8 == 0) ? (bx % 8) * (G / 8) + bx / 8 : bx;
    const int NGW = G * NWAVES, NGT = G * NWAVES * 64;
#define LG(v) ({ int v_ = (v); asm volatile("" : "+s"(v_)); v_; })
#define PH_IDS int tid = LG(wave0) * 64 + lane_id_fresh(); asm volatile("" : "+v"(tid)); const int lane = tid & 63, wave = __builtin_amdgcn_readfirstlane(tid >> 6), gw = LG(vcu) * NWAVES + wave, gt = LG(vcu) * (NWAVES * 64) + tid; (void)lane; (void)gw; (void)gt;
    for (int u = tid0; u < (LDS_BYTES - LDSCTL_OFF) / 4; u += NWAVES * 64) ((LAS unsigned*)(lds + LDSCTL_OFF))[u] = 0u;
    __syncthreads();
    volatile LAS unsigned long long* PT = (volatile LAS unsigned long long*)(lds + PTAB_OFF);
    if (tid0 < 24) PT[tid0] = (unsigned long long)args.in[tid0];
    if (tid0 == 24) PT[24] = (unsigned long long)args.out;
    if (tid0 == 25) PT[25] = (unsigned long long)args.ws;
    __syncthreads();
#define PTR(k) ((const void*)(GAS const void*)ldptr(ptab_base(lds), (k)))
    (void)xcd_barrier_post((unsigned*)(args.ws + WS_CTL) + CW_BAR + args.li * XCD_BAR_WORDS, MISC + 8);
    const int li_ = args.li;
#define bar mk_bar((unsigned*)((unsigned char*)PTR(25) + WS_CTL) + CW_BAR + LG(li_) * XCD_BAR_WORDS, (volatile LAS unsigned*)(lds + MISC_OFF) + 8)
    const int lo = args.ph_lo, hi = args.ph_hi;
#if MK_PER_PHASE || defined(KB_DEBUG)
#define RUN(k) (lo <= (k) && (k) < hi && ph_enabled(k))
#define SEAM(k) do { if (RUN(k) && RUN((k) + 1)) xcd_barrier(bar); } while (0)
#else
#define RUN(k) true
#define SEAM(k) xcd_barrier(bar)
#endif
#define WSP ((unsigned char*)PTR(25))
#define OUTP ((float*)PTR(24))
#define INF(k) ((const float*)PTR(k))
    LAS unsigned char* ring = lds;

    for (int rep_ = 0; rep_ < REPS(11); ++rep_) { if (rep_) xcd_barrier(bar);
    if (RUN(0)) { PH_IDS unsigned char* ws = WSP; ssq_t* SS0 = (ssq_t*)(ws + WS_SSQ);
        rot_table((float*)(ws + WS_ROT), gt, NGT);
        for (int j = 0; j < DEPTH / 2; ++j) s5_tables(INF(10) + (size_t)j * S5G * S5P, INF(11) + (size_t)j * S5G * S5P, INF(12) + (size_t)j * S5G, INF(13) + (size_t)j * S5G * S5P * S5H, INF(14) + (size_t)j * S5G * S5P * S5H,
                                                      INF(15) + (size_t)j * S5G * S5H * S5P, INF(16) + (size_t)j * S5G * S5H * S5P, ws + (size_t)j * S5T_STRIDE, gt, NGT); memn_rows(INF(1), INF(4), (bf16*)(ws + WS_MEMN), (bf16*)(ws + WS_MEMNP), gw, NGW, lane); x0_rows(INF(0), (bf16*)(ws + WS_XHAT), SS0, SS0 + M, gw, NGW, lane); }
    }
    for (int L = 0; L < DEPTH; ++L) {
        const int pb = 1 + PH_PER_LAYER * L; const bool isret = (L & 1) != 0; const int j = L >> 1;
for (int rep_ = 0; rep_ < REPS(0); ++rep_) { if (rep_) xcd_barrier(bar);
        if (RUN(pb + 0)) { PH_IDS unsigned char* ws = WSP;
            LayerW lw;
            lw.g = INF(3) + (size_t)L * 4 * DM;
            lw.f1in = INF(6) + (size_t)L * DM * 2 * DFF; lw.f1out = INF(7) + (size_t)L * DFF * DM;
            lw.f2in = INF(8) + (size_t)L * DM * 2 * DFF; lw.f2out = INF(9) + (size_t)L * DFF * DM;
            lw.mixin = isret ? INF(19) + (size_t)j * DM * RIN : INF(18) + (size_t)j * DM * 2 * DM;
            lw.mixout = isret ? INF(20) + (size_t)j * RVW * DM : nullptr;
            lw.xq = INF(21) + (size_t)L * DM * DM; lw.xkv = INF(22) + (size_t)L * DM * 2 * DM; lw.xkv2 = INF(22) + (size_t)(L + 1 < DEPTH ? L + 1 : L) * DM * 2 * DM; lw.xo = INF(23) + (size_t)L * DM * DM;
            lw.is_ret = isret ? 1 : 0;
            convert_layer(lw, ws, (LAS float*)(ring + wave * 16384), gw, NGW, lane);
        }
}
        SEAM(pb + 0);
for (int rep_ = 0; rep_ < REPS(1); ++rep_) { if (rep_) xcd_barrier(bar);
        if (RUN(pb + 1)) { unsigned char* ws = WSP; ssq_t* SS0 = (ssq_t*)(ws + WS_SSQ);
#if KB_FFN_MERGE
            { pg8::Gemm g{(const bf16*)(ws + WS_XHAT), (const bf16*)(ws + W_F1IN), M / 2, 2 * DFF, DM}; pg8::StaticOrder S; S.init(M / 2, 2 * DFF, LG(G), LG(bx)); EpiSwiGLU E{(bf16*)(ws + BIG_H), SS0};
              pg8::gemm_phase<EpiSwiGLU, pg8::StaticOrder, true, true>(ring, g, S, E, LG(wave0)); }
            xcd_barrier(bar);
            { const int par_ = (LG(bx) >> 3) & 1; const size_t r1 = (size_t)(M / 2);
              for (int i_ = 0; i_ < 2; ++i_) {
                if ((i_ ^ par_) == 0) { pg8::Gemm g{(const bf16*)(ws + BIG_H), (const bf16*)(ws + W_F1OUT), M / 2, DM, DFF}; pg8::StaticOrder S; S.init(M / 2, DM, LG(G), LG(bx)); EpiResid E{(bf16*)(ws + WS_XHAT), (SS0 + M), SS0, 0.5f};
                    pg8::gemm_phase<EpiResid, pg8::StaticOrder, true, true>(ring, g, S, E, LG(wave0)); }
                else { pg8::Gemm g{(const bf16*)(ws + WS_XHAT) + r1 * DM, (const bf16*)(ws + W_F1IN), M / 2, 2 * DFF, DM}; pg8::StaticOrder S; S.init(M / 2, 2 * DFF, LG(G), LG(bx)); EpiSwiGLU E{(bf16*)(ws + BIG_H) + r1 * DFF, SS0 + r1};
                    pg8::gemm_phase<EpiSwiGLU, pg8::StaticOrder, true, true>(ring, g, S, E, LG(wave0)); } } }
#else
            for (int hb = 0; hb < KB_FFN_SPLIT; ++hb) { const size_t r0 = (size_t)hb * (M / KB_FFN_SPLIT);
                { pg8::Gemm g{(const bf16*)(ws + WS_XHAT) + r0 * DM, (const bf16*)(ws + W_F1IN), M / KB_FFN_SPLIT, 2 * DFF, DM}; pg8::StaticOrder S; S.init(M / KB_FFN_SPLIT, 2 * DFF, LG(G), LG(bx)); EpiSwiGLU E{(bf16*)(ws + BIG_H) + r0 * DFF, SS0 + r0};
                  pg8::gemm_phase<EpiSwiGLU, pg8::StaticOrder, true, true>(ring, g, S, E, LG(wave0)); }
                if (hb + 1 < KB_FFN_SPLIT) { xcd_barrier(bar);
                    pg8::Gemm g{(const bf16*)(ws + BIG_H) + r0 * DFF, (const bf16*)(ws + W_F1OUT), M / KB_FFN_SPLIT, DM, DFF}; pg8::StaticOrder S; S.init(M / KB_FFN_SPLIT, DM, LG(G), LG(bx)); EpiResid E{(bf16*)(ws + WS_XHAT) + r0 * DM, (SS0 + M) + r0, SS0 + r0, 0.5f};
                    pg8::gemm_phase<EpiResid, pg8::StaticOrder, true, true>(ring, g, S, E, LG(wave0)); xcd_barrier(bar); } }
#endif
        }
}
        SEAM(pb + 1);
        if (RUN(pb + 2)) { unsigned char* ws = WSP; ssq_t* SS0 = (ssq_t*)(ws + WS_SSQ); const size_t r0 = (size_t)(FFN_NBLK - 1) * (M / FFN_NBLK);
            pg8::Gemm g{(const bf16*)(ws + BIG_H) + r0 * DFF, (const bf16*)(ws + W_F1OUT), M / FFN_NBLK, DM, DFF}; pg8::StaticOrder S; S.init(M / FFN_NBLK, DM, LG(G), LG(bx)); EpiResid E{(bf16*)(ws + WS_XHAT) + r0 * DM, (SS0 + M) + r0, SS0 + r0, 0.5f};
            pg8::gemm_phase<EpiResid, pg8::StaticOrder, true, true>(ring, g, S, E, LG(wave0)); }
        SEAM(pb + 2);
        if ((KB_REP >> 8) & 1) { unsigned char* ws = WSP; pg8::Gemm g{(const bf16*)(ws + WS_XHAT), (const bf16*)(ws + W_F1IN), M, 2 * DFF, DM}; pg8::StaticOrder S; S.init(M, 2 * DFF, LG(G), LG(bx)); EpiNull E{};
            pg8::gemm_phase<EpiNull, pg8::StaticOrder, true, true>(ring, g, S, E, LG(wave0)); xcd_barrier(bar); }
        if ((KB_REP >> 9) & 1) { unsigned char* ws = WSP; pg8::Gemm g{(const bf16*)(ws + BIG_H), (const bf16*)(ws + W_F1OUT), M, DM, DFF}; pg8::StaticOrder S; S.init(M, DM, LG(G), LG(bx)); EpiNull E{};
            pg8::gemm_phase<EpiNull, pg8::StaticOrder, true, true>(ring, g, S, E, LG(wave0)); xcd_barrier(bar); }
        if ((KB_REP >> 10) & 1) { unsigned char* ws = WSP; pg8::Gemm g{(const bf16*)(ws + BIG_H), (const bf16*)(ws + W_F1OUT), M, DM, DFF}; pg8::StaticOrder S; S.init(M, DM, LG(G), LG(bx));
            EpiResid E{(bf16*)(ws + WS_BIG + 384 * MiB), (ssq_t*)(ws + WS_BIG + 770 * MiB), (ssq_t*)(ws + WS_BIG + 771 * MiB), 0.5f};
            pg8::gemm_phase<EpiResid, pg8::StaticOrder, true, true>(ring, g, S, E, LG(wave0)); xcd_barrier(bar); }
        if (!isret) {
for (int rep_ = 0; rep_ < REPS(2); ++rep_) { if (rep_) xcd_barrier(bar);
            if (RUN(pb + 3)) { PH_IDS unsigned char* ws = WSP; s5_pass<1>((const bf16*)(ws + WS_XHAT), (const ssq_t*)(ws + WS_SSQ) + M, INF(3) + ((size_t)L * 4 + 1) * DM, INF(17) + (size_t)j * DM, ws + (size_t)j * S5T_STRIDE, (float*)(ws + BIG_ES), (bf16*)(ws + BIG_YB), ring, LG(vcu), LG(G), tid); }
            SEAM(pb + 3);
            if (RUN(pb + 4)) { PH_IDS unsigned char* ws = WSP; s5_carry((float*)(ws + BIG_ES), ws + (size_t)j * S5T_STRIDE, gt, NGT);
                for (int set = 0; set < 2; ++set) {
                    { pg8::Gemm g{(const bf16*)(ws + WS_MEMN), (const bf16*)(ws + W_XK + set * W_XKV_SET), MMEM, DM, DM}; pg8::StaticOrder S; S.init(MMEM, DM, LG(G), (LG(bx) + (2 * set) * (LG(G) / 4)) % LG(G)); EpiBf16<0> E{(bf16*)(ws + WS_XK + set * XKV_SET), DM, nullptr};
                      pg8::gemm_phase<EpiBf16<0>, pg8::StaticOrder, true, true>(ring, g, S, E, LG(wave0)); }
                    { pg8::Gemm g{(const bf16*)(ws + W_XV + set * W_XKV_SET), (const bf16*)(ws + WS_MEMNP), DM, MMEM, DM}; pg8::StaticOrder S; S.init(DM, MMEM, LG(G), (LG(bx) + (2 * set + 1) * (LG(G) / 4)) % LG(G)); EpiBf16<0> E{(bf16*)(ws + WS_XVT + set * XKV_SET), MMEM, nullptr};
                      pg8::gemm_phase<EpiBf16<0>, pg8::StaticOrder, true, true>(ring, g, S, E, LG(wave0)); } } }
            SEAM(pb + 4);
            if (RUN(pb + 5)) { PH_IDS unsigned char* ws = WSP; s5_pass<3>((const bf16*)(ws + WS_XHAT), (const ssq_t*)(ws + WS_SSQ) + M, INF(3) + ((size_t)L * 4 + 1) * DM, INF(17) + (size_t)j * DM, ws + (size_t)j * S5T_STRIDE, (float*)(ws + BIG_ES), (bf16*)(ws + BIG_YB), ring, LG(vcu), LG(G), tid); }
}
            SEAM(pb + 5);
            if (RUN(pb + 6)) { unsigned char* ws = WSP; ssq_t* SS0 = (ssq_t*)(ws + WS_SSQ);
                RSTAG(); pg8::Gemm g{(const bf16*)(ws + BIG_YB), (const bf16*)(ws + W_MIX), M, 2 * DM, DM}; pg8::StaticOrder S; S.init(M, 2 * DM, LG(G), LG(bx)); EpiS5Glu E{(bf16*)(ws + WS_XHAT), SS0, SS0 + M};
                pg8::gemm_phase<EpiS5Glu, pg8::StaticOrder, true, true>(ring, g, S, E, LG(wave0)); }
            SEAM(pb + 6);
        } else {
for (int rep_ = 0; rep_ < REPS(3); ++rep_) { if (rep_) xcd_barrier(bar);
            if (RUN(pb + 3)) { unsigned char* ws = WSP;
                { pg8::Gemm g{(const bf16*)(ws + WS_XHAT), (const bf16*)(ws + W_MIX), M, 2 * DM, DM}; pg8::StaticOrder S; S.init(M, 2 * DM, LG(G), LG(bx));
                  EpiRetIn E{(bf16*)(ws + BIG_RQ), (bf16*)(ws + BIG_RK), (const ssq_t*)(ws + WS_SSQ) + M, (const float*)(ws + WS_ROT), (const int*)PTR(2)};
                  pg8::gemm_phase<EpiRetIn, pg8::StaticOrder, true, true>(ring, g, S, E, LG(wave0)); }
                { pg8::Gemm g{(const bf16*)(ws + W_MIX) + (size_t)(2 * DM) * DM, (const bf16*)(ws + WS_XHAT), RVW, M, DM}; pg8::StaticOrder S; S.init(RVW, M, LG(G), LG(bx));
                  EpiRetVT E{(bf16*)(ws + BIG_RVT), (const ssq_t*)(ws + WS_SSQ) + M};
                  pg8::gemm_phase<EpiRetVT, pg8::StaticOrder, true, true>(ring, g, S, E, LG(wave0)); } }
}
            SEAM(pb + 3);
            for (int rep_ = 0; rep_ < REPS(4); ++rep_) { if (rep_) xcd_barrier(bar);
#if defined(KB_RET_STUB)
            if (RUN(pb + 4)) { PH_IDS unsigned char* ws = WSP; bf16* ro = (bf16*)(ws + BIG_RO); const bf16* rq = (const bf16*)(ws + (KB_RET_STUB == 1 ? BIG_RQ : BIG_RK)); float* rst = (float*)(ws + BIG_RST);
                for (size_t i = gt; i < (size_t)M * RVW / 8; i += NGT) { const size_t row = i / (RVW / 8), c8 = i % (RVW / 8); u32x4 v;
                    if (KB_RET_STUB == 3) v = *(const u32x4*)((const bf16*)(ws + BIG_RVT) + (c8 * 8) * (size_t)M / 8 * 8 + row / 8 * 8 + 0) ; else v = *(const u32x4*)(rq + row * DM + (c8 & 127) * 8);
                    *(u32x4*)(ro + i * 8) = v; }
                for (size_t i = gt; i < (size_t)M * RH * 8; i += NGT) { rst[2 * i] = 0.f; rst[2 * i + 1] = 64.f; } }
#else
            if (RUN(pb + 4)) { PH_IDS unsigned char* ws = WSP;

                ret_core((const bf16*)(ws + BIG_RQ), (const bf16*)(ws + BIG_RK), (const bf16*)(ws + BIG_RVT), (bf16*)(ws + BIG_RO), (float*)(ws + BIG_RST), ring, LG(vcu), LG(G), tid); }
#endif
}
#ifdef KB_PROBE_SKIP
            { xcd_barrier(bar); PH_IDS unsigned char* ws = WSP; ret_core<KB_PROBE_SKIP>((const bf16*)(ws + BIG_RQ), (const bf16*)(ws + BIG_RK), (const bf16*)(ws + BIG_RVT), (bf16*)OUTP, (float*)((char*)OUTP + 0), ring, LG(vcu), LG(G), tid); }
#endif
            SEAM(pb + 4);
            if (RUN(pb + 5)) { unsigned char* ws = WSP;
                pg8::Gemm g{(const bf16*)(ws + WS_XHAT), (const bf16*)(ws + W_MIX) + (size_t)(2 * DM + RVW) * DM, M, RVW, DM}; pg8::StaticOrder S; S.init(M, RVW, LG(G), LG(bx));
                EpiRetGate E{(bf16*)(ws + BIG_RO), (const ssq_t*)(ws + WS_SSQ) + M, (const float*)(ws + BIG_RST)};
                pg8::gemm_phase<EpiRetGate, pg8::StaticOrder, true, true>(ring, g, S, E, LG(wave0)); }
            SEAM(pb + 5);
            if (RUN(pb + 6)) { unsigned char* ws = WSP; ssq_t* SS0 = (ssq_t*)(ws + WS_SSQ);
                RSTAG(); pg8::Gemm g{(const bf16*)(ws + BIG_RO), (const bf16*)(ws + W_ROUT), M, DM, RVW}; pg8::StaticOrder S; S.init(M, DM, LG(G), LG(bx)); EpiResid E{(bf16*)(ws + WS_XHAT), SS0, SS0 + M, 1.0f};
                pg8::gemm_phase<EpiResid, pg8::StaticOrder, true, true>(ring, g, S, E, LG(wave0)); }
            SEAM(pb + 6);
        }
for (int rep_ = 0; rep_ < REPS(5); ++rep_) { if (rep_) xcd_barrier(bar);
        if (RUN(pb + 7)) { unsigned char* ws = WSP;
            pg8::Gemm g{(const bf16*)(ws + WS_XHAT), (const bf16*)(ws + W_XQ), M, DM, DM}; pg8::StaticOrder S; S.init(M, DM, LG(G), LG(bx));
            EpiBf16<1> E{(bf16*)(ws + BIG_XQ), DM, (const ssq_t*)(ws + WS_SSQ)}; pg8::gemm_phase<EpiBf16<1>, pg8::StaticOrder, true, true>(ring, g, S, E, LG(wave0)); }
}
        SEAM(pb + 7);
for (int rep_ = 0; rep_ < REPS(6); ++rep_) { if (rep_) xcd_barrier(bar);
        if (RUN(pb + 8)) { PH_IDS unsigned char* ws = WSP; xattn_core((const bf16*)(ws + BIG_XQ), (const bf16*)(ws + WS_XK + (L & 1) * XKV_SET), (const bf16*)(ws + WS_XVT + (L & 1) * XKV_SET), (bf16*)(ws + BIG_XO), ring, LG(vcu), LG(G), tid); }
}
        SEAM(pb + 8);
        if (RUN(pb + 9)) { unsigned char* ws = WSP; ssq_t* SS0 = (ssq_t*)(ws + WS_SSQ);
            RSTAG(); pg8::Gemm g{(const bf16*)(ws + BIG_XO), (const bf16*)(ws + W_XO), M, DM, DM}; pg8::StaticOrder S; S.init(M, DM, LG(G), LG(bx)); EpiResid E{(bf16*)(ws + WS_XHAT), SS0 + M, SS0, 1.0f};
            pg8::gemm_phase<EpiResid, pg8::StaticOrder, true, true>(ring, g, S, E, LG(wave0)); }
        SEAM(pb + 9);
for (int rep_ = 0; rep_ < REPS(7); ++rep_) { if (rep_) xcd_barrier(bar);
        if (RUN(pb + 10)) { unsigned char* ws = WSP; ssq_t* SS0 = (ssq_t*)(ws + WS_SSQ);
#if KB_FFN_MERGE
            { pg8::Gemm g{(const bf16*)(ws + WS_XHAT), (const bf16*)(ws + W_F2IN), M / 2, 2 * DFF, DM}; pg8::StaticOrder S; S.init(M / 2, 2 * DFF, LG(G), LG(bx)); EpiSwiGLU E{(bf16*)(ws + BIG_H), (SS0 + M)};
              pg8::gemm_phase<EpiSwiGLU, pg8::StaticOrder, true, true>(ring, g, S, E, LG(wave0)); }
            xcd_barrier(bar);
            { const int par_ = (LG(bx) >> 3) & 1; const size_t r1 = (size_t)(M / 2);
              for (int i_ = 0; i_ < 2; ++i_) {
                if ((i_ ^ par_) == 0) { pg8::Gemm g{(const bf16*)(ws + BIG_H), (const bf16*)(ws + W_F2OUT), M / 2, DM, DFF}; pg8::StaticOrder S; S.init(M / 2, DM, LG(G), LG(bx)); EpiResid E{(bf16*)(ws + WS_XHAT), SS0, (SS0 + M), 0.5f};
                    pg8::gemm_phase<EpiResid, pg8::StaticOrder, true, true>(ring, g, S, E, LG(wave0)); }
                else { pg8::Gemm g{(const bf16*)(ws + WS_XHAT) + r1 * DM, (const bf16*)(ws + W_F2IN), M / 2, 2 * DFF, DM}; pg8::StaticOrder S; S.init(M / 2, 2 * DFF, LG(G), LG(bx)); EpiSwiGLU E{(bf16*)(ws + BIG_H) + r1 * DFF, (SS0 + M) + r1};
                    pg8::gemm_phase<EpiSwiGLU, pg8::StaticOrder, true, true>(ring, g, S, E, LG(wave0)); } } }
#else
            for (int hb = 0; hb < KB_FFN_SPLIT; ++hb) { const size_t r0 = (size_t)hb * (M / KB_FFN_SPLIT);
                { pg8::Gemm g{(const bf16*)(ws + WS_XHAT) + r0 * DM, (const bf16*)(ws + W_F2IN), M / KB_FFN_SPLIT, 2 * DFF, DM}; pg8::StaticOrder S; S.init(M / KB_FFN_SPLIT, 2 * DFF, LG(G), LG(bx)); EpiSwiGLU E{(bf16*)(ws + BIG_H) + r0 * DFF, (SS0 + M) + r0};
                  pg8::gemm_phase<EpiSwiGLU, pg8::StaticOrder, true, true>(ring, g, S, E, LG(wave0)); }
                if (hb + 1 < KB_FFN_SPLIT) { xcd_barrier(bar);
                    pg8::Gemm g{(const bf16*)(ws + BIG_H) + r0 * DFF, (const bf16*)(ws + W_F2OUT), M / KB_FFN_SPLIT, DM, DFF}; pg8::StaticOrder S; S.init(M / KB_FFN_SPLIT, DM, LG(G), LG(bx)); EpiResid E{(bf16*)(ws + WS_XHAT) + r0 * DM, SS0 + r0, (SS0 + M) + r0, 0.5f};
                    pg8::gemm_phase<EpiResid, pg8::StaticOrder, true, true>(ring, g, S, E, LG(wave0)); xcd_barrier(bar); } }
#endif
        }
}
        SEAM(pb + 10);
        if (RUN(pb + 11)) { unsigned char* ws = WSP; ssq_t* SS0 = (ssq_t*)(ws + WS_SSQ); const size_t r0 = (size_t)(FFN_NBLK - 1) * (M / FFN_NBLK);
            pg8::Gemm g{(const bf16*)(ws + BIG_H) + r0 * DFF, (const bf16*)(ws + W_F2OUT), M / FFN_NBLK, DM, DFF}; pg8::StaticOrder S; S.init(M / FFN_NBLK, DM, LG(G), LG(bx)); EpiResid E{(bf16*)(ws + WS_XHAT) + r0 * DM, SS0 + r0, (SS0 + M) + r0, 0.5f};
            pg8::gemm_phase<EpiResid, pg8::StaticOrder, true, true>(ring, g, S, E, LG(wave0)); }
        SEAM(pb + 11);
    }
    for (int rep_ = 0; rep_ < REPS(12); ++rep_) { if (rep_) xcd_barrier(bar);
    if (RUN(PH_FINAL)) { PH_IDS unsigned char* ws = WSP; float* out = OUTP; final_rows((const bf16*)(ws + WS_XHAT), (const ssq_t*)(ws + WS_SSQ) + KB_FINAL_SS * M, INF(5), out, gw, NGW, lane); }
    }
#undef RUN
#undef SEAM
#undef bar
}

extern "C" void kernel_launch(void* const* d_in, const int* in_sizes, int n_in, void* d_out, int out_size, void* d_ws, size_t ws_size, hipStream_t stream) {
    static int grid = 0;
    if (grid == 0) {
        if (n_in != 24 || in_sizes[0] != M * DM || out_size != M * DM || ws_size < WS_END) { fprintf(stderr, "kernel_launch: unexpected shapes / workspace (n_in %d, ws %zu, need %zu)\n", n_in, ws_size, (size_t)WS_END); grid = -1; return; }
        int dev = 0, cus = 0, per_cu = 0;
        if (hipGetDevice(&dev) != hipSuccess || hipDeviceGetAttribute(&cus, hipDeviceAttributeMultiprocessorCount, dev) != hipSuccess) { grid = -1; return; }
        if (hipFuncSetAttribute((const void*)hybrid_fwd, hipFuncAttributeMaxDynamicSharedMemorySize, LDS_BYTES) != hipSuccess) { fprintf(stderr, "kernel_launch: hipFuncSetAttribute failed\n"); grid = -1; return; }
        if (hipOccupancyMaxActiveBlocksPerMultiprocessor(&per_cu, (const void*)hybrid_fwd, NWAVES * 64, LDS_BYTES) != hipSuccess || per_cu < 1) { fprintf(stderr, "kernel_launch: occupancy query says %d blocks per CU\n", per_cu); }
        (void)hipGetLastError();
        grid = cus;
    }
    if (grid < 0) return;
    if (hipMemsetAsync((char*)d_ws + WS_CTL, 0, CTL_ZERO_BYTES, stream) != hipSuccess) return;
    Args a{};
    for (int i = 0; i < 24; ++i) a.in[i] = d_in[i];
    a.out = (float*)d_out; a.ws = (unsigned char*)d_ws; a.pad = 0;
#if MK_PER_PHASE
    for (int p = 0; p < N_PHASES; ++p) { a.ph_lo = p; a.ph_hi = p + 1; a.li = 0; hipLaunchKernelGGL(hybrid_fwd, dim3(grid), dim3(NWAVES * 64), LDS_BYTES, stream, a); }
#else
    a.ph_lo = 0; a.ph_hi = N_PHASES; a.li = 0;
    hipLaunchKernelGGL(hybrid_fwd, dim3(grid), dim3(NWAVES * 64), LDS_BYTES, stream, a);
#endif
}
#endif
```
